# Optimizing an MI355X kernel written in HIP

```python
import math
import jax
import jax.numpy as jnp
from jax import lax
import numpy as np


D_MODEL = 1024
BATCH = 4
SEQ = 4096
DEPTH = 2
DEC_BATCH = 8
DEC_SEQ = 16
PAST_LEN = 4096

CHUNK = 64
EPS = 1e-6
CONV_W = 4
NH_A = 4
DK_A = 128
DV_A = 256
D_A = NH_A * DV_A
NH_B = 16
HEADDIM_B = 64
D_B = NH_B * HEADDIM_B
D_STATE = 128
NG_B = 2
HPG_B = NH_B // NG_B
CONV_DIM_B = D_B + 2 * NG_B * D_STATE
NH_C = 8
DK_C = 128
DV_C = 128
D_CK = NH_C * DK_C
D_CV = NH_C * DV_C
CONV_DIM_C = 2 * D_CK + D_CV
D_FF = 2816

SIZES_AB = (NH_A * DK_A, NH_A * DK_A, D_A, D_A, NH_A, NH_A, D_B, CONV_DIM_B, NH_B)
D_IN_AB = 2 * NH_A * DK_A + 2 * D_A + 2 * NH_A + D_B + CONV_DIM_B + NH_B
SIZES_C = (CONV_DIM_C, D_CV, NH_C, NH_C)
D_IN_C = CONV_DIM_C + D_CV + 2 * NH_C

kernel_name = 'hybrid_mlstm_ssd_gdn_macaron_stream_step'


def f32(t):
    return t.astype(jnp.float32)


def rmsnorm(x, g):
    xf = f32(x)
    y = xf * lax.rsqrt(jnp.mean(xf * xf, axis=-1, keepdims=True) + EPS)
    return (y * f32(g)).astype(x.dtype)


def l2norm(x):
    return x * lax.rsqrt(jnp.sum(x * x, axis=-1, keepdims=True) + EPS)


def swiglu(x, w_gate, w_up, w_down):
    return (jax.nn.silu(x @ w_gate) * (x @ w_up)) @ w_down


def split_cols(a, sizes):
    out, off = [], 0
    for s in sizes:
        out.append(a[..., off:off + s])
        off += s
    return out


def tril(L, k=0):
    return jnp.tril(jnp.ones((L, L), dtype=bool), k)


def causal_conv(x, buf, w, b=None):
    xp = jnp.concatenate([buf.astype(x.dtype), x], axis=1)
    y = lax.conv_general_dilated(f32(xp), f32(w)[:, None, :], (1,), 'VALID',
                                 dimension_numbers=('NWC', 'WIO', 'NWC'),
                                 feature_group_count=x.shape[-1])
    if b is not None:
        y = y + f32(b)
    return y, xp[:, xp.shape[1] - (CONV_W - 1):]


def to_chunks(a):
    return jnp.moveaxis(a.reshape(a.shape[0], a.shape[1] // CHUNK, CHUNK, *a.shape[2:]), 1, 0)


def from_chunks(a):
    a = jnp.moveaxis(a, 0, 1)
    return a.reshape(a.shape[0], a.shape[1] * a.shape[2], *a.shape[3:])


def chunk_scan(step, state, xs):
    if xs[0].shape[1] <= CHUNK:
        return step(state, xs)
    state, ys = lax.scan(step, state, tuple(to_chunks(t) for t in xs))
    return state, from_chunks(ys)


def mlstm_step(state, xs):
    C, n, m = state
    q, k, v, ig, lf = xs
    L = q.shape[1]
    causal = tril(L)[None, :, :, None]
    b = jnp.cumsum(lf, axis=1)
    dmat = jnp.where(causal, b[:, :, None, :] - b[:, None, :, :] + ig[:, None, :, :], -jnp.inf)
    inter = b + m[:, None, :]
    m_s = jnp.maximum(inter, dmat.max(axis=2))
    scores = jnp.einsum('bshd,brhd->bsrh', q, k) * jnp.exp(dmat - m_s[:, :, None, :])
    w_inter = jnp.exp(inter - m_s)
    num = jnp.einsum('bsrh,brhe->bshe', scores, v) + w_inter[..., None] * jnp.einsum('bshd,bhde->bshe', q, C)
    den = scores.sum(axis=2) + w_inter * jnp.einsum('bshd,bhd->bsh', q, n)
    h = num / jnp.maximum(jnp.abs(den), jnp.exp(-m_s))[..., None]
    bL = b[:, -1]
    dl = bL[:, None, :] - b + ig
    m_new = jnp.maximum(bL + m, dl.max(axis=1))
    wr = jnp.exp(dl - m_new[:, None, :])
    decay = jnp.exp(bL + m - m_new)
    C = decay[..., None, None] * C + jnp.einsum('brh,brhd,brhe->bhde', wr, k, v)
    n = decay[..., None] * n + jnp.einsum('brh,brhd->bhd', wr, k)
    return (C, n, m_new), h


def ssd_step(S, xs):
    x, bm, cm, dt, a = xs
    L = x.shape[1]
    causal = tril(L)[None, :, :, None, None]
    b = jnp.cumsum(a, axis=1)
    seg = jnp.exp(jnp.where(causal, b[:, :, None] - b[:, None], -jnp.inf))
    cb = jnp.einsum('bsgn,brgn->bsrg', cm, bm)
    y = (jnp.einsum('bsrgj,brgjp->bsgjp', cb[..., None] * seg, dt[..., None] * x)
         + jnp.exp(b)[..., None] * jnp.einsum('bsgn,bgjpn->bsgjp', cm, S))
    bL = b[:, -1]
    S = (jnp.exp(bL)[..., None, None] * S
         + jnp.einsum('brgj,brgjp,brgn->bgjpn', jnp.exp(bL[:, None] - b) * dt, x, bm))
    return S, y


def gdn_step(S, xs):
    q, k, v, beta, g = xs
    L = q.shape[1]
    gam = jnp.swapaxes(jnp.cumsum(g, axis=1), 1, 2)
    dec = jnp.exp(jnp.where(tril(L), gam[..., :, None] - gam[..., None, :], -jnp.inf))
    qh, kh, vh = jnp.swapaxes(q, 1, 2), jnp.swapaxes(k, 1, 2), jnp.swapaxes(v, 1, 2)
    bh = jnp.swapaxes(beta, 1, 2)[..., None]
    a_mat = jnp.where(tril(L, -1), bh * dec * (kh @ jnp.swapaxes(kh, -1, -2)), 0.0)
    rhs = jnp.concatenate([bh * vh, bh * jnp.exp(gam)[..., None] * kh], axis=-1)
    sol = lax.linalg.triangular_solve(a_mat, rhs, left_side=True, lower=True, unit_diagonal=True)
    u = sol[..., :DV_C] - sol[..., DV_C:] @ S
    o = jnp.exp(gam)[..., None] * (qh @ S) + ((qh @ jnp.swapaxes(kh, -1, -2)) * dec) @ u
    gL = gam[..., -1]
    S = (jnp.exp(gL)[..., None, None] * S
         + jnp.einsum('bhr,bhrd,bhre->bhde', jnp.exp(gL[..., None] - gam), kh, u))
    return S, jnp.swapaxes(o, 1, 2)


def mixer_ab(h, state, w_in, w_out, b_i, b_f, mlstm_norm, conv_w, conv_b, dt_bias, a_log, d_skip, ssd_norm):
    bsz, T, _ = h.shape
    C0, n0, m0, S0, buf0 = state
    q, k, v, o, ig, fg, z, xbc, dt = split_cols(h @ w_in, SIZES_AB)
    q = f32(q).reshape(bsz, T, NH_A, DK_A)
    k = f32(k).reshape(bsz, T, NH_A, DK_A) * (DK_A ** -0.5)
    v = f32(v).reshape(bsz, T, NH_A, DV_A)
    ig = f32(ig) + f32(b_i)
    lf = jax.nn.log_sigmoid(f32(fg) + f32(b_f))
    (C1, n1, m1), h_a = chunk_scan(mlstm_step, (f32(C0), f32(n0), f32(m0)), (q, k, v, ig, lf))
    h_a = jax.nn.sigmoid(f32(o)) * rmsnorm(h_a, mlstm_norm).reshape(bsz, T, D_A)
    xbc, buf1 = causal_conv(xbc, buf0, conv_w, conv_b)
    xs, bm, cm = split_cols(jax.nn.silu(xbc), (D_B, NG_B * D_STATE, NG_B * D_STATE))
    dt = jax.nn.softplus(f32(dt) + f32(dt_bias))
    a = -jnp.exp(f32(a_log)) * dt
    x5 = xs.reshape(bsz, T, NG_B, HPG_B, HEADDIM_B)
    S1, y = chunk_scan(ssd_step, f32(S0).reshape(bsz, NG_B, HPG_B, HEADDIM_B, D_STATE),
                       (x5, bm.reshape(bsz, T, NG_B, D_STATE), cm.reshape(bsz, T, NG_B, D_STATE),
                        dt.reshape(bsz, T, NG_B, HPG_B), a.reshape(bsz, T, NG_B, HPG_B)))
    y = (y + f32(d_skip).reshape(NG_B, HPG_B, 1) * x5).reshape(bsz, T, D_B) * jax.nn.silu(f32(z))
    y = rmsnorm(y.reshape(bsz, T, NG_B, D_B // NG_B), ssd_norm.reshape(NG_B, D_B // NG_B)).reshape(bsz, T, D_B)
    out = jnp.concatenate([h_a, y], axis=-1).astype(h.dtype) @ w_out
    return out, (C1, n1, m1, S1.reshape(bsz, NH_B, HEADDIM_B, D_STATE), buf1)


def mixer_c(h, state, w_in, w_out, conv_w, dt_bias, a_log, gdn_norm):
    bsz, T, _ = h.shape
    S0, buf0 = state
    qkv, z, b, a = split_cols(h @ w_in, SIZES_C)
    qkv, buf1 = causal_conv(qkv, buf0, conv_w)
    q, k, v = split_cols(jax.nn.silu(qkv), (D_CK, D_CK, D_CV))
    q = l2norm(q.reshape(bsz, T, NH_C, DK_C)) * (DK_C ** -0.5)
    k = l2norm(k.reshape(bsz, T, NH_C, DK_C))
    v = v.reshape(bsz, T, NH_C, DV_C)
    beta = jax.nn.sigmoid(f32(b))
    g = -jnp.exp(f32(a_log)) * jax.nn.softplus(f32(a) + f32(dt_bias))
    S1, o = chunk_scan(gdn_step, f32(S0), (q, k, v, beta, g))
    o = rmsnorm(o, gdn_norm) * jax.nn.silu(f32(z).reshape(bsz, T, NH_C, DV_C))
    return o.reshape(bsz, T, D_CV).astype(h.dtype) @ w_out, (S1, buf1)


def trunk(x, ab_state, c_state, norm_g, norm_f, ffn_w_gate, ffn_w_up, ffn_w_down,
          ab_w_in, ab_w_out, mlstm_b_i, mlstm_b_f, mlstm_norm, ssd_conv_w, ssd_conv_b,
          ssd_dt_bias, ssd_a_log, ssd_d, ssd_norm, gdn_w_in, gdn_w_out, gdn_conv_w,
          gdn_dt_bias, gdn_a_log, gdn_norm):
    for l in range(DEPTH):
        x = x + 0.5 * swiglu(rmsnorm(x, norm_g[l, 0]), ffn_w_gate[l, 0], ffn_w_up[l, 0], ffn_w_down[l, 0])
        hn = rmsnorm(x, norm_g[l, 1])
        if l % 2 == 0:
            out, ab_state = mixer_ab(hn, ab_state, ab_w_in, ab_w_out, mlstm_b_i, mlstm_b_f, mlstm_norm,
                                     ssd_conv_w, ssd_conv_b, ssd_dt_bias, ssd_a_log, ssd_d, ssd_norm)
        else:
            out, c_state = mixer_c(hn, c_state, gdn_w_in, gdn_w_out, gdn_conv_w, gdn_dt_bias, gdn_a_log, gdn_norm)
        x = x + out
        x = x + 0.5 * swiglu(rmsnorm(x, norm_g[l, 2]), ffn_w_gate[l, 1], ffn_w_up[l, 1], ffn_w_down[l, 1])
    ab_state = tuple(s.astype(x.dtype) for s in ab_state)
    c_state = tuple(s.astype(x.dtype) for s in c_state)
    return rmsnorm(x, norm_f), ab_state, c_state


def _dt_bias(key, n):
    dt = jnp.exp(jax.random.uniform(key, (n,), jnp.float32, math.log(1e-3), math.log(1e-1)))
    return dt + jnp.log(-jnp.expm1(-dt))


def setup_inputs(seed: int = 0) -> dict:
    key = jax.random.key(seed)
    ks = jax.random.split(key, 32)

    def nrm(k, shape, scale):
        return scale * jax.random.normal(k, shape, jnp.float32)

    return {
        'x_prompt': nrm(ks[0], (BATCH, SEQ, D_MODEL), 1.0),
        'x_sample': nrm(ks[1], (DEC_BATCH, DEC_SEQ, D_MODEL), 1.0),
        'state_mlstm_C': nrm(ks[2], (DEC_BATCH, NH_A, DK_A, DV_A), 0.1),
        'state_mlstm_n': nrm(ks[3], (DEC_BATCH, NH_A, DK_A), 0.1),
        'state_mlstm_m': nrm(ks[4], (DEC_BATCH, NH_A), 0.5),
        'state_ssd': nrm(ks[5], (DEC_BATCH, NH_B, HEADDIM_B, D_STATE), 0.1),
        'cache_ssd_conv': nrm(ks[6], (DEC_BATCH, CONV_W - 1, CONV_DIM_B), 1.0),
        'state_gdn': nrm(ks[7], (DEC_BATCH, NH_C, DK_C, DV_C), 0.1),
        'cache_gdn_conv': nrm(ks[8], (DEC_BATCH, CONV_W - 1, CONV_DIM_C), 1.0),
        'norm_g': 1.0 + nrm(ks[9], (DEPTH, 3, D_MODEL), 0.02),
        'norm_f': 1.0 + nrm(ks[10], (D_MODEL,), 0.02),
        'ffn_w_gate': nrm(ks[11], (DEPTH, 2, D_MODEL, D_FF), D_MODEL ** -0.5),
        'ffn_w_up': nrm(ks[12], (DEPTH, 2, D_MODEL, D_FF), D_MODEL ** -0.5),
        'ffn_w_down': nrm(ks[13], (DEPTH, 2, D_FF, D_MODEL), D_FF ** -0.5),
        'ab_w_in': nrm(ks[14], (D_MODEL, D_IN_AB), D_MODEL ** -0.5),
        'ab_w_out': nrm(ks[15], (D_A + D_B, D_MODEL), (D_A + D_B) ** -0.5),
        'mlstm_b_i': nrm(ks[16], (NH_A,), 0.1),
        'mlstm_b_f': jnp.linspace(3.0, 6.0, NH_A, dtype=jnp.float32) + nrm(ks[17], (NH_A,), 0.1),
        'mlstm_norm': 1.0 + nrm(ks[18], (NH_A, DV_A), 0.02),
        'ssd_conv_w': nrm(ks[19], (CONV_W, CONV_DIM_B), CONV_W ** -0.5),
        'ssd_conv_b': nrm(ks[20], (CONV_DIM_B,), 0.02),
        'ssd_dt_bias': _dt_bias(ks[21], NH_B),
        'ssd_a_log': jnp.log(jax.random.uniform(ks[22], (NH_B,), jnp.float32, 1.0, 16.0)),
        'ssd_d': 1.0 + nrm(ks[23], (NH_B,), 0.1),
        'ssd_norm': 1.0 + nrm(ks[24], (D_B,), 0.02),
        'gdn_w_in': nrm(ks[25], (D_MODEL, D_IN_C), D_MODEL ** -0.5),
        'gdn_w_out': nrm(ks[26], (D_CV, D_MODEL), D_CV ** -0.5),
        'gdn_conv_w': nrm(ks[27], (CONV_W, CONV_DIM_C), CONV_W ** -0.5),
        'gdn_dt_bias': _dt_bias(ks[28], NH_C),
        'gdn_a_log': jnp.log(jax.random.uniform(ks[29], (NH_C,), jnp.float32, 1.0, 16.0)),
        'gdn_norm': 1.0 + nrm(ks[30], (DV_C,), 0.02),
    }


def reference(x_prompt, x_sample, state_mlstm_C, state_mlstm_n, state_mlstm_m, state_ssd,
              cache_ssd_conv, state_gdn, cache_gdn_conv, norm_g, norm_f, ffn_w_gate, ffn_w_up,
              ffn_w_down, ab_w_in, ab_w_out, mlstm_b_i, mlstm_b_f, mlstm_norm, ssd_conv_w,
              ssd_conv_b, ssd_dt_bias, ssd_a_log, ssd_d, ssd_norm, gdn_w_in, gdn_w_out,
              gdn_conv_w, gdn_dt_bias, gdn_a_log, gdn_norm):
    weights = (norm_g, norm_f, ffn_w_gate, ffn_w_up, ffn_w_down, ab_w_in, ab_w_out, mlstm_b_i,
               mlstm_b_f, mlstm_norm, ssd_conv_w, ssd_conv_b, ssd_dt_bias, ssd_a_log, ssd_d,
               ssd_norm, gdn_w_in, gdn_w_out, gdn_conv_w, gdn_dt_bias, gdn_a_log, gdn_norm)
    bp = x_prompt.shape[0]
    fdt = jnp.float32
    ab0 = (jnp.zeros((bp, NH_A, DK_A, DV_A), fdt), jnp.zeros((bp, NH_A, DK_A), fdt),
           jnp.zeros((bp, NH_A), fdt), jnp.zeros((bp, NH_B, HEADDIM_B, D_STATE), fdt),
           jnp.zeros((bp, CONV_W - 1, CONV_DIM_B), x_prompt.dtype))
    c0 = (jnp.zeros((bp, NH_C, DK_C, DV_C), fdt), jnp.zeros((bp, CONV_W - 1, CONV_DIM_C), x_prompt.dtype))
    y_prompt, (p_C, p_n, p_m, p_ssd, p_ssd_conv), (p_gdn, p_gdn_conv) = trunk(x_prompt, ab0, c0, *weights)
    y_sample, (s_C, s_n, s_m, s_ssd, s_ssd_conv), (s_gdn, s_gdn_conv) = trunk(
        x_sample, (state_mlstm_C, state_mlstm_n, state_mlstm_m, state_ssd, cache_ssd_conv),
        (state_gdn, cache_gdn_conv), *weights)
    return (y_prompt, y_sample, p_C, p_n, p_m, p_ssd, p_ssd_conv, p_gdn, p_gdn_conv,
            s_C, s_n, s_m, s_ssd, s_ssd_conv, s_gdn, s_gdn_conv)
```

```cpp
#include <hip/hip_runtime.h>
#include <hip/hip_cooperative_groups.h>
#include <cstdio>
namespace cg = cooperative_groups;

typedef unsigned short bf16_t;
typedef short bf16x8 __attribute__((ext_vector_type(8)));
typedef float f32x4 __attribute__((ext_vector_type(4)));
typedef unsigned u32x2 __attribute__((ext_vector_type(2)));
typedef unsigned u32x4 __attribute__((ext_vector_type(4)));

#define DI __device__ __forceinline__
#define NTOK 16512
#define NPR 16384
#define LDS_BYTES 75776
#ifndef PHM
#define PHM 15
#endif

#define WS_WGU   0ull
#define WS_WD    (WS_WGU + 5632ull * 1024 * 2)
#define WS_WIN   (WS_WD + 1024ull * 2816 * 2)
#define WS_WOUT  (WS_WIN + 5760ull * 1024 * 2)
#define WS_H     (WS_WOUT + 1024ull * 2048 * 2)
#define WS_BIG   (WS_H + 16512ull * 1024 * 2)
#define WS_GATES (WS_BIG + 16512ull * 5632 * 2)
#define WS_HALO  (WS_GATES + 16512ull * 32 * 4)
#define WS_EGL   (WS_HALO + 272ull * 3 * 3072 * 2)
#define WS_END   (WS_EGL + 264ull * 8 * 4)

struct Params {
    const float* in[31];
    float* out;
    char* ws;
};

DI bf16_t f2bf(float f) { unsigned u = __float_as_uint(f); u += 0x7fffu + ((u >> 16) & 1u); return (bf16_t)(u >> 16); }
DI float bf2f(bf16_t h) { return __uint_as_float(((unsigned)h) << 16); }
DI unsigned pack2(float lo, float hi) { return (unsigned)f2bf(lo) | ((unsigned)f2bf(hi) << 16); }
DI float lo2f(unsigned u) { return __uint_as_float(u << 16); }
DI float hi2f(unsigned u) { return __uint_as_float(u & 0xffff0000u); }
DI float siluf(float x) { return x / (1.f + __expf(-x)); }
DI float sigmf(float x) { return 1.f / (1.f + __expf(-x)); }
DI float softplusf(float x) { return fmaxf(x, 0.f) + log1pf(__expf(-fabsf(x))); }
DI f32x4 mfma16(bf16x8 a, bf16x8 b, f32x4 c) { return __builtin_amdgcn_mfma_f32_16x16x32_bf16(a, b, c, 0, 0, 0); }
DI bf16x8 ldfrag(const bf16_t* base, int ld, int row, int k) { return *(const bf16x8*)(base + row * ld + k); }
DI void unpack8(u32x4 v, float* f) {
    f[0] = lo2f(v.x); f[1] = hi2f(v.x); f[2] = lo2f(v.y); f[3] = hi2f(v.y);
    f[4] = lo2f(v.z); f[5] = hi2f(v.z); f[6] = lo2f(v.w); f[7] = hi2f(v.w);
}
DI float wave_sum(float v) {
#pragma unroll
    for (int o = 32; o >= 1; o >>= 1) v += __shfl_xor(v, o);
    return v;
}

DI void phase_norm(const float* xp, const float* xs, const float* g, bf16_t* h) {
    const int lane = threadIdx.x & 63, gw = blockIdx.x * 4 + (threadIdx.x >> 6), nw = gridDim.x * 4;
    for (int row = gw; row < NTOK; row += nw) {
        const float* src = row < NPR ? xp + (size_t)row * 1024 : xs + (size_t)(row - NPR) * 1024;
        float4 v[4]; float ss = 0.f;
#pragma unroll
        for (int i = 0; i < 4; ++i) { v[i] = *(const float4*)(src + i * 256 + lane * 4); ss += v[i].x * v[i].x + v[i].y * v[i].y + v[i].z * v[i].z + v[i].w * v[i].w; }
        ss = wave_sum(ss);
        const float r = rsqrtf(ss * (1.f / 1024.f) + 1e-6f);
#pragma unroll
        for (int i = 0; i < 4; ++i) {
            const float4 gg = *(const float4*)(g + i * 256 + lane * 4);
            u32x2 o; o.x = pack2(v[i].x * r * gg.x, v[i].y * r * gg.y); o.y = pack2(v[i].z * r * gg.z, v[i].w * r * gg.w);
            *(u32x2*)(h + (size_t)row * 1024 + i * 256 + lane * 4) = o;
        }
    }
}
DI void phase_final_norm(float* x, const float* g) {
    const int lane = threadIdx.x & 63, gw = blockIdx.x * 4 + (threadIdx.x >> 6), nw = gridDim.x * 4;
    for (int row = gw; row < NTOK; row += nw) {
        float* src = x + (size_t)row * 1024;
        float4 v[4]; float ss = 0.f;
#pragma unroll
        for (int i = 0; i < 4; ++i) { v[i] = *(const float4*)(src + i * 256 + lane * 4); ss += v[i].x * v[i].x + v[i].y * v[i].y + v[i].z * v[i].z + v[i].w * v[i].w; }
        ss = wave_sum(ss);
        const float r = rsqrtf(ss * (1.f / 1024.f) + 1e-6f);
#pragma unroll
        for (int i = 0; i < 4; ++i) {
            const float4 gg = *(const float4*)(g + i * 256 + lane * 4);
            float4 o; o.x = v[i].x * r * gg.x; o.y = v[i].y * r * gg.y; o.z = v[i].z * r * gg.z; o.w = v[i].w * r * gg.w;
            *(float4*)(src + i * 256 + lane * 4) = o;
        }
    }
}

DI int map_row(int mode, int n) {
    if (mode == 0) return n;
    if (mode == 1) return ((n >> 4) << 5) + (n & 15);
    if (mode == 2) return ((n >> 4) << 5) + 16 + (n & 15);
    if (n < 2048) return n;
    if (n < 3072) return n + 1024;
    if (n < 3080) return n - 3072 + 5632;
    if (n < 4104) return n - 3080 + 2048;
    if (n < 5640) return n - 4104 + 4096;
    return n;
}
DI void cvt_job(const float* src, int K, int N, bf16_t* dst, int mode, int rot, char* smem) {
    float* tile = (float*)smem;
    const int tid = threadIdx.x, nkt = K >> 6, nnt = (N + 63) >> 6, ntiles = nkt * nnt;
    for (int t = (int)((blockIdx.x + rot) % gridDim.x); t < ntiles; t += gridDim.x) {
        const int kt = t % nkt, nt = t / nkt;
        __syncthreads();
#pragma unroll
        for (int i = 0; i < 4; ++i) {
            const int kl = (tid >> 4) + 16 * i, nl = (tid & 15) * 4, n = nt * 64 + nl;
            float4 v = make_float4(0.f, 0.f, 0.f, 0.f);
            if (n < N) v = *(const float4*)(src + (size_t)(kt * 64 + kl) * N + n);
            tile[kl * 65 + nl] = v.x; tile[kl * 65 + nl + 1] = v.y; tile[kl * 65 + nl + 2] = v.z; tile[kl * 65 + nl + 3] = v.w;
        }
        __syncthreads();
        const int nl = tid >> 2, kq = (tid & 3) * 16, n = nt * 64 + nl;
        if (n < N) {
            u32x4 o0, o1;
            o0.x = pack2(tile[(kq + 0) * 65 + nl], tile[(kq + 1) * 65 + nl]);   o0.y = pack2(tile[(kq + 2) * 65 + nl], tile[(kq + 3) * 65 + nl]);
            o0.z = pack2(tile[(kq + 4) * 65 + nl], tile[(kq + 5) * 65 + nl]);   o0.w = pack2(tile[(kq + 6) * 65 + nl], tile[(kq + 7) * 65 + nl]);
            o1.x = pack2(tile[(kq + 8) * 65 + nl], tile[(kq + 9) * 65 + nl]);   o1.y = pack2(tile[(kq + 10) * 65 + nl], tile[(kq + 11) * 65 + nl]);
            o1.z = pack2(tile[(kq + 12) * 65 + nl], tile[(kq + 13) * 65 + nl]); o1.w = pack2(tile[(kq + 14) * 65 + nl], tile[(kq + 15) * 65 + nl]);
            bf16_t* d = dst + (size_t)map_row(mode, n) * K + kt * 64 + kq;
            *(u32x4*)d = o0; *(u32x4*)(d + 8) = o1;
        }
    }
    __syncthreads();
}

struct Epi {
    bf16_t* o16; int ldc;
    float* o32;
    const float* rp; const float* rs; float scale;
    float* gates; bf16_t* halo; int cv0, cv1;
};
enum { EPI_GU = 0, EPI_RES = 1, EPI_PROJ = 2 };

template <int EPI>
DI void gemm_phase(const bf16_t* A, int lda, const bf16_t* Bt, int K, int nN, const Epi& e, char* smem) {
    const int tid = threadIdx.x, wid = tid >> 6, lane = tid & 63, wr = wid >> 1, wc = wid & 1, fr = lane & 15, fq = lane >> 4;
    char* SA = smem; char* SB = smem + 16384;
    const int ntiles = 129 * nN;
    for (int t = blockIdx.x; t < ntiles; t += gridDim.x) {
        const int pm = t / nN, pn = t % nN;
        f32x4 acc[4][4];
#pragma unroll
        for (int n = 0; n < 4; ++n)
#pragma unroll
            for (int m = 0; m < 4; ++m) acc[n][m] = (f32x4){0.f, 0.f, 0.f, 0.f};
        const bf16_t* Ab = A + (size_t)(pm * 128) * lda;
        const bf16_t* Bb = Bt + (size_t)(pn * 128) * K;
        for (int k0 = 0; k0 < K; k0 += 64) {
#pragma unroll
            for (int i = 0; i < 4; ++i) {
                const int b = tid * 16 + i * 4096, r = b >> 7, c = (b >> 4) & 7, gc = (c ^ (r & 7)) * 8;
                __builtin_amdgcn_global_load_lds((const unsigned*)(Ab + (size_t)r * lda + k0 + gc), (__attribute__((address_space(3))) unsigned*)(SA + b), 16, 0, 0);
                __builtin_amdgcn_global_load_lds((const unsigned*)(Bb + (size_t)r * K + k0 + gc), (__attribute__((address_space(3))) unsigned*)(SB + b), 16, 0, 0);
            }
            asm volatile("s_waitcnt vmcnt(0)" ::: "memory");
            __syncthreads();
#pragma unroll
            for (int ks = 0; ks < 2; ++ks) {
                bf16x8 af[4], bf[4];
                const int sw = ((ks * 4 + fq) ^ (fr & 7)) << 4;
#pragma unroll
                for (int m = 0; m < 4; ++m) af[m] = *(const bf16x8*)(SA + (wr * 64 + m * 16 + fr) * 128 + sw);
#pragma unroll
                for (int n = 0; n < 4; ++n) bf[n] = *(const bf16x8*)(SB + (wc * 64 + n * 16 + fr) * 128 + sw);
#pragma unroll
                for (int n = 0; n < 4; ++n)
#pragma unroll
                    for (int m = 0; m < 4; ++m) acc[n][m] = mfma16(bf[n], af[m], acc[n][m]);
            }
            __syncthreads();
        }
#pragma unroll
        for (int m = 0; m < 4; ++m) {
            const int row = pm * 128 + wr * 64 + m * 16 + fr;
            if (EPI == EPI_GU) {
#pragma unroll
                for (int i = 0; i < 2; ++i) {
                    const f32x4 g = acc[2 * i][m], u = acc[2 * i + 1][m];
                    u32x2 o; o.x = pack2(siluf(g[0]) * u[0], siluf(g[1]) * u[1]); o.y = pack2(siluf(g[2]) * u[2], siluf(g[3]) * u[3]);
                    *(u32x2*)(e.o16 + (size_t)row * e.ldc + pn * 64 + wc * 32 + i * 16 + 4 * fq) = o;
                }
            } else if (EPI == EPI_RES) {
                const float* rsrc = row < NPR ? e.rp + (size_t)row * 1024 : e.rs + (size_t)(row - NPR) * 1024;
#pragma unroll
                for (int n = 0; n < 4; ++n) {
                    const int col = pn * 128 + wc * 64 + n * 16 + 4 * fq;
                    const float4 r4 = *(const float4*)(rsrc + col);
                    float4 o; o.x = r4.x + e.scale * acc[n][m][0]; o.y = r4.y + e.scale * acc[n][m][1]; o.z = r4.z + e.scale * acc[n][m][2]; o.w = r4.w + e.scale * acc[n][m][3];
                    *(float4*)(e.o32 + (size_t)row * 1024 + col) = o;
                }
            } else {
                if (pn < nN - 1) {
                    int hr, unit;
                    if (row < NPR) { hr = (row & 63) - 61; unit = row >> 6; } else { hr = ((row - NPR) & 15) - 13; unit = 256 + ((row - NPR) >> 4); }
#pragma unroll
                    for (int n = 0; n < 4; ++n) {
                        const int col = pn * 128 + wc * 64 + n * 16 + 4 * fq;
                        u32x2 o; o.x = pack2(acc[n][m][0], acc[n][m][1]); o.y = pack2(acc[n][m][2], acc[n][m][3]);
                        *(u32x2*)(e.o16 + (size_t)row * e.ldc + col) = o;
                        if (hr >= 0 && col >= e.cv0 && col < e.cv1) *(u32x2*)(e.halo + ((size_t)unit * 3 + hr) * 3072 + (col - e.cv0)) = o;
                    }
                } else if (wc == 0) {
#pragma unroll
                    for (int n = 0; n < 2; ++n) {
                        float4 o; o.x = acc[n][m][0]; o.y = acc[n][m][1]; o.z = acc[n][m][2]; o.w = acc[n][m][3];
                        *(float4*)(e.gates + (size_t)row * 32 + n * 16 + 4 * fq) = o;
                    }
                }
            }
        }
    }
}


#define OFF_YS   16777216
#define OFF_PC   16908288
#define OFF_PN   17432576
#define OFF_PM   17434624
#define OFF_PSSD 17434640
#define OFF_PSC  17958928
#define OFF_PG   17977360
#define OFF_PGC  18501648
#define OFF_SC   18538512
#define OFF_SN   19587088
#define OFF_SM   19591184
#define OFF_SSSD 19591216
#define OFF_SSC  20639792
#define OFF_SG   20676656
#define OFF_SGC  21725232

DI float scan_add(float v, int lane) {
#pragma unroll
    for (int o = 1; o < 64; o <<= 1) { const float t = __shfl_up(v, o); if (lane >= o) v += t; }
    return v;
}
DI float scan_max(float v, int lane) {
#pragma unroll
    for (int o = 1; o < 64; o <<= 1) { const float t = __shfl_up(v, o); if (lane >= o) v = fmaxf(v, t); }
    return v;
}
DI u32x2 pack4(f32x4 v) { u32x2 o; o.x = pack2(v[0], v[1]); o.y = pack2(v[2], v[3]); return o; }
DI u32x4 pack8(const float* f) { u32x4 o; o.x = pack2(f[0], f[1]); o.y = pack2(f[2], f[3]); o.z = pack2(f[4], f[5]); o.w = pack2(f[6], f[7]); return o; }

DI void fill_cache_halo(const float* cache, int width, bf16_t* halo) {
    for (int i = blockIdx.x * 256 + threadIdx.x; i < 8 * 3 * width; i += gridDim.x * 256) {
        const int s = i / (3 * width), rem = i % (3 * width), r = rem / width, col = rem % width;
        halo[((size_t)(264 + s) * 3 + r) * 3072 + col] = f2bf(cache[i]);
    }
}

DI void phase_conv_ssd(const Params& p, bf16_t* BIG, const bf16_t* halo) {
    const int tid = threadIdx.x, cv = tid & 31, tg = tid >> 5;
    const float* cw = p.in[19]; const float* cb = p.in[20];
    for (int it = blockIdx.x; it < 264 * 6; it += gridDim.x) {
        const int unit = it / 6, cblk = it % 6, col = cblk * 256 + cv * 8;
        const bool smp = unit >= 256;
        const int L = smp ? 16 : 64, c = unit & 63, s = unit - 256;
        const size_t row0 = smp ? (size_t)NPR + s * 16 : (size_t)unit * 64;
        const bool act = tg * 8 < L;
        float x[11][8];
        if (act) {
#pragma unroll
            for (int i = 0; i < 11; ++i) {
                const int rl = tg * 8 - 3 + i;
                if (rl >= 0) { const u32x4 v = *(const u32x4*)(BIG + (row0 + rl) * 5632 + 4096 + col); unpack8(v, x[i]); }
                else if (!smp) {
                    if (c == 0) {
#pragma unroll
                        for (int j = 0; j < 8; ++j) x[i][j] = 0.f;
                    } else { const u32x4 v = *(const u32x4*)(halo + ((size_t)(unit - 1) * 3 + (rl + 3)) * 3072 + col); unpack8(v, x[i]); }
                } else {
                    const float* src = p.in[6] + ((size_t)s * 3 + (rl + 3)) * 1536 + col;
                    const float4 a = *(const float4*)src, b = *(const float4*)(src + 4);
                    x[i][0] = a.x; x[i][1] = a.y; x[i][2] = a.z; x[i][3] = a.w; x[i][4] = b.x; x[i][5] = b.y; x[i][6] = b.z; x[i][7] = b.w;
                }
            }
        }
        __syncthreads();
        if (act) {
            float w[4][8], bb[8];
#pragma unroll
            for (int i = 0; i < 4; ++i) {
                const float4 a = *(const float4*)(cw + i * 1536 + col), b = *(const float4*)(cw + i * 1536 + col + 4);
                w[i][0] = a.x; w[i][1] = a.y; w[i][2] = a.z; w[i][3] = a.w; w[i][4] = b.x; w[i][5] = b.y; w[i][6] = b.z; w[i][7] = b.w;
            }
            { const float4 a = *(const float4*)(cb + col), b = *(const float4*)(cb + col + 4);
              bb[0] = a.x; bb[1] = a.y; bb[2] = a.z; bb[3] = a.w; bb[4] = b.x; bb[5] = b.y; bb[6] = b.z; bb[7] = b.w; }
#pragma unroll
            for (int t = 0; t < 8; ++t) {
                float o[8];
#pragma unroll
                for (int j = 0; j < 8; ++j) { const float a = bb[j] + w[0][j] * x[t][j] + w[1][j] * x[t + 1][j] + w[2][j] * x[t + 2][j] + w[3][j] * x[t + 3][j]; o[j] = siluf(a); }
                *(u32x4*)(BIG + (row0 + tg * 8 + t) * 5632 + 4096 + col) = pack8(o);
            }
        }
        if ((smp || c == 63) && tid < 96) {
            const int i = tid >> 5;
            float f[8]; unpack8(*(const u32x4*)(halo + ((size_t)unit * 3 + i) * 3072 + col), f);
            float* dst = smp ? p.out + OFF_SSC + ((size_t)s * 3 + i) * 1536 + col : p.out + OFF_PSC + ((size_t)(unit >> 6) * 3 + i) * 1536 + col;
            *(float4*)dst = make_float4(f[0], f[1], f[2], f[3]); *(float4*)(dst + 4) = make_float4(f[4], f[5], f[6], f[7]);
        }
        __syncthreads();
    }
}

#define L_Q   0
#define L_K   17408
#define L_KT  34816
#define L_VT  53248
#define L_VW  55552
#define L_P   57856
#define L_ST  67072
#define L_F   71424

DI void mlstm_chain(const Params& p, bf16_t* BIG, const float* gates, int b, int hd, int es, bool smp, char* smem) {
    const int tid = threadIdx.x, wid = tid >> 6, lane = tid & 63, fr = lane & 15, fq = lane >> 4;
    bf16_t* Qs = (bf16_t*)(smem + L_Q); bf16_t* Ks = (bf16_t*)(smem + L_K); bf16_t* KTs = (bf16_t*)(smem + L_KT); bf16_t* VTs = (bf16_t*)(smem + L_VT);
    bf16_t* VWs = (bf16_t*)(smem + L_VW); bf16_t* Ps = (bf16_t*)(smem + L_P); bf16_t* STs = (bf16_t*)(smem + L_ST);
    float* fl = (float*)(smem + L_F);
    float* as_ = fl; float* Ms = fl + 64; float* bs = fl + 128; float* wrs = fl + 192; float* rsum = fl + 256; float* qns = fl + 320; float* ns = fl + 384; float* sc = fl + 512;
    const int L = smp ? 16 : 64, nch = smp ? 1 : 64, sidx = b * 4 + hd;
    const size_t row0 = smp ? (size_t)NPR + b * 16 : (size_t)b * 4096;
    const float bi = p.in[16][hd], bfg = p.in[17][hd];
    float m = 0.f, nreg = 0.f;
    f32x4 accC[2];
    accC[0] = (f32x4){0.f, 0.f, 0.f, 0.f}; accC[1] = accC[0];
    if (smp) {
        const float* C0 = p.in[2] + (size_t)sidx * 128 * 256;
#pragma unroll
        for (int mt = 0; mt < 2; ++mt)
#pragma unroll
            for (int j = 0; j < 4; ++j) accC[mt][j] = C0[(size_t)(32 * wid + 16 * mt + 4 * fq + j) * 256 + es * 16 + fr];
        if (tid < 128) nreg = p.in[3][sidx * 128 + tid];
        m = p.in[4][sidx];
    }
    __syncthreads();
#pragma unroll
    for (int mt = 0; mt < 2; ++mt) *(u32x2*)(STs + fr * 136 + 32 * wid + 16 * mt + 4 * fq) = pack4(accC[mt]);
    if (tid < 128) ns[tid] = nreg;

    u32x4 qv[4], kv[4], vv; float gi = 0.f, gf = 0.f;
    auto load = [&](int c) __attribute__((always_inline)) {
        const size_t r0 = row0 + (size_t)c * 64;
{
            const int r = tid >> 2, qt = tid & 3, rc = r < L ? r : L - 1;
            const bf16_t* qp = BIG + (r0 + rc) * 5632 + hd * 128 + qt * 32;
#pragma unroll
            for (int i = 0; i < 4; ++i) {
                qv[i] = *(const u32x4*)(qp + i * 8); kv[i] = *(const u32x4*)(qp + 512 + i * 8);
                if (r >= L) { qv[i] = (u32x4){0u, 0u, 0u, 0u}; kv[i] = (u32x4){0u, 0u, 0u, 0u}; }
            }
        }
        { const int r = (tid & 127) >> 1, cc = tid & 1, rc = r < L ? r : L - 1;
          vv = *(const u32x4*)(BIG + (r0 + rc) * 5632 + 1024 + hd * 256 + es * 16 + cc * 8);
          if (r >= L) vv = (u32x4){0u, 0u, 0u, 0u}; }
        { const int lc = lane < L ? lane : L - 1; gi = gates[(r0 + lc) * 32 + hd]; gf = gates[(r0 + lc) * 32 + 4 + hd]; }
    };
    load(0);
    for (int c = 0; c < nch; ++c) {
        __syncthreads();
        if (wid == 0) {
            float ig = -1e30f, lf = 0.f;
            if (lane < L) { ig = gi + bi; const float x = gf + bfg; lf = fminf(x, 0.f) - log1pf(__expf(-fabsf(x))); }
            const float bc = scan_add(lf, lane);
            const float a = ig - bc;
            const float pm = scan_max(a, lane);
            const float M = fmaxf(m, pm);
            const float Mlast = __shfl(M, L - 1), bL = __shfl(bc, L - 1);
            as_[lane] = a; Ms[lane] = M; bs[lane] = bc; wrs[lane] = lane < L ? __expf(a - Mlast) : 0.f;
            if (lane == 0) { sc[0] = Mlast; sc[1] = bL; }
        }
        __syncthreads();
{
            const int r = tid >> 2, qt = tid & 3;
            bf16_t* qd = Qs + r * 136 + qt * 32; bf16_t* kd = Ks + r * 136 + qt * 32; bf16_t* ktd = KTs + (qt * 32) * 72 + r;
#pragma unroll
            for (int i = 0; i < 4; ++i) {
                *(u32x4*)(qd + i * 8) = qv[i];
                float kf[8]; unpack8(kv[i], kf);
#pragma unroll
                for (int j = 0; j < 8; ++j) { kf[j] *= 0.08838834764831845f; ktd[(i * 8 + j) * 72] = f2bf(kf[j]); }
                *(u32x4*)(kd + i * 8) = pack8(kf);
            }
        }
        if (tid < 128) {
            const int r = tid >> 1, cc = tid & 1; const float w = wrs[r];
            float vf[8]; unpack8(vv, vf);
#pragma unroll
            for (int j = 0; j < 8; ++j) { VTs[(cc * 8 + j) * 72 + r] = f2bf(vf[j]); VWs[(cc * 8 + j) * 72 + r] = f2bf(vf[j] * w); }
        }
        if (c + 1 < nch) load(c + 1);
        __syncthreads();
        {
            f32x4 s4[4];
#pragma unroll
            for (int nt = 0; nt < 4; ++nt) s4[nt] = (f32x4){0.f, 0.f, 0.f, 0.f};
#pragma unroll
            for (int kk = 0; kk < 4; ++kk) {
                const bf16x8 qf = ldfrag(Qs, 136, 16 * wid + fr, kk * 32 + fq * 8);
#pragma unroll
                for (int nt = 0; nt < 4; ++nt) s4[nt] = mfma16(ldfrag(Ks, 136, 16 * nt + fr, kk * 32 + fq * 8), qf, s4[nt]);
            }
            const int s = 16 * wid + fr; const float Msv = Ms[s]; float rs = 0.f;
#pragma unroll
            for (int nt = 0; nt < 4; ++nt) {
                f32x4 pv;
#pragma unroll
                for (int j = 0; j < 4; ++j) { const int r = 16 * nt + 4 * fq + j; const float d = (r <= s) ? __expf(as_[r] - Msv) : 0.f; pv[j] = s4[nt][j] * d; rs += pv[j]; }
                *(u32x2*)(Ps + s * 72 + 16 * nt + 4 * fq) = pack4(pv);
            }
            rs += __shfl_xor(rs, 16); rs += __shfl_xor(rs, 32);
            if (fq == 0) rsum[s] = rs;
            const int s2 = tid >> 2, part = tid & 3; float qa = 0.f;
#pragma unroll
            for (int j = 0; j < 4; ++j) { float qf8[8]; unpack8(*(const u32x4*)(Qs + s2 * 136 + part * 32 + j * 8), qf8);
#pragma unroll
                for (int i = 0; i < 8; ++i) qa += qf8[i] * ns[part * 32 + j * 8 + i]; }
            qa += __shfl_xor(qa, 1); qa += __shfl_xor(qa, 2);
            if (part == 0) qns[s2] = qa;
        }
        __syncthreads();
        const float Mlast = sc[0], bL = sc[1];
        {
            f32x4 h1 = (f32x4){0.f, 0.f, 0.f, 0.f}, h2 = h1;
#pragma unroll
            for (int kk = 0; kk < 2; ++kk) h1 = mfma16(ldfrag(VTs, 72, fr, kk * 32 + fq * 8), ldfrag(Ps, 72, 16 * wid + fr, kk * 32 + fq * 8), h1);
#pragma unroll
            for (int kk = 0; kk < 4; ++kk) h2 = mfma16(ldfrag(STs, 136, fr, kk * 32 + fq * 8), ldfrag(Qs, 136, 16 * wid + fr, kk * 32 + fq * 8), h2);
            const int s = 16 * wid + fr; const float Msv = Ms[s], wi = __expf(m - Msv);
            const float den = rsum[s] + wi * qns[s], ms = bs[s] + Msv, inv = 1.f / fmaxf(fabsf(den), __expf(-ms));
            f32x4 hv;
#pragma unroll
            for (int j = 0; j < 4; ++j) hv[j] = (h1[j] + wi * h2[j]) * inv;
            if (s < L) *(u32x2*)(BIG + (row0 + (size_t)c * 64 + s) * 5632 + 1024 + hd * 256 + es * 16 + 4 * fq) = pack4(hv);
        }
        {
            const float decay = __expf(m - Mlast);
#pragma unroll
            for (int mt = 0; mt < 2; ++mt) {
                accC[mt] *= decay;
#pragma unroll
                for (int kk = 0; kk < 2; ++kk) accC[mt] = mfma16(ldfrag(KTs, 72, 32 * wid + 16 * mt + fr, kk * 32 + fq * 8), ldfrag(VWs, 72, fr, kk * 32 + fq * 8), accC[mt]);
            }
            if (tid < 128) {
                float sn = 0.f;
#pragma unroll
                for (int r8 = 0; r8 < 8; ++r8) { float kf[8]; unpack8(*(const u32x4*)(KTs + tid * 72 + r8 * 8), kf);
#pragma unroll
                    for (int i = 0; i < 8; ++i) sn += kf[i] * wrs[r8 * 8 + i]; }
                nreg = decay * nreg + sn;
            }
        }
        m = bL + Mlast;
        __syncthreads();
#pragma unroll
        for (int mt = 0; mt < 2; ++mt) *(u32x2*)(STs + fr * 136 + 32 * wid + 16 * mt + 4 * fq) = pack4(accC[mt]);
        if (tid < 128) ns[tid] = nreg;
    }
    float* Co = p.out + (smp ? OFF_SC : OFF_PC) + (size_t)sidx * 128 * 256;
#pragma unroll
    for (int mt = 0; mt < 2; ++mt)
#pragma unroll
        for (int j = 0; j < 4; ++j) Co[(size_t)(32 * wid + 16 * mt + 4 * fq + j) * 256 + es * 16 + fr] = accC[mt][j];
    if (es == 0) {
        if (tid < 128) p.out[(smp ? OFF_SN : OFF_PN) + sidx * 128 + tid] = nreg;
        if (tid == 0) p.out[(smp ? OFF_SM : OFF_PM) + sidx] = m;
    }
}

DI void ssd_chain(const Params& p, bf16_t* BIG, const float* gates, int b, int hd, int ps, bool smp, char* smem) {
    const int tid = threadIdx.x, wid = tid >> 6, lane = tid & 63, fr = lane & 15, fq = lane >> 4;
    bf16_t* Cs = (bf16_t*)(smem + L_Q); bf16_t* Bs = (bf16_t*)(smem + L_K); bf16_t* BTs = (bf16_t*)(smem + L_KT); bf16_t* XTs = (bf16_t*)(smem + L_VT);
    bf16_t* XWs = (bf16_t*)(smem + L_VW); bf16_t* Ps = (bf16_t*)(smem + L_P); bf16_t* STs = (bf16_t*)(smem + L_ST);
    float* fl = (float*)(smem + L_F);
    float* bs = fl; float* dts = fl + 64; float* wrs = fl + 128; float* sc = fl + 192;
    const int L = smp ? 16 : 64, nch = smp ? 1 : 64, sidx = b * 16 + hd, g = hd >> 3;
    const size_t row0 = smp ? (size_t)NPR + b * 16 : (size_t)b * 4096;
    const float dtb = p.in[21][hd], negA = -__expf(p.in[22][hd]), Dk = p.in[23][hd];
    f32x4 accS[2];
    accS[0] = (f32x4){0.f, 0.f, 0.f, 0.f}; accS[1] = accS[0];
    if (smp) {
        const float* S0 = p.in[5] + (size_t)sidx * 64 * 128;
#pragma unroll
        for (int i = 0; i < 2; ++i)
#pragma unroll
            for (int j = 0; j < 4; ++j) accS[i][j] = S0[(size_t)(ps * 16 + fr) * 128 + 16 * (2 * wid + i) + 4 * fq + j];
    }
    __syncthreads();
#pragma unroll
    for (int i = 0; i < 2; ++i) *(u32x2*)(STs + fr * 136 + 16 * (2 * wid + i) + 4 * fq) = pack4(accS[i]);

    u32x4 qv[4], kv[4], vv; float gd = 0.f;
    auto load = [&](int c) __attribute__((always_inline)) {
        const size_t r0 = row0 + (size_t)c * 64;
{
            const int r = tid >> 2, qt = tid & 3, rc = r < L ? r : L - 1;
            const bf16_t* bp = BIG + (r0 + rc) * 5632 + 5120 + g * 128 + qt * 32;
#pragma unroll
            for (int i = 0; i < 4; ++i) {
                qv[i] = *(const u32x4*)(bp + 256 + i * 8); kv[i] = *(const u32x4*)(bp + i * 8);
                if (r >= L) { qv[i] = (u32x4){0u, 0u, 0u, 0u}; kv[i] = (u32x4){0u, 0u, 0u, 0u}; }
            }
        }
        { const int r = (tid & 127) >> 1, cc = tid & 1, rc = r < L ? r : L - 1;
          vv = *(const u32x4*)(BIG + (r0 + rc) * 5632 + 4096 + hd * 64 + ps * 16 + cc * 8);
          if (r >= L) vv = (u32x4){0u, 0u, 0u, 0u}; }
        { const int lc = lane < L ? lane : L - 1; gd = gates[(r0 + lc) * 32 + 8 + hd]; }
    };
    load(0);
    for (int c = 0; c < nch; ++c) {
        __syncthreads();
        if (wid == 0) {
            float dtv = 0.f;
            if (lane < L) dtv = softplusf(gd + dtb);
            const float a = negA * dtv;
            const float bc = scan_add(a, lane);
            const float bL = __shfl(bc, L - 1);
            bs[lane] = bc; dts[lane] = dtv; wrs[lane] = __expf(bL - bc) * dtv;
            if (lane == 0) sc[1] = bL;
        }
        __syncthreads();
{
            const int r = tid >> 2, qt = tid & 3;
            bf16_t* qd = Cs + r * 136 + qt * 32; bf16_t* kd = Bs + r * 136 + qt * 32; bf16_t* ktd = BTs + (qt * 32) * 72 + r;
#pragma unroll
            for (int i = 0; i < 4; ++i) {
                *(u32x4*)(qd + i * 8) = qv[i];
                *(u32x4*)(kd + i * 8) = kv[i];
                const unsigned kw[4] = {kv[i].x, kv[i].y, kv[i].z, kv[i].w};
#pragma unroll
                for (int j = 0; j < 4; ++j) { ktd[(i * 8 + 2 * j) * 72] = (bf16_t)(kw[j] & 0xffffu); ktd[(i * 8 + 2 * j + 1) * 72] = (bf16_t)(kw[j] >> 16); }
            }
        }
        if (tid < 128) {
            const int r = tid >> 1, cc = tid & 1; const float w = wrs[r];
            float vf[8]; unpack8(vv, vf);
#pragma unroll
            for (int j = 0; j < 8; ++j) { XTs[(cc * 8 + j) * 72 + r] = f2bf(vf[j]); XWs[(cc * 8 + j) * 72 + r] = f2bf(vf[j] * w); }
        }
        if (c + 1 < nch) load(c + 1);
        __syncthreads();
        {
            f32x4 s4[4];
#pragma unroll
            for (int nt = 0; nt < 4; ++nt) s4[nt] = (f32x4){0.f, 0.f, 0.f, 0.f};
#pragma unroll
            for (int kk = 0; kk < 4; ++kk) {
                const bf16x8 qf = ldfrag(Cs, 136, 16 * wid + fr, kk * 32 + fq * 8);
#pragma unroll
                for (int nt = 0; nt < 4; ++nt) s4[nt] = mfma16(ldfrag(Bs, 136, 16 * nt + fr, kk * 32 + fq * 8), qf, s4[nt]);
            }
            const int s = 16 * wid + fr; const float bsv = bs[s];
#pragma unroll
            for (int nt = 0; nt < 4; ++nt) {
                f32x4 pv;
#pragma unroll
                for (int j = 0; j < 4; ++j) { const int r = 16 * nt + 4 * fq + j; const float d = (r <= s) ? __expf(bsv - bs[r]) * dts[r] : 0.f; pv[j] = s4[nt][j] * d; }
                *(u32x2*)(Ps + s * 72 + 16 * nt + 4 * fq) = pack4(pv);
            }
        }
        __syncthreads();
        const float bL = sc[1];
        {
            f32x4 h1 = (f32x4){0.f, 0.f, 0.f, 0.f}, h2 = h1;
#pragma unroll
            for (int kk = 0; kk < 2; ++kk) h1 = mfma16(ldfrag(XTs, 72, fr, kk * 32 + fq * 8), ldfrag(Ps, 72, 16 * wid + fr, kk * 32 + fq * 8), h1);
#pragma unroll
            for (int kk = 0; kk < 4; ++kk) h2 = mfma16(ldfrag(STs, 136, fr, kk * 32 + fq * 8), ldfrag(Cs, 136, 16 * wid + fr, kk * 32 + fq * 8), h2);
            const int s = 16 * wid + fr; const float eb = __expf(bs[s]);
            if (s < L) {
                bf16_t* zp = BIG + (row0 + (size_t)c * 64 + s) * 5632 + 2048 + hd * 64 + ps * 16 + 4 * fq;
                const u32x2 zr = *(const u32x2*)zp;
                const float zf[4] = {lo2f(zr.x), hi2f(zr.x), lo2f(zr.y), hi2f(zr.y)};
                f32x4 yv;
#pragma unroll
                for (int j = 0; j < 4; ++j) { const float xv = bf2f(XTs[(4 * fq + j) * 72 + s]); yv[j] = (h1[j] + eb * h2[j] + Dk * xv) * siluf(zf[j]); }
                *(u32x2*)zp = pack4(yv);
            }
        }
        {
            const float dec = __expf(bL);
#pragma unroll
            for (int i = 0; i < 2; ++i) {
                accS[i] *= dec;
#pragma unroll
                for (int kk = 0; kk < 2; ++kk) accS[i] = mfma16(ldfrag(BTs, 72, 16 * (2 * wid + i) + fr, kk * 32 + fq * 8), ldfrag(XWs, 72, fr, kk * 32 + fq * 8), accS[i]);
            }
        }
        __syncthreads();
#pragma unroll
        for (int i = 0; i < 2; ++i) *(u32x2*)(STs + fr * 136 + 16 * (2 * wid + i) + 4 * fq) = pack4(accS[i]);
    }
    float* So = p.out + (smp ? OFF_SSSD : OFF_PSSD) + (size_t)sidx * 64 * 128;
#pragma unroll
    for (int i = 0; i < 2; ++i) {
        float4 o; o.x = accS[i][0]; o.y = accS[i][1]; o.z = accS[i][2]; o.w = accS[i][3];
        *(float4*)(So + (size_t)(ps * 16 + fr) * 128 + 16 * (2 * wid + i) + 4 * fq) = o;
    }
}

DI void phase_scan_l0(const Params& p, bf16_t* BIG, const float* gates, char* smem) {
    for (int it = blockIdx.x; it < 1536; it += gridDim.x) {
        const bool smp = it >= 512;
        const int j = it & 255, k = smp ? (it - 512) & 511 : j;
#ifndef NO_MLSTM
        if (it < 256 || (smp && it < 1024)) mlstm_chain(p, BIG, gates, k >> 6, (k >> 4) & 3, k & 15, smp, smem);
#endif
#ifndef NO_SSD
        if ((it >= 256 && it < 512) || it >= 1024) ssd_chain(p, BIG, gates, k >> 6, (k >> 2) & 15, k & 3, smp, smem);
#endif
    }
}

DI void phase_post_l0(const Params& p, bf16_t* BIG) {
    const int lane = threadIdx.x & 63, gw = blockIdx.x * 4 + (threadIdx.x >> 6), nw = gridDim.x * 4;
    for (int row = gw; row < NTOK; row += nw) {
        bf16_t* rp = BIG + (size_t)row * 5632;
#pragma unroll
        for (int hd = 0; hd < 4; ++hd) {
            const u32x2 rv = *(const u32x2*)(rp + 1024 + hd * 256 + lane * 4), ov = *(const u32x2*)(rp + 3072 + hd * 256 + lane * 4);
            const float x[4] = {lo2f(rv.x), hi2f(rv.x), lo2f(rv.y), hi2f(rv.y)}, o[4] = {lo2f(ov.x), hi2f(ov.x), lo2f(ov.y), hi2f(ov.y)};
            const float ss = wave_sum(x[0] * x[0] + x[1] * x[1] + x[2] * x[2] + x[3] * x[3]);
            const float r = rsqrtf(ss * (1.f / 256.f) + 1e-6f);
            const float4 gg = *(const float4*)(p.in[18] + hd * 256 + lane * 4);
            f32x4 y; y[0] = sigmf(o[0]) * x[0] * r * gg.x; y[1] = sigmf(o[1]) * x[1] * r * gg.y; y[2] = sigmf(o[2]) * x[2] * r * gg.z; y[3] = sigmf(o[3]) * x[3] * r * gg.w;
            *(u32x2*)(rp + 1024 + hd * 256 + lane * 4) = pack4(y);
        }
#pragma unroll
        for (int g = 0; g < 2; ++g) {
            float x[8]; unpack8(*(const u32x4*)(rp + 2048 + g * 512 + lane * 8), x);
            float ss = 0.f;
#pragma unroll
            for (int j = 0; j < 8; ++j) ss += x[j] * x[j];
            ss = wave_sum(ss);
            const float r = rsqrtf(ss * (1.f / 512.f) + 1e-6f);
            const float4 g0 = *(const float4*)(p.in[24] + g * 512 + lane * 8), g1 = *(const float4*)(p.in[24] + g * 512 + lane * 8 + 4);
            float y[8] = {x[0] * r * g0.x, x[1] * r * g0.y, x[2] * r * g0.z, x[3] * r * g0.w, x[4] * r * g1.x, x[5] * r * g1.y, x[6] * r * g1.z, x[7] * r * g1.w};
            *(u32x4*)(rp + 2048 + g * 512 + lane * 8) = pack8(y);
        }
    }
}

#define G_QN  0
#define G_KN  18432
#define G_VT  18432
#define G_AT  36864
#define G_VN  53504
#define G_TV  53504
#define G_TW  62720
#define G_F   71936
DI void gdn_g1_item(const Params& p, bf16_t* BIG, bf16_t* Wb, bf16_t* PB, const float* gates, const bf16_t* halo, float* egl, int unit, int hd, char* smem) {
    const int tid = threadIdx.x, wid = tid >> 6, lane = tid & 63, fr = lane & 15, fq = lane >> 4;
    bf16_t* Qn = (bf16_t*)(smem + G_QN); bf16_t* Kn = (bf16_t*)(smem + G_KN); bf16_t* KTs = (bf16_t*)(smem + G_QN); bf16_t* VTs = (bf16_t*)(smem + G_VT);
    bf16_t* Vn = (bf16_t*)(smem + G_VN);
    float* AT = (float*)(smem + G_AT); bf16_t* Tv = (bf16_t*)(smem + G_TV); bf16_t* Tw = (bf16_t*)(smem + G_TW);
    float* beta_s = (float*)(smem + G_F); float* gam_s = beta_s + 64;
    const bool smp = unit >= 256;
    const int L = smp ? 16 : 64, c = unit & 63, s_ = unit - 256;
    const size_t row0 = smp ? (size_t)NPR + s_ * 16 : (size_t)unit * 64;
    const int tok = tid >> 2, qt = tid & 3;
    const float* cw = p.in[27];
    const bf16_t* hp = halo + (size_t)(smp ? 264 + s_ : (unit > 0 ? unit - 1 : 0)) * 3 * 3072;
    const bool zh = !smp && c == 0;
    __syncthreads();
    if (wid == 0) {
        float beta = 0.f, g = 0.f;
        const int lc = lane < L ? lane : L - 1;
        const float br = gates[(row0 + lc) * 32 + hd], ar = gates[(row0 + lc) * 32 + 8 + hd];
        if (lane < L) { beta = sigmf(br); g = -__expf(p.in[29][hd]) * softplusf(ar + p.in[28][hd]); }
        const float gam = scan_add(g, lane);
        beta_s[lane] = beta; gam_s[lane] = gam;
        if (lane == L - 1) egl[unit * 8 + hd] = __expf(gam);
    }
#pragma unroll 1
    for (int mi = 0; mi < 3; ++mi) {
        float o[32];
#pragma unroll
        for (int j = 0; j < 4; ++j) {
            const int col = mi * 1024 + hd * 128 + qt * 32 + j * 8;
            float a8[8];
#pragma unroll
            for (int q = 0; q < 8; ++q) a8[q] = 0.f;
#pragma unroll
            for (int i = 0; i < 4; ++i) {
                const int tc = tok < L ? tok : L - 1, rlc = tc - 3 + i;
                const bf16_t* src = rlc >= 0 ? BIG + (row0 + rlc) * 4096 + col : hp + (rlc + 3) * 3072 + col;
                u32x4 xv = *(const u32x4*)src;
                if (rlc < 0 && zh) xv = (u32x4){0u, 0u, 0u, 0u};
                float xf[8]; unpack8(xv, xf);
                const float4 w0 = *(const float4*)(cw + i * 3072 + col), w1 = *(const float4*)(cw + i * 3072 + col + 4);
                a8[0] += w0.x * xf[0]; a8[1] += w0.y * xf[1]; a8[2] += w0.z * xf[2]; a8[3] += w0.w * xf[3];
                a8[4] += w1.x * xf[4]; a8[5] += w1.y * xf[5]; a8[6] += w1.z * xf[6]; a8[7] += w1.w * xf[7];
            }
#pragma unroll
            for (int q = 0; q < 8; ++q) o[j * 8 + q] = siluf(a8[q]);
        }
        if (mi < 2) {
            float ss = 0.f;
#pragma unroll
            for (int q = 0; q < 32; ++q) ss += o[q] * o[q];
            ss += __shfl_xor(ss, 1); ss += __shfl_xor(ss, 2);
            const float sc = rsqrtf(ss + 1e-6f) * (mi == 0 ? 0.08838834764831845f : 1.f);
#pragma unroll
            for (int q = 0; q < 32; ++q) o[q] *= sc;
        }
        if (tok >= L) {
#pragma unroll
            for (int q = 0; q < 32; ++q) o[q] = 0.f;
        }
        bf16_t* dst = (mi == 0 ? Qn : (mi == 1 ? Kn : Vn)) + tok * 136 + qt * 32;
#pragma unroll
        for (int j = 0; j < 4; ++j) *(u32x4*)(dst + j * 8) = pack8(o + j * 8);
    }
    __syncthreads();
    {
        f32x4 a4[4], p4[4];
#pragma unroll
        for (int nt = 0; nt < 4; ++nt) { a4[nt] = (f32x4){0.f, 0.f, 0.f, 0.f}; p4[nt] = a4[nt]; }
#pragma unroll 1
        for (int kk = 0; kk < 4; ++kk) {
            const bf16x8 qf = ldfrag(Qn, 136, 16 * wid + fr, kk * 32 + fq * 8), ksf = ldfrag(Kn, 136, 16 * wid + fr, kk * 32 + fq * 8);
#pragma unroll
            for (int nt = 0; nt < 4; ++nt) { const bf16x8 kf = ldfrag(Kn, 136, 16 * nt + fr, kk * 32 + fq * 8); a4[nt] = mfma16(kf, ksf, a4[nt]); p4[nt] = mfma16(kf, qf, p4[nt]); }
        }
        const int s = 16 * wid + fr; const float gs = gam_s[s], bsv = beta_s[s];
#pragma unroll
        for (int nt = 0; nt < 4; ++nt) {
            f32x4 pv;
#pragma unroll
            for (int j = 0; j < 4; ++j) {
                const int r = 16 * nt + 4 * fq + j;
                const float d = (r <= s) ? __expf(gs - gam_s[r]) : 0.f;
                pv[j] = p4[nt][j] * d;
                AT[s * 65 + r] = (r < s) ? a4[nt][j] * d * bsv : 0.f;
            }
            if (s < L) *(u32x2*)(PB + (row0 + s) * 512 + hd * 64 + 16 * nt + 4 * fq) = pack4(pv);
        }
    }
    __syncthreads();
    if (tok < L) {
        const float eg = __expf(gam_s[tok]);
#pragma unroll
        for (int j = 0; j < 4; ++j) {
            float qf8[8]; unpack8(*(const u32x4*)(Qn + tok * 136 + qt * 32 + j * 8), qf8);
#pragma unroll
            for (int q = 0; q < 8; ++q) qf8[q] *= eg;
            *(u32x4*)(BIG + (row0 + tok) * 4096 + hd * 128 + qt * 32 + j * 8) = pack8(qf8);
        }
    }
    __syncthreads();
    {
        u32x4 kk4[4];
#pragma unroll
        for (int j = 0; j < 4; ++j) kk4[j] = *(const u32x4*)(Kn + tok * 136 + qt * 32 + j * 8);
        bf16_t* ktd = KTs + (qt * 32) * 72 + tok;
#pragma unroll
        for (int j = 0; j < 4; ++j) {
            const unsigned kw[4] = {kk4[j].x, kk4[j].y, kk4[j].z, kk4[j].w};
#pragma unroll
            for (int q = 0; q < 4; ++q) { ktd[(j * 8 + 2 * q) * 72] = (bf16_t)(kw[q] & 0xffffu); ktd[(j * 8 + 2 * q + 1) * 72] = (bf16_t)(kw[q] >> 16); }
        }
    }
    __syncthreads();
    {
        u32x4 vv4[4];
#pragma unroll
        for (int j = 0; j < 4; ++j) vv4[j] = *(const u32x4*)(Vn + tok * 136 + qt * 32 + j * 8);
        bf16_t* vtd = VTs + (qt * 32) * 72 + tok;
#pragma unroll
        for (int j = 0; j < 4; ++j) {
            const unsigned vw[4] = {vv4[j].x, vv4[j].y, vv4[j].z, vv4[j].w};
#pragma unroll
            for (int q = 0; q < 4; ++q) { vtd[(j * 8 + 2 * q) * 72] = (bf16_t)(vw[q] & 0xffffu); vtd[(j * 8 + 2 * q + 1) * 72] = (bf16_t)(vw[q] >> 16); }
        }
    }
    __syncthreads();
    if (wid == 0) {
        const int j = lane;
        for (int s = 0; s < 64; ++s) {
            float acc = (s == j) ? 1.f : 0.f;
            for (int r = 0; r < s; ++r) acc -= AT[s * 65 + r] * AT[r * 65 + j];
            AT[s * 65 + j] = acc;
        }
        const float bj = beta_s[j], bej = bj * __expf(gam_s[j]);
        for (int s = 0; s < 64; ++s) { const float t = AT[s * 65 + j]; Tv[s * 72 + j] = f2bf(t * bj); Tw[s * 72 + j] = f2bf(t * bej); }
    }
    __syncthreads();
    {
        const int s = 16 * wid + fr;
        const bf16x8 tw0 = ldfrag(Tw, 72, s, fq * 8), tw1 = ldfrag(Tw, 72, s, 32 + fq * 8), tv0 = ldfrag(Tv, 72, s, fq * 8), tv1 = ldfrag(Tv, 72, s, 32 + fq * 8);
#pragma unroll
        for (int nt = 0; nt < 8; ++nt) {
            f32x4 w4 = (f32x4){0.f, 0.f, 0.f, 0.f}, u4 = w4;
            w4 = mfma16(ldfrag(KTs, 72, 16 * nt + fr, fq * 8), tw0, w4); w4 = mfma16(ldfrag(KTs, 72, 16 * nt + fr, 32 + fq * 8), tw1, w4);
            u4 = mfma16(ldfrag(VTs, 72, 16 * nt + fr, fq * 8), tv0, u4); u4 = mfma16(ldfrag(VTs, 72, 16 * nt + fr, 32 + fq * 8), tv1, u4);
            if (s < L) {
                *(u32x2*)(Wb + (row0 + s) * 1024 + hd * 128 + 16 * nt + 4 * fq) = pack4(w4);
                *(u32x2*)(BIG + (row0 + s) * 4096 + 2048 + hd * 128 + 16 * nt + 4 * fq) = pack4(u4);
            }
        }
        const float gL = gam_s[L - 1];
#pragma unroll
        for (int i = 0; i < 4; ++i) {
            const int idx = tid + 256 * i, d = idx >> 3, r8 = idx & 7;
            if (r8 * 8 < L) {
                float kf[8]; unpack8(*(const u32x4*)(KTs + d * 72 + r8 * 8), kf);
#pragma unroll
                for (int q = 0; q < 8; ++q) kf[q] *= __expf(gL - gam_s[r8 * 8 + q]);
                const int e = d * L + r8 * 8;
                *(u32x4*)(BIG + (row0 + (e >> 7)) * 4096 + 1024 + hd * 128 + (e & 127)) = pack8(kf);
            }
        }
        if ((smp || c == 63) && tid < 144) {
            const int i = tid / 48, rem = tid % 48, col = (rem >> 4) * 1024 + hd * 128 + (rem & 15) * 8;
            float f[8]; unpack8(*(const u32x4*)(halo + ((size_t)unit * 3 + i) * 3072 + col), f);
            float* dst = smp ? p.out + OFF_SGC + ((size_t)s_ * 3 + i) * 3072 + col : p.out + OFF_PGC + ((size_t)(unit >> 6) * 3 + i) * 3072 + col;
            *(float4*)dst = make_float4(f[0], f[1], f[2], f[3]); *(float4*)(dst + 4) = make_float4(f[4], f[5], f[6], f[7]);
        }
    }
}

#define S_W   0
#define S_Q   17408
#define S_KT  34816
#define S_P   53248
#define S_UT  62464
#define S_ST  64768
DI void gdn_chain(const Params& p, bf16_t* BIG, const bf16_t* Wb, const bf16_t* PB, const float* egl, int b, int hd, int es, bool smp, char* smem) {
    const int tid = threadIdx.x, wid = tid >> 6, lane = tid & 63, fr = lane & 15, fq = lane >> 4;
    bf16_t* Ws = (bf16_t*)(smem + S_W); bf16_t* Qs = (bf16_t*)(smem + S_Q); bf16_t* KTs = (bf16_t*)(smem + S_KT); bf16_t* Ps = (bf16_t*)(smem + S_P);
    bf16_t* UTs = (bf16_t*)(smem + S_UT); bf16_t* STs = (bf16_t*)(smem + S_ST);
    const int L = smp ? 16 : 64, nch = smp ? 1 : 64, sidx = b * 8 + hd;
    const size_t row0 = smp ? (size_t)NPR + b * 16 : (size_t)b * 4096;
    f32x4 accS[2];
    accS[0] = (f32x4){0.f, 0.f, 0.f, 0.f}; accS[1] = accS[0];
    if (smp) {
        const float* S0 = p.in[7] + (size_t)sidx * 128 * 128;
#pragma unroll
        for (int mt = 0; mt < 2; ++mt)
#pragma unroll
            for (int j = 0; j < 4; ++j) accS[mt][j] = S0[(size_t)(32 * wid + 16 * mt + 4 * fq + j) * 128 + es * 16 + fr];
    }
    __syncthreads();
#pragma unroll
    for (int mt = 0; mt < 2; ++mt) *(u32x2*)(STs + fr * 136 + 32 * wid + 16 * mt + 4 * fq) = pack4(accS[mt]);
    u32x4 wv[4], qv[4], ktv[4], pv[2]; u32x2 u0; float eg = 1.f;
    auto load = [&](int c) __attribute__((always_inline)) {
        const size_t r0 = row0 + (size_t)c * 64;
{
            const int r = tid >> 2, qt = tid & 3, d = tid >> 1, half = tid & 1, rc = r < L ? r : L - 1;
            const bf16_t* wp = Wb + (r0 + rc) * 1024 + hd * 128 + qt * 32;
            const bf16_t* qp = BIG + (r0 + rc) * 4096 + hd * 128 + qt * 32;
            const bf16_t* pp = PB + (r0 + rc) * 512 + hd * 64 + qt * 16;
#pragma unroll
            for (int i = 0; i < 4; ++i) {
                wv[i] = *(const u32x4*)(wp + i * 8); qv[i] = *(const u32x4*)(qp + i * 8);
                if (r >= L) { wv[i] = (u32x4){0u, 0u, 0u, 0u}; qv[i] = (u32x4){0u, 0u, 0u, 0u}; }
                const int rr = half * 32 + i * 8, rrc = rr < L ? rr : 0;
                const int e = d * L + rrc;
                ktv[i] = *(const u32x4*)(BIG + (r0 + (e >> 7)) * 4096 + 1024 + hd * 128 + (e & 127));
                if (rr >= L) ktv[i] = (u32x4){0u, 0u, 0u, 0u};
            }
#pragma unroll
            for (int i = 0; i < 2; ++i) { pv[i] = *(const u32x4*)(pp + i * 8); if (r >= L) pv[i] = (u32x4){0u, 0u, 0u, 0u}; }
        }
        const int s = 16 * wid + fr, sc_ = s < L ? s : L - 1;
        u0 = *(const u32x2*)(BIG + (r0 + sc_) * 4096 + 2048 + hd * 128 + es * 16 + 4 * fq);
        if (s >= L) u0 = (u32x2){0u, 0u};
        eg = egl[(smp ? 256 + b : b * 64 + c) * 8 + hd];
    };
    load(0);
    for (int c = 0; c < nch; ++c) {
        __syncthreads();
{
            const int r = tid >> 2, qt = tid & 3, d = tid >> 1, half = tid & 1;
#pragma unroll
            for (int i = 0; i < 4; ++i) {
                *(u32x4*)(Ws + r * 136 + qt * 32 + i * 8) = wv[i]; *(u32x4*)(Qs + r * 136 + qt * 32 + i * 8) = qv[i];
                *(u32x4*)(KTs + d * 72 + half * 32 + i * 8) = ktv[i];
            }
#pragma unroll
            for (int i = 0; i < 2; ++i) *(u32x4*)(Ps + r * 72 + qt * 16 + i * 8) = pv[i];
        }
        const u32x2 u0c = u0; const float egc = eg;
        if (c + 1 < nch) load(c + 1);
        __syncthreads();
        const int s = 16 * wid + fr;
        {
            f32x4 w4 = (f32x4){0.f, 0.f, 0.f, 0.f};
#pragma unroll
            for (int kk = 0; kk < 4; ++kk) w4 = mfma16(ldfrag(STs, 136, fr, kk * 32 + fq * 8), ldfrag(Ws, 136, s, kk * 32 + fq * 8), w4);
            const float uf[4] = {lo2f(u0c.x) - w4[0], hi2f(u0c.x) - w4[1], lo2f(u0c.y) - w4[2], hi2f(u0c.y) - w4[3]};
#pragma unroll
            for (int j = 0; j < 4; ++j) UTs[(4 * fq + j) * 72 + s] = f2bf(uf[j]);
        }
        __syncthreads();
        {
            f32x4 o4 = (f32x4){0.f, 0.f, 0.f, 0.f};
#pragma unroll
            for (int kk = 0; kk < 4; ++kk) o4 = mfma16(ldfrag(STs, 136, fr, kk * 32 + fq * 8), ldfrag(Qs, 136, s, kk * 32 + fq * 8), o4);
#pragma unroll
            for (int kk = 0; kk < 2; ++kk) o4 = mfma16(ldfrag(UTs, 72, fr, kk * 32 + fq * 8), ldfrag(Ps, 72, s, kk * 32 + fq * 8), o4);
            if (s < L) *(u32x2*)(BIG + (row0 + (size_t)c * 64 + s) * 4096 + 2048 + hd * 128 + es * 16 + 4 * fq) = pack4(o4);
#pragma unroll
            for (int mt = 0; mt < 2; ++mt) {
                accS[mt] *= egc;
#pragma unroll
                for (int kk = 0; kk < 2; ++kk) accS[mt] = mfma16(ldfrag(KTs, 72, 32 * wid + 16 * mt + fr, kk * 32 + fq * 8), ldfrag(UTs, 72, fr, kk * 32 + fq * 8), accS[mt]);
            }
        }
        __syncthreads();
#pragma unroll
        for (int mt = 0; mt < 2; ++mt) *(u32x2*)(STs + fr * 136 + 32 * wid + 16 * mt + 4 * fq) = pack4(accS[mt]);
    }
    float* So = p.out + (smp ? OFF_SG : OFF_PG) + (size_t)sidx * 128 * 128;
#pragma unroll
    for (int mt = 0; mt < 2; ++mt)
#pragma unroll
        for (int j = 0; j < 4; ++j) So[(size_t)(32 * wid + 16 * mt + 4 * fq + j) * 128 + es * 16 + fr] = accS[mt][j];
}

DI void phase_post_l1(const Params& p, bf16_t* BIG) {
    const int lane = threadIdx.x & 63, gw = blockIdx.x * 4 + (threadIdx.x >> 6), nw = gridDim.x * 4;
    const int hd = lane >> 3, e0 = (lane & 7) * 16;
    for (int row = gw; row < NTOK; row += nw) {
        bf16_t* op = BIG + (size_t)row * 4096 + 2048 + hd * 128 + e0;
        const bf16_t* zp = BIG + (size_t)row * 4096 + 3072 + hd * 128 + e0;
        float x[16], z[16];
        unpack8(*(const u32x4*)op, x); unpack8(*(const u32x4*)(op + 8), x + 8);
        unpack8(*(const u32x4*)zp, z); unpack8(*(const u32x4*)(zp + 8), z + 8);
        float ss = 0.f;
#pragma unroll
        for (int j = 0; j < 16; ++j) ss += x[j] * x[j];
        ss += __shfl_xor(ss, 1); ss += __shfl_xor(ss, 2); ss += __shfl_xor(ss, 4);
        const float r = rsqrtf(ss * (1.f / 128.f) + 1e-6f);
        float y[16];
#pragma unroll
        for (int j = 0; j < 16; ++j) y[j] = x[j] * r * p.in[30][e0 + j] * siluf(z[j]);
        *(u32x4*)op = pack8(y); *(u32x4*)(op + 8) = pack8(y + 8);
    }
}

__global__ void __launch_bounds__(256, 2) fwd_megakernel(Params p) {
    __shared__ __attribute__((aligned(16))) char smem[LDS_BYTES];
    cg::grid_group grid = cg::this_grid();
    char* ws = p.ws;
    bf16_t* WGU = (bf16_t*)(ws + WS_WGU); bf16_t* WD = (bf16_t*)(ws + WS_WD); bf16_t* WIN = (bf16_t*)(ws + WS_WIN); bf16_t* WOUT = (bf16_t*)(ws + WS_WOUT);
    bf16_t* H = (bf16_t*)(ws + WS_H); bf16_t* BIG = (bf16_t*)(ws + WS_BIG); float* GATES = (float*)(ws + WS_GATES); bf16_t* HALO = (bf16_t*)(ws + WS_HALO); float* EGL = (float*)(ws + WS_EGL);
    bf16_t* PB = BIG + (size_t)NTOK * 4096;
    float* X = p.out; float* XS = p.out + (size_t)NPR * 1024;
    const float* ng = p.in[9];
    const size_t FW = (size_t)1024 * 2816;
    Epi e{};
    phase_norm(p.in[0], p.in[1], ng, H);
    cvt_job(p.in[11], 1024, 2816, WGU, 1, 0, smem);
    cvt_job(p.in[12], 1024, 2816, WGU, 2, 100, smem);
    cvt_job(p.in[13], 2816, 1024, WD, 0, 200, smem);
    cvt_job(p.in[14], 1024, 5656, WIN, 3, 300, smem);
    cvt_job(p.in[15], 2048, 1024, WOUT, 0, 400, smem);
    grid.sync();
    e.o16 = BIG; e.ldc = 2816;
    gemm_phase<EPI_GU>(H, 1024, WGU, 1024, 44, e, smem);
    grid.sync();
    e.o32 = X; e.rp = p.in[0]; e.rs = p.in[1]; e.scale = 0.5f;
    gemm_phase<EPI_RES>(BIG, 2816, WD, 2816, 8, e, smem);
    grid.sync();
    phase_norm(X, XS, ng + 1024, H);
    cvt_job(p.in[11] + FW, 1024, 2816, WGU, 1, 0, smem);
    cvt_job(p.in[12] + FW, 1024, 2816, WGU, 2, 100, smem);
    cvt_job(p.in[13] + FW, 2816, 1024, WD, 0, 200, smem);
    grid.sync();
    e.o16 = BIG; e.ldc = 5632; e.gates = GATES; e.halo = HALO; e.cv0 = 4096; e.cv1 = 5632;
    gemm_phase<EPI_PROJ>(H, 1024, WIN, 1024, 45, e, smem);
    grid.sync();
#if PHM & 1
    phase_conv_ssd(p, BIG, HALO);
#endif
    grid.sync();
#if PHM & 2
    phase_scan_l0(p, BIG, GATES, smem);
#endif
    grid.sync();
    phase_post_l0(p, BIG);
    grid.sync();
    e.o32 = X; e.rp = X; e.rs = XS; e.scale = 1.0f;
    gemm_phase<EPI_RES>(BIG + 1024, 5632, WOUT, 2048, 8, e, smem);
    grid.sync();
    phase_norm(X, XS, ng + 2048, H);
    grid.sync();
    e.o16 = BIG; e.ldc = 2816;
    gemm_phase<EPI_GU>(H, 1024, WGU, 1024, 44, e, smem);
    grid.sync();
    e.scale = 0.5f;
    gemm_phase<EPI_RES>(BIG, 2816, WD, 2816, 8, e, smem);
    grid.sync();
    phase_norm(X, XS, ng + 3072, H);
    cvt_job(p.in[11] + 2 * FW, 1024, 2816, WGU, 1, 0, smem);
    cvt_job(p.in[12] + 2 * FW, 1024, 2816, WGU, 2, 100, smem);
    cvt_job(p.in[13] + 2 * FW, 2816, 1024, WD, 0, 200, smem);
    cvt_job(p.in[25], 1024, 4112, WIN, 0, 300, smem);
    cvt_job(p.in[26], 1024, 1024, WOUT, 0, 400, smem);
    grid.sync();
    gemm_phase<EPI_GU>(H, 1024, WGU, 1024, 44, e, smem);
    grid.sync();
    gemm_phase<EPI_RES>(BIG, 2816, WD, 2816, 8, e, smem);
    grid.sync();
    phase_norm(X, XS, ng + 4096, H);
    fill_cache_halo(p.in[8], 3072, HALO);
    cvt_job(p.in[11] + 3 * FW, 1024, 2816, WGU, 1, 0, smem);
    cvt_job(p.in[12] + 3 * FW, 1024, 2816, WGU, 2, 100, smem);
    cvt_job(p.in[13] + 3 * FW, 2816, 1024, WD, 0, 200, smem);
    grid.sync();
    e.o16 = BIG; e.ldc = 4096; e.cv0 = 0; e.cv1 = 3072;
    gemm_phase<EPI_PROJ>(H, 1024, WIN, 1024, 33, e, smem);
    grid.sync();
#if PHM & 4
    for (int it = blockIdx.x; it < 264 * 8; it += gridDim.x) gdn_g1_item(p, BIG, H, PB, GATES, HALO, EGL, it >> 3, it & 7, smem);
#endif
    grid.sync();
#if PHM & 8
    for (int it = blockIdx.x; it < 768; it += gridDim.x) {
        const bool smp = it >= 256; const int j = smp ? it - 256 : it;
        gdn_chain(p, BIG, H, PB, EGL, j >> 6, (j >> 3) & 7, j & 7, smp, smem);
    }
#endif
    grid.sync();
    phase_post_l1(p, BIG);
    grid.sync();
    e.scale = 1.0f;
    gemm_phase<EPI_RES>(BIG + 2048, 4096, WOUT, 1024, 8, e, smem);
    grid.sync();
    phase_norm(X, XS, ng + 5120, H);
    grid.sync();
    e.o16 = BIG; e.ldc = 2816;
    gemm_phase<EPI_GU>(H, 1024, WGU, 1024, 44, e, smem);
    grid.sync();
    e.scale = 0.5f;
    gemm_phase<EPI_RES>(BIG, 2816, WD, 2816, 8, e, smem);
    grid.sync();
    phase_final_norm(X, p.in[10]);
}

extern "C" void kernel_launch(void* const* d_in, const int* in_sizes, int n_in, void* d_out, int out_size, void* d_ws, size_t ws_size, hipStream_t stream) {
    static int grid_blocks = 0;
    if (!grid_blocks) {
        int dev = 0, cus = 0, per_cu = 0;
        hipGetDevice(&dev);
        hipDeviceGetAttribute(&cus, hipDeviceAttributeMultiprocessorCount, dev);
        hipOccupancyMaxActiveBlocksPerMultiprocessor(&per_cu, fwd_megakernel, 256, 0);
        if (per_cu > 2) per_cu = 2;
        if (per_cu < 1) per_cu = 1;
        grid_blocks = cus * per_cu;
    }
    Params p{};
    for (int i = 0; i < 31; ++i) p.in[i] = (const float*)d_in[i];
    p.out = (float*)d_out;
    p.ws = (char*)d_ws;
    void* args[] = {&p};
    hipError_t err = hipLaunchCooperativeKernel((void*)fwd_megakernel, dim3(grid_blocks), dim3(256), args, 0, stream);
    if (err != hipSuccess) fprintf(stderr, "cooperative launch failed: %s (grid %d)\n", hipGetErrorString(err), grid_blocks);
}
```

```cpp
#include <hip/hip_runtime.h>
#include <hip/hip_cooperative_groups.h>
#include <cstdio>
namespace cg = cooperative_groups;

typedef unsigned short bf16_t;
typedef short bf16x8 __attribute__((ext_vector_type(8)));
typedef float f32x4 __attribute__((ext_vector_type(4)));
typedef unsigned u32x2 __attribute__((ext_vector_type(2)));
typedef unsigned u32x4 __attribute__((ext_vector_type(4)));

#define DI __device__ __forceinline__
#define NTOK 16512
#define NPR 16384
#define LDS_BYTES 75776
#ifndef PHM
#define PHM 15
#endif

#define WS_WGU   0ull
#define WS_WD    (WS_WGU + 5632ull * 1024 * 2)
#define WS_WIN   (WS_WD + 1024ull * 2816 * 2)
#define WS_WOUT  (WS_WIN + 5760ull * 1024 * 2)
#define WS_H     (WS_WOUT + 1024ull * 2048 * 2)
#define WS_BIG   (WS_H + 16512ull * 1024 * 2)
#define WS_GATES (WS_BIG + 16512ull * 5632 * 2)
#define WS_HALO  (WS_GATES + 16512ull * 32 * 4)
#define WS_EGL   (WS_HALO + 272ull * 3 * 3072 * 2)
#define WS_END   (WS_EGL + 264ull * 8 * 4)

struct Params {
    const float* in[31];
    float* out;
    char* ws;
};

DI int get_tid() { int t = threadIdx.x; asm volatile("" : "+v"(t)); return t; }
DI bf16_t f2bf(float f) { unsigned u = __float_as_uint(f); u += 0x7fffu + ((u >> 16) & 1u); return (bf16_t)(u >> 16); }
DI float bf2f(bf16_t h) { return __uint_as_float(((unsigned)h) << 16); }
DI unsigned pack2(float lo, float hi) { return (unsigned)f2bf(lo) | ((unsigned)f2bf(hi) << 16); }
DI float lo2f(unsigned u) { return __uint_as_float(u << 16); }
DI float hi2f(unsigned u) { return __uint_as_float(u & 0xffff0000u); }
DI float siluf(float x) { return x / (1.f + __expf(-x)); }
DI float sigmf(float x) { return 1.f / (1.f + __expf(-x)); }
DI float softplusf(float x) { return fmaxf(x, 0.f) + log1pf(__expf(-fabsf(x))); }
DI f32x4 mfma16(bf16x8 a, bf16x8 b, f32x4 c) { return __builtin_amdgcn_mfma_f32_16x16x32_bf16(a, b, c, 0, 0, 0); }
DI bf16x8 ldfrag(const bf16_t* base, int ld, int row, int k) { return *(const bf16x8*)(base + row * ld + k); }
DI void unpack8(u32x4 v, float* f) {
    f[0] = lo2f(v.x); f[1] = hi2f(v.x); f[2] = lo2f(v.y); f[3] = hi2f(v.y);
    f[4] = lo2f(v.z); f[5] = hi2f(v.z); f[6] = lo2f(v.w); f[7] = hi2f(v.w);
}
DI float wave_sum(float v) {
#pragma unroll
    for (int o = 32; o >= 1; o >>= 1) v += __shfl_xor(v, o);
    return v;
}

DI void phase_norm(const float* xp, const float* xs, const float* g, bf16_t* h) {
    const int tid_ = get_tid(), lane = tid_ & 63, gw = blockIdx.x * 4 + (tid_ >> 6), nw = gridDim.x * 4;
    for (int row = gw; row < NTOK; row += nw) {
        const float* src = row < NPR ? xp + (size_t)row * 1024 : xs + (size_t)(row - NPR) * 1024;
        float4 v[4]; float ss = 0.f;
#pragma unroll
        for (int i = 0; i < 4; ++i) { v[i] = *(const float4*)(src + i * 256 + lane * 4); ss += v[i].x * v[i].x + v[i].y * v[i].y + v[i].z * v[i].z + v[i].w * v[i].w; }
        ss = wave_sum(ss);
        const float r = rsqrtf(ss * (1.f / 1024.f) + 1e-6f);
#pragma unroll
        for (int i = 0; i < 4; ++i) {
            const float4 gg = *(const float4*)(g + i * 256 + lane * 4);
            u32x2 o; o.x = pack2(v[i].x * r * gg.x, v[i].y * r * gg.y); o.y = pack2(v[i].z * r * gg.z, v[i].w * r * gg.w);
            *(u32x2*)(h + (size_t)row * 1024 + i * 256 + lane * 4) = o;
        }
    }
}
DI void phase_final_norm(float* x, const float* g) {
    const int tid_ = get_tid(), lane = tid_ & 63, gw = blockIdx.x * 4 + (tid_ >> 6), nw = gridDim.x * 4;
    for (int row = gw; row < NTOK; row += nw) {
        float* src = x + (size_t)row * 1024;
        float4 v[4]; float ss = 0.f;
#pragma unroll
        for (int i = 0; i < 4; ++i) { v[i] = *(const float4*)(src + i * 256 + lane * 4); ss += v[i].x * v[i].x + v[i].y * v[i].y + v[i].z * v[i].z + v[i].w * v[i].w; }
        ss = wave_sum(ss);
        const float r = rsqrtf(ss * (1.f / 1024.f) + 1e-6f);
#pragma unroll
        for (int i = 0; i < 4; ++i) {
            const float4 gg = *(const float4*)(g + i * 256 + lane * 4);
            float4 o; o.x = v[i].x * r * gg.x; o.y = v[i].y * r * gg.y; o.z = v[i].z * r * gg.z; o.w = v[i].w * r * gg.w;
            *(float4*)(src + i * 256 + lane * 4) = o;
        }
    }
}

DI int map_row(int mode, int n) {
    if (mode == 0) return n;
    if (mode == 1) return ((n >> 4) << 5) + (n & 15);
    if (mode == 2) return ((n >> 4) << 5) + 16 + (n & 15);
    if (n < 2048) return n;
    if (n < 3072) return n + 1024;
    if (n < 3080) return n - 3072 + 5632;
    if (n < 4104) return n - 3080 + 2048;
    if (n < 5640) return n - 4104 + 4096;
    return n;
}
DI void cvt_job(const float* src, int K, int N, bf16_t* dst, int mode, int rot, char* smem) {
    float* tile = (float*)smem;
    const int tid = get_tid(), nkt = K >> 6, nnt = (N + 63) >> 6, ntiles = nkt * nnt;
    for (int t = (int)((blockIdx.x + rot) % gridDim.x); t < ntiles; t += gridDim.x) {
        const int kt = t % nkt, nt = t / nkt;
        __syncthreads();
#pragma unroll
        for (int i = 0; i < 4; ++i) {
            const int kl = (tid >> 4) + 16 * i, nl = (tid & 15) * 4, n = nt * 64 + nl;
            float4 v = make_float4(0.f, 0.f, 0.f, 0.f);
            if (n < N) v = *(const float4*)(src + (size_t)(kt * 64 + kl) * N + n);
            tile[kl * 65 + nl] = v.x; tile[kl * 65 + nl + 1] = v.y; tile[kl * 65 + nl + 2] = v.z; tile[kl * 65 + nl + 3] = v.w;
        }
        __syncthreads();
        const int nl = tid >> 2, kq = (tid & 3) * 16, n = nt * 64 + nl;
        if (n < N) {
            u32x4 o0, o1;
            o0.x = pack2(tile[(kq + 0) * 65 + nl], tile[(kq + 1) * 65 + nl]);   o0.y = pack2(tile[(kq + 2) * 65 + nl], tile[(kq + 3) * 65 + nl]);
            o0.z = pack2(tile[(kq + 4) * 65 + nl], tile[(kq + 5) * 65 + nl]);   o0.w = pack2(tile[(kq + 6) * 65 + nl], tile[(kq + 7) * 65 + nl]);
            o1.x = pack2(tile[(kq + 8) * 65 + nl], tile[(kq + 9) * 65 + nl]);   o1.y = pack2(tile[(kq + 10) * 65 + nl], tile[(kq + 11) * 65 + nl]);
            o1.z = pack2(tile[(kq + 12) * 65 + nl], tile[(kq + 13) * 65 + nl]); o1.w = pack2(tile[(kq + 14) * 65 + nl], tile[(kq + 15) * 65 + nl]);
            bf16_t* d = dst + (size_t)map_row(mode, n) * K + kt * 64 + kq;
            *(u32x4*)d = o0; *(u32x4*)(d + 8) = o1;
        }
    }
    __syncthreads();
}

struct Epi {
    bf16_t* o16; int ldc;
    float* o32;
    const float* rp; const float* rs; float scale;
    float* gates; bf16_t* halo; int cv0, cv1;
};
enum { EPI_GU = 0, EPI_RES = 1, EPI_PROJ = 2 };

template <int EPI>
DI void gemm_phase(const bf16_t* A, int lda, const bf16_t* Bt, int K, int nN, const Epi& e, char* smem) {
    const int tid = get_tid(), wid = tid >> 6, lane = tid & 63, wr = wid >> 1, wc = wid & 1, fr = lane & 15, fq = lane >> 4;
    const int G8 = gridDim.x >> 3, full = 8 * nN, ntiles = 129 * nN;
    for (int i = 0;; ++i) {
        const int Lt = (i * 8 + ((int)blockIdx.x & 7)) * G8 + ((int)blockIdx.x >> 3);
        if (i * (int)gridDim.x >= ntiles) break;
        if (Lt >= ntiles) continue;
        const int srow = Lt / full, rem = Lt - srow * full, hgt = (srow == 16) ? 1 : 8;
        const int scol = rem / (hgt * 8), rem2 = rem - scol * hgt * 8;
        const int pm = srow * 8 + rem2 % hgt, pn = scol * 8 + rem2 / hgt;
        f32x4 acc[4][4];
#pragma unroll
        for (int n = 0; n < 4; ++n)
#pragma unroll
            for (int m = 0; m < 4; ++m) acc[n][m] = (f32x4){0.f, 0.f, 0.f, 0.f};
        const bf16_t* Ab = A + (size_t)(pm * 128) * lda;
        const bf16_t* Bb = Bt + (size_t)(pn * 128) * K;
        const int nk = K >> 6;
        const int sr = tid >> 3, sgc = ((tid & 7) ^ (sr & 7)) * 8;
        const bf16_t* ap = Ab + (size_t)sr * lda + sgc;
        const bf16_t* bp = Bb + (size_t)sr * K + sgc;
        const size_t a32 = (size_t)32 * lda, b32 = (size_t)32 * K;
        __attribute__((address_space(3))) char* lbase = (__attribute__((address_space(3))) char*)smem + tid * 16;
#define GEMM_STAGE(BUF)                                                                                                         \
        {                                                                                                                        \
            _Pragma("unroll") for (int ii = 0; ii < 4; ++ii) {                                                                   \
                __builtin_amdgcn_global_load_lds((const unsigned*)(ap + ii * a32), (__attribute__((address_space(3))) unsigned*)(lbase + (BUF) * 32768 + ii * 4096), 16, 0, 0);          \
                __builtin_amdgcn_global_load_lds((const unsigned*)(bp + ii * b32), (__attribute__((address_space(3))) unsigned*)(lbase + (BUF) * 32768 + 16384 + ii * 4096), 16, 0, 0);  \
            }                                                                                                                    \
            ap += 64; bp += 64;                                                                                                  \
        }
#define GEMM_COMPUTE(BUF)                                                                                                       \
        {                                                                                                                        \
            const char* SA = smem + (BUF) * 32768; const char* SB = SA + 16384;                                                  \
            _Pragma("unroll") for (int ks = 0; ks < 2; ++ks) {                                                                   \
                bf16x8 af[4], bf[4];                                                                                             \
                const int sw = ((ks * 4 + fq) ^ (fr & 7)) << 4;                                                                  \
                _Pragma("unroll") for (int m = 0; m < 4; ++m) af[m] = *(const bf16x8*)(SA + (wr * 64 + m * 16 + fr) * 128 + sw); \
                _Pragma("unroll") for (int n = 0; n < 4; ++n) bf[n] = *(const bf16x8*)(SB + (wc * 64 + n * 16 + fr) * 128 + sw); \
                _Pragma("unroll") for (int n = 0; n < 4; ++n)                                                                    \
                    _Pragma("unroll") for (int m = 0; m < 4; ++m) acc[n][m] = mfma16(bf[n], af[m], acc[n][m]);                   \
            }                                                                                                                    \
        }
        __syncthreads();
        GEMM_STAGE(0)
        for (int kt = 0; kt < nk; kt += 2) {
            asm volatile("s_waitcnt vmcnt(0)" ::: "memory");
            __syncthreads();
            GEMM_STAGE(1)
            GEMM_COMPUTE(0)
            asm volatile("s_waitcnt vmcnt(0)" ::: "memory");
            __syncthreads();
            if (kt + 2 < nk) GEMM_STAGE(0)
            GEMM_COMPUTE(1)
        }
#pragma unroll
        for (int m = 0; m < 4; ++m) {
            const int row = pm * 128 + wr * 64 + m * 16 + fr;
            if (EPI == EPI_GU) {
#pragma unroll
                for (int i = 0; i < 2; ++i) {
                    const f32x4 g = acc[2 * i][m], u = acc[2 * i + 1][m];
                    u32x2 o; o.x = pack2(siluf(g[0]) * u[0], siluf(g[1]) * u[1]); o.y = pack2(siluf(g[2]) * u[2], siluf(g[3]) * u[3]);
                    *(u32x2*)(e.o16 + (size_t)row * e.ldc + pn * 64 + wc * 32 + i * 16 + 4 * fq) = o;
                }
            } else if (EPI == EPI_RES) {
                const float* rsrc = row < NPR ? e.rp + (size_t)row * 1024 : e.rs + (size_t)(row - NPR) * 1024;
#pragma unroll
                for (int n = 0; n < 4; ++n) {
                    const int col = pn * 128 + wc * 64 + n * 16 + 4 * fq;
                    const float4 r4 = *(const float4*)(rsrc + col);
                    float4 o; o.x = r4.x + e.scale * acc[n][m][0]; o.y = r4.y + e.scale * acc[n][m][1]; o.z = r4.z + e.scale * acc[n][m][2]; o.w = r4.w + e.scale * acc[n][m][3];
                    *(float4*)(e.o32 + (size_t)row * 1024 + col) = o;
                }
            } else {
                if (pn < nN - 1) {
                    int hr, unit;
                    if (row < NPR) { hr = (row & 63) - 61; unit = row >> 6; } else { hr = ((row - NPR) & 15) - 13; unit = 256 + ((row - NPR) >> 4); }
#pragma unroll
                    for (int n = 0; n < 4; ++n) {
                        const int col = pn * 128 + wc * 64 + n * 16 + 4 * fq;
                        u32x2 o; o.x = pack2(acc[n][m][0], acc[n][m][1]); o.y = pack2(acc[n][m][2], acc[n][m][3]);
                        *(u32x2*)(e.o16 + (size_t)row * e.ldc + col) = o;
                        if (hr >= 0 && col >= e.cv0 && col < e.cv1) *(u32x2*)(e.halo + ((size_t)unit * 3 + hr) * 3072 + (col - e.cv0)) = o;
                    }
                } else if (wc == 0) {
#pragma unroll
                    for (int n = 0; n < 2; ++n) {
                        float4 o; o.x = acc[n][m][0]; o.y = acc[n][m][1]; o.z = acc[n][m][2]; o.w = acc[n][m][3];
                        *(float4*)(e.gates + (size_t)row * 32 + n * 16 + 4 * fq) = o;
                    }
                }
            }
        }
    }
}


#define OFF_YS   16777216
#define OFF_PC   16908288
#define OFF_PN   17432576
#define OFF_PM   17434624
#define OFF_PSSD 17434640
#define OFF_PSC  17958928
#define OFF_PG   17977360
#define OFF_PGC  18501648
#define OFF_SC   18538512
#define OFF_SN   19587088
#define OFF_SM   19591184
#define OFF_SSSD 19591216
#define OFF_SSC  20639792
#define OFF_SG   20676656
#define OFF_SGC  21725232

DI float scan_add(float v, int lane) {
#pragma unroll
    for (int o = 1; o < 64; o <<= 1) { const float t = __shfl_up(v, o); if (lane >= o) v += t; }
    return v;
}
DI float scan_max(float v, int lane) {
#pragma unroll
    for (int o = 1; o < 64; o <<= 1) { const float t = __shfl_up(v, o); if (lane >= o) v = fmaxf(v, t); }
    return v;
}
DI u32x2 pack4(f32x4 v) { u32x2 o; o.x = pack2(v[0], v[1]); o.y = pack2(v[2], v[3]); return o; }
DI u32x4 pack8(const float* f) { u32x4 o; o.x = pack2(f[0], f[1]); o.y = pack2(f[2], f[3]); o.z = pack2(f[4], f[5]); o.w = pack2(f[6], f[7]); return o; }

DI void fill_cache_halo(const float* cache, int width, bf16_t* halo) {
    for (int i = blockIdx.x * 256 + get_tid(); i < 8 * 3 * width; i += gridDim.x * 256) {
        const int s = i / (3 * width), rem = i % (3 * width), r = rem / width, col = rem % width;
        halo[((size_t)(264 + s) * 3 + r) * 3072 + col] = f2bf(cache[i]);
    }
}

DI void phase_conv_ssd(const Params& p, bf16_t* BIG, const bf16_t* halo) {
    const int tid = get_tid(), cv = tid & 31, tg = tid >> 5;
    const float* cw = p.in[19]; const float* cb = p.in[20];
    for (int it = blockIdx.x; it < 264 * 6; it += gridDim.x) {
        const int unit = it / 6, cblk = it % 6, col = cblk * 256 + cv * 8;
        const bool smp = unit >= 256;
        const int L = smp ? 16 : 64, c = unit & 63, s = unit - 256;
        const size_t row0 = smp ? (size_t)NPR + s * 16 : (size_t)unit * 64;
        const bool act = tg * 8 < L;
        float x[11][8];
        if (act) {
#pragma unroll
            for (int i = 0; i < 11; ++i) {
                const int rl = tg * 8 - 3 + i;
                if (rl >= 0) { const u32x4 v = *(const u32x4*)(BIG + (row0 + rl) * 5632 + 4096 + col); unpack8(v, x[i]); }
                else if (!smp) {
                    if (c == 0) {
#pragma unroll
                        for (int j = 0; j < 8; ++j) x[i][j] = 0.f;
                    } else { const u32x4 v = *(const u32x4*)(halo + ((size_t)(unit - 1) * 3 + (rl + 3)) * 3072 + col); unpack8(v, x[i]); }
                } else {
                    const float* src = p.in[6] + ((size_t)s * 3 + (rl + 3)) * 1536 + col;
                    const float4 a = *(const float4*)src, b = *(const float4*)(src + 4);
                    x[i][0] = a.x; x[i][1] = a.y; x[i][2] = a.z; x[i][3] = a.w; x[i][4] = b.x; x[i][5] = b.y; x[i][6] = b.z; x[i][7] = b.w;
                }
            }
        }
        __syncthreads();
        if (act) {
            float w[4][8], bb[8];
#pragma unroll
            for (int i = 0; i < 4; ++i) {
                const float4 a = *(const float4*)(cw + i * 1536 + col), b = *(const float4*)(cw + i * 1536 + col + 4);
                w[i][0] = a.x; w[i][1] = a.y; w[i][2] = a.z; w[i][3] = a.w; w[i][4] = b.x; w[i][5] = b.y; w[i][6] = b.z; w[i][7] = b.w;
            }
            { const float4 a = *(const float4*)(cb + col), b = *(const float4*)(cb + col + 4);
              bb[0] = a.x; bb[1] = a.y; bb[2] = a.z; bb[3] = a.w; bb[4] = b.x; bb[5] = b.y; bb[6] = b.z; bb[7] = b.w; }
#pragma unroll
            for (int t = 0; t < 8; ++t) {
                float o[8];
#pragma unroll
                for (int j = 0; j < 8; ++j) { const float a = bb[j] + w[0][j] * x[t][j] + w[1][j] * x[t + 1][j] + w[2][j] * x[t + 2][j] + w[3][j] * x[t + 3][j]; o[j] = siluf(a); }
                *(u32x4*)(BIG + (row0 + tg * 8 + t) * 5632 + 4096 + col) = pack8(o);
            }
        }
        if ((smp || c == 63) && tid < 96) {
            const int i = tid >> 5;
            float f[8]; unpack8(*(const u32x4*)(halo + ((size_t)unit * 3 + i) * 3072 + col), f);
            float* dst = smp ? p.out + OFF_SSC + ((size_t)s * 3 + i) * 1536 + col : p.out + OFF_PSC + ((size_t)(unit >> 6) * 3 + i) * 1536 + col;
            *(float4*)dst = make_float4(f[0], f[1], f[2], f[3]); *(float4*)(dst + 4) = make_float4(f[4], f[5], f[6], f[7]);
        }
        __syncthreads();
    }
}

#define L_Q   0
#define L_K   17408
#define L_KT  34816
#define L_VT  53248
#define L_VW  55552
#define L_P   57856
#define L_ST  67072
#define L_F   71424

DI void mlstm_chain(const Params& p, bf16_t* BIG, const float* gates, int b, int hd, int es, bool smp, char* smem) {
    const int tid = get_tid(), wid = tid >> 6, lane = tid & 63, fr = lane & 15, fq = lane >> 4;
    bf16_t* Qs = (bf16_t*)(smem + L_Q); bf16_t* Ks = (bf16_t*)(smem + L_K); bf16_t* KTs = (bf16_t*)(smem + L_KT); bf16_t* VTs = (bf16_t*)(smem + L_VT);
    bf16_t* VWs = (bf16_t*)(smem + L_VW); bf16_t* Ps = (bf16_t*)(smem + L_P); bf16_t* STs = (bf16_t*)(smem + L_ST);
    float* fl = (float*)(smem + L_F);
    float* as_ = fl; float* Ms = fl + 64; float* bs = fl + 128; float* wrs = fl + 192; float* rsum = fl + 256; float* qns = fl + 320; float* ns = fl + 384; float* sc = fl + 512;
    const int L = smp ? 16 : 64, nch = smp ? 1 : 64, sidx = b * 4 + hd;
    const size_t row0 = smp ? (size_t)NPR + b * 16 : (size_t)b * 4096;
    const float bi = p.in[16][hd], bfg = p.in[17][hd];
    float m = 0.f, nreg = 0.f;
    f32x4 accC[2];
    accC[0] = (f32x4){0.f, 0.f, 0.f, 0.f}; accC[1] = accC[0];
    if (smp) {
        const float* C0 = p.in[2] + (size_t)sidx * 128 * 256;
#pragma unroll
        for (int mt = 0; mt < 2; ++mt)
#pragma unroll
            for (int j = 0; j < 4; ++j) accC[mt][j] = C0[(size_t)(32 * wid + 16 * mt + 4 * fq + j) * 256 + es * 16 + fr];
        if (tid < 128) nreg = p.in[3][sidx * 128 + tid];
        m = p.in[4][sidx];
    }
    __syncthreads();
#pragma unroll
    for (int mt = 0; mt < 2; ++mt) *(u32x2*)(STs + fr * 136 + 32 * wid + 16 * mt + 4 * fq) = pack4(accC[mt]);
    if (tid < 128) ns[tid] = nreg;

    u32x4 qv[4], kv[4], vv; float gi = 0.f, gf = 0.f;
    auto load = [&](int c) __attribute__((always_inline)) {
        const size_t r0 = row0 + (size_t)c * 64;
{
            const int r = tid >> 2, qt = tid & 3, rc = r < L ? r : L - 1;
            const bf16_t* qp = BIG + (r0 + rc) * 5632 + hd * 128 + qt * 32;
#pragma unroll
            for (int i = 0; i < 4; ++i) {
                qv[i] = *(const u32x4*)(qp + i * 8); kv[i] = *(const u32x4*)(qp + 512 + i * 8);
                if (r >= L) { qv[i] = (u32x4){0u, 0u, 0u, 0u}; kv[i] = (u32x4){0u, 0u, 0u, 0u}; }
            }
        }
        { const int r = (tid & 127) >> 1, cc = tid & 1, rc = r < L ? r : L - 1;
          vv = *(const u32x4*)(BIG + (r0 + rc) * 5632 + 1024 + hd * 256 + es * 16 + cc * 8);
          if (r >= L) vv = (u32x4){0u, 0u, 0u, 0u}; }
        { const int lc = lane < L ? lane : L - 1; gi = gates[(r0 + lc) * 32 + hd]; gf = gates[(r0 + lc) * 32 + 4 + hd]; }
    };
    load(0);
    for (int c = 0; c < nch; ++c) {
        __syncthreads();
        if (wid == 0) {
            float ig = -1e30f, lf = 0.f;
            if (lane < L) { ig = gi + bi; const float x = gf + bfg; lf = fminf(x, 0.f) - log1pf(__expf(-fabsf(x))); }
            const float bc = scan_add(lf, lane);
            const float a = ig - bc;
            const float pm = scan_max(a, lane);
            const float M = fmaxf(m, pm);
            const float Mlast = __shfl(M, L - 1), bL = __shfl(bc, L - 1);
            as_[lane] = a; Ms[lane] = M; bs[lane] = bc; wrs[lane] = lane < L ? __expf(a - Mlast) : 0.f;
            if (lane == 0) { sc[0] = Mlast; sc[1] = bL; }
        }
        __syncthreads();
{
            const int r = tid >> 2, qt = tid & 3;
            bf16_t* qd = Qs + r * 136 + qt * 32; bf16_t* kd = Ks + r * 136 + qt * 32; bf16_t* ktd = KTs + (qt * 32) * 72 + r;
#pragma unroll
            for (int i = 0; i < 4; ++i) {
                *(u32x4*)(qd + i * 8) = qv[i];
                float kf[8]; unpack8(kv[i], kf);
#pragma unroll
                for (int j = 0; j < 8; ++j) { kf[j] *= 0.08838834764831845f; ktd[(i * 8 + j) * 72] = f2bf(kf[j]); }
                *(u32x4*)(kd + i * 8) = pack8(kf);
            }
        }
        if (tid < 128) {
            const int r = tid >> 1, cc = tid & 1; const float w = wrs[r];
            float vf[8]; unpack8(vv, vf);
#pragma unroll
            for (int j = 0; j < 8; ++j) { VTs[(cc * 8 + j) * 72 + r] = f2bf(vf[j]); VWs[(cc * 8 + j) * 72 + r] = f2bf(vf[j] * w); }
        }
        if (c + 1 < nch) load(c + 1);
        __syncthreads();
        {
            f32x4 s4[4];
#pragma unroll
            for (int nt = 0; nt < 4; ++nt) s4[nt] = (f32x4){0.f, 0.f, 0.f, 0.f};
#pragma unroll 1
            for (int kk = 0; kk < 4; ++kk) {
                const bf16x8 qf = ldfrag(Qs, 136, 16 * wid + fr, kk * 32 + fq * 8);
#pragma unroll
                for (int nt = 0; nt < 4; ++nt) s4[nt] = mfma16(ldfrag(Ks, 136, 16 * nt + fr, kk * 32 + fq * 8), qf, s4[nt]);
            }
            const int s = 16 * wid + fr; const float Msv = Ms[s]; float rs = 0.f;
#pragma unroll
            for (int nt = 0; nt < 4; ++nt) {
                f32x4 pv;
#pragma unroll
                for (int j = 0; j < 4; ++j) { const int r = 16 * nt + 4 * fq + j; const float d = (r <= s) ? __expf(as_[r] - Msv) : 0.f; pv[j] = s4[nt][j] * d; rs += pv[j]; }
                *(u32x2*)(Ps + s * 72 + 16 * nt + 4 * fq) = pack4(pv);
            }
            rs += __shfl_xor(rs, 16); rs += __shfl_xor(rs, 32);
            if (fq == 0) rsum[s] = rs;
            const int s2 = tid >> 2, part = tid & 3; float qa = 0.f;
#pragma unroll
            for (int j = 0; j < 4; ++j) { float qf8[8]; unpack8(*(const u32x4*)(Qs + s2 * 136 + part * 32 + j * 8), qf8);
#pragma unroll
                for (int i = 0; i < 8; ++i) qa += qf8[i] * ns[part * 32 + j * 8 + i]; }
            qa += __shfl_xor(qa, 1); qa += __shfl_xor(qa, 2);
            if (part == 0) qns[s2] = qa;
        }
        __syncthreads();
        const float Mlast = sc[0], bL = sc[1];
        {
            f32x4 h1 = (f32x4){0.f, 0.f, 0.f, 0.f}, h2 = h1;
#pragma unroll
            for (int kk = 0; kk < 2; ++kk) h1 = mfma16(ldfrag(VTs, 72, fr, kk * 32 + fq * 8), ldfrag(Ps, 72, 16 * wid + fr, kk * 32 + fq * 8), h1);
#pragma unroll
            for (int kk = 0; kk < 4; ++kk) h2 = mfma16(ldfrag(STs, 136, fr, kk * 32 + fq * 8), ldfrag(Qs, 136, 16 * wid + fr, kk * 32 + fq * 8), h2);
            const int s = 16 * wid + fr; const float Msv = Ms[s], wi = __expf(m - Msv);
            const float den = rsum[s] + wi * qns[s], ms = bs[s] + Msv, inv = 1.f / fmaxf(fabsf(den), __expf(-ms));
            f32x4 hv;
#pragma unroll
            for (int j = 0; j < 4; ++j) hv[j] = (h1[j] + wi * h2[j]) * inv;
            if (s < L) *(u32x2*)(BIG + (row0 + (size_t)c * 64 + s) * 5632 + 1024 + hd * 256 + es * 16 + 4 * fq) = pack4(hv);
        }
        {
            const float decay = __expf(m - Mlast);
#pragma unroll
            for (int mt = 0; mt < 2; ++mt) {
                accC[mt] *= decay;
#pragma unroll
                for (int kk = 0; kk < 2; ++kk) accC[mt] = mfma16(ldfrag(KTs, 72, 32 * wid + 16 * mt + fr, kk * 32 + fq * 8), ldfrag(VWs, 72, fr, kk * 32 + fq * 8), accC[mt]);
            }
            if (tid < 128) {
                float sn = 0.f;
#pragma unroll
                for (int r8 = 0; r8 < 8; ++r8) { float kf[8]; unpack8(*(const u32x4*)(KTs + tid * 72 + r8 * 8), kf);
#pragma unroll
                    for (int i = 0; i < 8; ++i) sn += kf[i] * wrs[r8 * 8 + i]; }
                nreg = decay * nreg + sn;
            }
        }
        m = bL + Mlast;
        __syncthreads();
#pragma unroll
        for (int mt = 0; mt < 2; ++mt) *(u32x2*)(STs + fr * 136 + 32 * wid + 16 * mt + 4 * fq) = pack4(accC[mt]);
        if (tid < 128) ns[tid] = nreg;
    }
    float* Co = p.out + (smp ? OFF_SC : OFF_PC) + (size_t)sidx * 128 * 256;
#pragma unroll
    for (int mt = 0; mt < 2; ++mt)
#pragma unroll
        for (int j = 0; j < 4; ++j) Co[(size_t)(32 * wid + 16 * mt + 4 * fq + j) * 256 + es * 16 + fr] = accC[mt][j];
    if (es == 0) {
        if (tid < 128) p.out[(smp ? OFF_SN : OFF_PN) + sidx * 128 + tid] = nreg;
        if (tid == 0) p.out[(smp ? OFF_SM : OFF_PM) + sidx] = m;
    }
}

DI void ssd_chain(const Params& p, bf16_t* BIG, const float* gates, int b, int hd, int ps, bool smp, char* smem) {
    const int tid = get_tid(), wid = tid >> 6, lane = tid & 63, fr = lane & 15, fq = lane >> 4;
    bf16_t* Cs = (bf16_t*)(smem + L_Q); bf16_t* Bs = (bf16_t*)(smem + L_K); bf16_t* BTs = (bf16_t*)(smem + L_KT); bf16_t* XTs = (bf16_t*)(smem + L_VT);
    bf16_t* XWs = (bf16_t*)(smem + L_VW); bf16_t* Ps = (bf16_t*)(smem + L_P); bf16_t* STs = (bf16_t*)(smem + L_ST);
    float* fl = (float*)(smem + L_F);
    float* bs = fl; float* dts = fl + 64; float* wrs = fl + 128; float* sc = fl + 192;
    const int L = smp ? 16 : 64, nch = smp ? 1 : 64, sidx = b * 16 + hd, g = hd >> 3;
    const size_t row0 = smp ? (size_t)NPR + b * 16 : (size_t)b * 4096;
    const float dtb = p.in[21][hd], negA = -__expf(p.in[22][hd]), Dk = p.in[23][hd];
    f32x4 accS[2];
    accS[0] = (f32x4){0.f, 0.f, 0.f, 0.f}; accS[1] = accS[0];
    if (smp) {
        const float* S0 = p.in[5] + (size_t)sidx * 64 * 128;
#pragma unroll
        for (int i = 0; i < 2; ++i)
#pragma unroll
            for (int j = 0; j < 4; ++j) accS[i][j] = S0[(size_t)(ps * 16 + fr) * 128 + 16 * (2 * wid + i) + 4 * fq + j];
    }
    __syncthreads();
#pragma unroll
    for (int i = 0; i < 2; ++i) *(u32x2*)(STs + fr * 136 + 16 * (2 * wid + i) + 4 * fq) = pack4(accS[i]);

    u32x4 qv[4], kv[4], vv; float gd = 0.f;
    auto load = [&](int c) __attribute__((always_inline)) {
        const size_t r0 = row0 + (size_t)c * 64;
{
            const int r = tid >> 2, qt = tid & 3, rc = r < L ? r : L - 1;
            const bf16_t* bp = BIG + (r0 + rc) * 5632 + 5120 + g * 128 + qt * 32;
#pragma unroll
            for (int i = 0; i < 4; ++i) {
                qv[i] = *(const u32x4*)(bp + 256 + i * 8); kv[i] = *(const u32x4*)(bp + i * 8);
                if (r >= L) { qv[i] = (u32x4){0u, 0u, 0u, 0u}; kv[i] = (u32x4){0u, 0u, 0u, 0u}; }
            }
        }
        { const int r = (tid & 127) >> 1, cc = tid & 1, rc = r < L ? r : L - 1;
          vv = *(const u32x4*)(BIG + (r0 + rc) * 5632 + 4096 + hd * 64 + ps * 16 + cc * 8);
          if (r >= L) vv = (u32x4){0u, 0u, 0u, 0u}; }
        { const int lc = lane < L ? lane : L - 1; gd = gates[(r0 + lc) * 32 + 8 + hd]; }
    };
    load(0);
    for (int c = 0; c < nch; ++c) {
        __syncthreads();
        if (wid == 0) {
            float dtv = 0.f;
            if (lane < L) dtv = softplusf(gd + dtb);
            const float a = negA * dtv;
            const float bc = scan_add(a, lane);
            const float bL = __shfl(bc, L - 1);
            bs[lane] = bc; dts[lane] = dtv; wrs[lane] = __expf(bL - bc) * dtv;
            if (lane == 0) sc[1] = bL;
        }
        __syncthreads();
{
            const int r = tid >> 2, qt = tid & 3;
            bf16_t* qd = Cs + r * 136 + qt * 32; bf16_t* kd = Bs + r * 136 + qt * 32; bf16_t* ktd = BTs + (qt * 32) * 72 + r;
#pragma unroll
            for (int i = 0; i < 4; ++i) {
                *(u32x4*)(qd + i * 8) = qv[i];
                *(u32x4*)(kd + i * 8) = kv[i];
                const unsigned kw[4] = {kv[i].x, kv[i].y, kv[i].z, kv[i].w};
#pragma unroll
                for (int j = 0; j < 4; ++j) { ktd[(i * 8 + 2 * j) * 72] = (bf16_t)(kw[j] & 0xffffu); ktd[(i * 8 + 2 * j + 1) * 72] = (bf16_t)(kw[j] >> 16); }
            }
        }
        if (tid < 128) {
            const int r = tid >> 1, cc = tid & 1; const float w = wrs[r];
            float vf[8]; unpack8(vv, vf);
#pragma unroll
            for (int j = 0; j < 8; ++j) { XTs[(cc * 8 + j) * 72 + r] = f2bf(vf[j]); XWs[(cc * 8 + j) * 72 + r] = f2bf(vf[j] * w); }
        }
        if (c + 1 < nch) load(c + 1);
        __syncthreads();
        {
            f32x4 s4[4];
#pragma unroll
            for (int nt = 0; nt < 4; ++nt) s4[nt] = (f32x4){0.f, 0.f, 0.f, 0.f};
#pragma unroll 1
            for (int kk = 0; kk < 4; ++kk) {
                const bf16x8 qf = ldfrag(Cs, 136, 16 * wid + fr, kk * 32 + fq * 8);
#pragma unroll
                for (int nt = 0; nt < 4; ++nt) s4[nt] = mfma16(ldfrag(Bs, 136, 16 * nt + fr, kk * 32 + fq * 8), qf, s4[nt]);
            }
            const int s = 16 * wid + fr; const float bsv = bs[s];
#pragma unroll
            for (int nt = 0; nt < 4; ++nt) {
                f32x4 pv;
#pragma unroll
                for (int j = 0; j < 4; ++j) { const int r = 16 * nt + 4 * fq + j; const float d = (r <= s) ? __expf(bsv - bs[r]) * dts[r] : 0.f; pv[j] = s4[nt][j] * d; }
                *(u32x2*)(Ps + s * 72 + 16 * nt + 4 * fq) = pack4(pv);
            }
        }
        __syncthreads();
        const float bL = sc[1];
        {
            f32x4 h1 = (f32x4){0.f, 0.f, 0.f, 0.f}, h2 = h1;
#pragma unroll
            for (int kk = 0; kk < 2; ++kk) h1 = mfma16(ldfrag(XTs, 72, fr, kk * 32 + fq * 8), ldfrag(Ps, 72, 16 * wid + fr, kk * 32 + fq * 8), h1);
#pragma unroll
            for (int kk = 0; kk < 4; ++kk) h2 = mfma16(ldfrag(STs, 136, fr, kk * 32 + fq * 8), ldfrag(Cs, 136, 16 * wid + fr, kk * 32 + fq * 8), h2);
            const int s = 16 * wid + fr; const float eb = __expf(bs[s]);
            if (s < L) {
                bf16_t* zp = BIG + (row0 + (size_t)c * 64 + s) * 5632 + 2048 + hd * 64 + ps * 16 + 4 * fq;
                const u32x2 zr = *(const u32x2*)zp;
                const float zf[4] = {lo2f(zr.x), hi2f(zr.x), lo2f(zr.y), hi2f(zr.y)};
                f32x4 yv;
#pragma unroll
                for (int j = 0; j < 4; ++j) { const float xv = bf2f(XTs[(4 * fq + j) * 72 + s]); yv[j] = (h1[j] + eb * h2[j] + Dk * xv) * siluf(zf[j]); }
                *(u32x2*)zp = pack4(yv);
            }
        }
        {
            const float dec = __expf(bL);
#pragma unroll
            for (int i = 0; i < 2; ++i) {
                accS[i] *= dec;
#pragma unroll
                for (int kk = 0; kk < 2; ++kk) accS[i] = mfma16(ldfrag(BTs, 72, 16 * (2 * wid + i) + fr, kk * 32 + fq * 8), ldfrag(XWs, 72, fr, kk * 32 + fq * 8), accS[i]);
            }
        }
        __syncthreads();
#pragma unroll
        for (int i = 0; i < 2; ++i) *(u32x2*)(STs + fr * 136 + 16 * (2 * wid + i) + 4 * fq) = pack4(accS[i]);
    }
    float* So = p.out + (smp ? OFF_SSSD : OFF_PSSD) + (size_t)sidx * 64 * 128;
#pragma unroll
    for (int i = 0; i < 2; ++i) {
        float4 o; o.x = accS[i][0]; o.y = accS[i][1]; o.z = accS[i][2]; o.w = accS[i][3];
        *(float4*)(So + (size_t)(ps * 16 + fr) * 128 + 16 * (2 * wid + i) + 4 * fq) = o;
    }
}

DI void phase_scan_l0(const Params& p, bf16_t* BIG, const float* gates, char* smem) {
    for (int it = blockIdx.x; it < 1536; it += gridDim.x) {
        const bool smp = it >= 512;
        const int j = it & 255, k = smp ? (it - 512) & 511 : j;
#ifndef NO_MLSTM
        if (it < 256 || (smp && it < 1024)) mlstm_chain(p, BIG, gates, k >> 6, (k >> 4) & 3, k & 15, smp, smem);
#endif
#ifndef NO_SSD
        if ((it >= 256 && it < 512) || it >= 1024) ssd_chain(p, BIG, gates, k >> 6, (k >> 2) & 15, k & 3, smp, smem);
#endif
    }
}

DI void phase_post_l0(const Params& p, bf16_t* BIG) {
    const int tid_ = get_tid(), lane = tid_ & 63, gw = blockIdx.x * 4 + (tid_ >> 6), nw = gridDim.x * 4;
    for (int row = gw; row < NTOK; row += nw) {
        bf16_t* rp = BIG + (size_t)row * 5632;
#pragma unroll
        for (int hd = 0; hd < 4; ++hd) {
            const u32x2 rv = *(const u32x2*)(rp + 1024 + hd * 256 + lane * 4), ov = *(const u32x2*)(rp + 3072 + hd * 256 + lane * 4);
            const float x[4] = {lo2f(rv.x), hi2f(rv.x), lo2f(rv.y), hi2f(rv.y)}, o[4] = {lo2f(ov.x), hi2f(ov.x), lo2f(ov.y), hi2f(ov.y)};
            const float ss = wave_sum(x[0] * x[0] + x[1] * x[1] + x[2] * x[2] + x[3] * x[3]);
            const float r = rsqrtf(ss * (1.f / 256.f) + 1e-6f);
            const float4 gg = *(const float4*)(p.in[18] + hd * 256 + lane * 4);
            f32x4 y; y[0] = sigmf(o[0]) * x[0] * r * gg.x; y[1] = sigmf(o[1]) * x[1] * r * gg.y; y[2] = sigmf(o[2]) * x[2] * r * gg.z; y[3] = sigmf(o[3]) * x[3] * r * gg.w;
            *(u32x2*)(rp + 1024 + hd * 256 + lane * 4) = pack4(y);
        }
#pragma unroll
        for (int g = 0; g < 2; ++g) {
            float x[8]; unpack8(*(const u32x4*)(rp + 2048 + g * 512 + lane * 8), x);
            float ss = 0.f;
#pragma unroll
            for (int j = 0; j < 8; ++j) ss += x[j] * x[j];
            ss = wave_sum(ss);
            const float r = rsqrtf(ss * (1.f / 512.f) + 1e-6f);
            const float4 g0 = *(const float4*)(p.in[24] + g * 512 + lane * 8), g1 = *(const float4*)(p.in[24] + g * 512 + lane * 8 + 4);
            float y[8] = {x[0] * r * g0.x, x[1] * r * g0.y, x[2] * r * g0.z, x[3] * r * g0.w, x[4] * r * g1.x, x[5] * r * g1.y, x[6] * r * g1.z, x[7] * r * g1.w};
            *(u32x4*)(rp + 2048 + g * 512 + lane * 8) = pack8(y);
        }
    }
}

#define G_QN  0
#define G_KN  18432
#define G_VT  18432
#define G_AT  36864
#define G_VN  53504
#define G_TV  53504
#define G_TW  62720
#define G_F   71936
DI void gdn_g1_item(const Params& p, bf16_t* BIG, bf16_t* Wb, bf16_t* PB, const float* gates, const bf16_t* halo, float* egl, int unit, int hd, char* smem) {
    const int tid = get_tid(), wid = tid >> 6, lane = tid & 63, fr = lane & 15, fq = lane >> 4;
    bf16_t* Qn = (bf16_t*)(smem + G_QN); bf16_t* Kn = (bf16_t*)(smem + G_KN); bf16_t* KTs = (bf16_t*)(smem + G_QN); bf16_t* VTs = (bf16_t*)(smem + G_VT);
    bf16_t* Vn = (bf16_t*)(smem + G_VN);
    float* AT = (float*)(smem + G_AT); bf16_t* Tv = (bf16_t*)(smem + G_TV); bf16_t* Tw = (bf16_t*)(smem + G_TW);
    float* beta_s = (float*)(smem + G_F); float* gam_s = beta_s + 64;
    const bool smp = unit >= 256;
    const int L = smp ? 16 : 64, c = unit & 63, s_ = unit - 256;
    const size_t row0 = smp ? (size_t)NPR + s_ * 16 : (size_t)unit * 64;
    const int tok = tid >> 2, qt = tid & 3;
    const float* cw = p.in[27];
    const bf16_t* hp = halo + (size_t)(smp ? 264 + s_ : (unit > 0 ? unit - 1 : 0)) * 3 * 3072;
    const bool zh = !smp && c == 0;
    __syncthreads();
    if (wid == 0) {
        float beta = 0.f, g = 0.f;
        const int lc = lane < L ? lane : L - 1;
        const float br = gates[(row0 + lc) * 32 + hd], ar = gates[(row0 + lc) * 32 + 8 + hd];
        if (lane < L) { beta = sigmf(br); g = -__expf(p.in[29][hd]) * softplusf(ar + p.in[28][hd]); }
        const float gam = scan_add(g, lane);
        beta_s[lane] = beta; gam_s[lane] = gam;
        if (lane == L - 1) egl[unit * 8 + hd] = __expf(gam);
    }
#pragma unroll 1
    for (int mi = 0; mi < 3; ++mi) {
        float o[32];
#pragma unroll
        for (int j = 0; j < 4; ++j) {
            const int col = mi * 1024 + hd * 128 + qt * 32 + j * 8;
            float a8[8];
#pragma unroll
            for (int q = 0; q < 8; ++q) a8[q] = 0.f;
#pragma unroll
            for (int i = 0; i < 4; ++i) {
                const int tc = tok < L ? tok : L - 1, rlc = tc - 3 + i;
                const bf16_t* src = rlc >= 0 ? BIG + (row0 + rlc) * 4096 + col : hp + (rlc + 3) * 3072 + col;
                u32x4 xv = *(const u32x4*)src;
                if (rlc < 0 && zh) xv = (u32x4){0u, 0u, 0u, 0u};
                float xf[8]; unpack8(xv, xf);
                const float4 w0 = *(const float4*)(cw + i * 3072 + col), w1 = *(const float4*)(cw + i * 3072 + col + 4);
                a8[0] += w0.x * xf[0]; a8[1] += w0.y * xf[1]; a8[2] += w0.z * xf[2]; a8[3] += w0.w * xf[3];
                a8[4] += w1.x * xf[4]; a8[5] += w1.y * xf[5]; a8[6] += w1.z * xf[6]; a8[7] += w1.w * xf[7];
            }
#pragma unroll
            for (int q = 0; q < 8; ++q) o[j * 8 + q] = siluf(a8[q]);
        }
        if (mi < 2) {
            float ss = 0.f;
#pragma unroll
            for (int q = 0; q < 32; ++q) ss += o[q] * o[q];
            ss += __shfl_xor(ss, 1); ss += __shfl_xor(ss, 2);
            const float sc = rsqrtf(ss + 1e-6f) * (mi == 0 ? 0.08838834764831845f : 1.f);
#pragma unroll
            for (int q = 0; q < 32; ++q) o[q] *= sc;
        }
        if (tok >= L) {
#pragma unroll
            for (int q = 0; q < 32; ++q) o[q] = 0.f;
        }
        bf16_t* dst = (mi == 0 ? Qn : (mi == 1 ? Kn : Vn)) + tok * 136 + qt * 32;
#pragma unroll
        for (int j = 0; j < 4; ++j) *(u32x4*)(dst + j * 8) = pack8(o + j * 8);
    }
    __syncthreads();
    {
        f32x4 a4[4], p4[4];
#pragma unroll
        for (int nt = 0; nt < 4; ++nt) { a4[nt] = (f32x4){0.f, 0.f, 0.f, 0.f}; p4[nt] = a4[nt]; }
#pragma unroll 1
        for (int kk = 0; kk < 4; ++kk) {
            const bf16x8 qf = ldfrag(Qn, 136, 16 * wid + fr, kk * 32 + fq * 8), ksf = ldfrag(Kn, 136, 16 * wid + fr, kk * 32 + fq * 8);
#pragma unroll
            for (int nt = 0; nt < 4; ++nt) { const bf16x8 kf = ldfrag(Kn, 136, 16 * nt + fr, kk * 32 + fq * 8); a4[nt] = mfma16(kf, ksf, a4[nt]); p4[nt] = mfma16(kf, qf, p4[nt]); }
        }
        const int s = 16 * wid + fr; const float gs = gam_s[s], bsv = beta_s[s];
#pragma unroll
        for (int nt = 0; nt < 4; ++nt) {
            f32x4 pv;
#pragma unroll
            for (int j = 0; j < 4; ++j) {
                const int r = 16 * nt + 4 * fq + j;
                const float d = (r <= s) ? __expf(gs - gam_s[r]) : 0.f;
                pv[j] = p4[nt][j] * d;
                AT[s * 65 + r] = (r < s) ? a4[nt][j] * d * bsv : 0.f;
            }
            if (s < L) *(u32x2*)(PB + (row0 + s) * 512 + hd * 64 + 16 * nt + 4 * fq) = pack4(pv);
        }
    }
    __syncthreads();
    if (tok < L) {
        const float eg = __expf(gam_s[tok]);
#pragma unroll
        for (int j = 0; j < 4; ++j) {
            float qf8[8]; unpack8(*(const u32x4*)(Qn + tok * 136 + qt * 32 + j * 8), qf8);
#pragma unroll
            for (int q = 0; q < 8; ++q) qf8[q] *= eg;
            *(u32x4*)(BIG + (row0 + tok) * 4096 + hd * 128 + qt * 32 + j * 8) = pack8(qf8);
        }
    }
    __syncthreads();
    {
        u32x4 kk4[4];
#pragma unroll
        for (int j = 0; j < 4; ++j) kk4[j] = *(const u32x4*)(Kn + tok * 136 + qt * 32 + j * 8);
        bf16_t* ktd = KTs + (qt * 32) * 72 + tok;
#pragma unroll
        for (int j = 0; j < 4; ++j) {
            const unsigned kw[4] = {kk4[j].x, kk4[j].y, kk4[j].z, kk4[j].w};
#pragma unroll
            for (int q = 0; q < 4; ++q) { ktd[(j * 8 + 2 * q) * 72] = (bf16_t)(kw[q] & 0xffffu); ktd[(j * 8 + 2 * q + 1) * 72] = (bf16_t)(kw[q] >> 16); }
        }
    }
    __syncthreads();
    {
        u32x4 vv4[4];
#pragma unroll
        for (int j = 0; j < 4; ++j) vv4[j] = *(const u32x4*)(Vn + tok * 136 + qt * 32 + j * 8);
        bf16_t* vtd = VTs + (qt * 32) * 72 + tok;
#pragma unroll
        for (int j = 0; j < 4; ++j) {
            const unsigned vw[4] = {vv4[j].x, vv4[j].y, vv4[j].z, vv4[j].w};
#pragma unroll
            for (int q = 0; q < 4; ++q) { vtd[(j * 8 + 2 * q) * 72] = (bf16_t)(vw[q] & 0xffffu); vtd[(j * 8 + 2 * q + 1) * 72] = (bf16_t)(vw[q] >> 16); }
        }
    }
    __syncthreads();
    if (wid == 0) {
        const int j = lane;
        for (int s = 0; s < 64; ++s) {
            float acc = (s == j) ? 1.f : 0.f;
            for (int r = 0; r < s; ++r) acc -= AT[s * 65 + r] * AT[r * 65 + j];
            AT[s * 65 + j] = acc;
        }
        const float bj = beta_s[j], bej = bj * __expf(gam_s[j]);
        for (int s = 0; s < 64; ++s) { const float t = AT[s * 65 + j]; Tv[s * 72 + j] = f2bf(t * bj); Tw[s * 72 + j] = f2bf(t * bej); }
    }
    __syncthreads();
    {
        const int s = 16 * wid + fr;
        const bf16x8 tw0 = ldfrag(Tw, 72, s, fq * 8), tw1 = ldfrag(Tw, 72, s, 32 + fq * 8), tv0 = ldfrag(Tv, 72, s, fq * 8), tv1 = ldfrag(Tv, 72, s, 32 + fq * 8);
#pragma unroll 2
        for (int nt = 0; nt < 8; ++nt) {
            f32x4 w4 = (f32x4){0.f, 0.f, 0.f, 0.f}, u4 = w4;
            w4 = mfma16(ldfrag(KTs, 72, 16 * nt + fr, fq * 8), tw0, w4); w4 = mfma16(ldfrag(KTs, 72, 16 * nt + fr, 32 + fq * 8), tw1, w4);
            u4 = mfma16(ldfrag(VTs, 72, 16 * nt + fr, fq * 8), tv0, u4); u4 = mfma16(ldfrag(VTs, 72, 16 * nt + fr, 32 + fq * 8), tv1, u4);
            if (s < L) {
                *(u32x2*)(Wb + (row0 + s) * 1024 + hd * 128 + 16 * nt + 4 * fq) = pack4(w4);
                *(u32x2*)(BIG + (row0 + s) * 4096 + 2048 + hd * 128 + 16 * nt + 4 * fq) = pack4(u4);
            }
        }
        const float gL = gam_s[L - 1];
#pragma unroll
        for (int i = 0; i < 4; ++i) {
            const int idx = tid + 256 * i, d = idx >> 3, r8 = idx & 7;
            if (r8 * 8 < L) {
                float kf[8]; unpack8(*(const u32x4*)(KTs + d * 72 + r8 * 8), kf);
#pragma unroll
                for (int q = 0; q < 8; ++q) kf[q] *= __expf(gL - gam_s[r8 * 8 + q]);
                const int e = d * L + r8 * 8;
                *(u32x4*)(BIG + (row0 + (e >> 7)) * 4096 + 1024 + hd * 128 + (e & 127)) = pack8(kf);
            }
        }
        if ((smp || c == 63) && tid < 144) {
            const int i = tid / 48, rem = tid % 48, col = (rem >> 4) * 1024 + hd * 128 + (rem & 15) * 8;
            float f[8]; unpack8(*(const u32x4*)(halo + ((size_t)unit * 3 + i) * 3072 + col), f);
            float* dst = smp ? p.out + OFF_SGC + ((size_t)s_ * 3 + i) * 3072 + col : p.out + OFF_PGC + ((size_t)(unit >> 6) * 3 + i) * 3072 + col;
            *(float4*)dst = make_float4(f[0], f[1], f[2], f[3]); *(float4*)(dst + 4) = make_float4(f[4], f[5], f[6], f[7]);
        }
    }
}

#define S_W   0
#define S_Q   17408
#define S_KT  34816
#define S_P   53248
#define S_UT  62464
#define S_ST  64768
DI void gdn_chain(const Params& p, bf16_t* BIG, const bf16_t* Wb, const bf16_t* PB, const float* egl, int b, int hd, int es, bool smp, char* smem) {
    const int tid = get_tid(), wid = tid >> 6, lane = tid & 63, fr = lane & 15, fq = lane >> 4;
    bf16_t* Ws = (bf16_t*)(smem + S_W); bf16_t* Qs = (bf16_t*)(smem + S_Q); bf16_t* KTs = (bf16_t*)(smem + S_KT); bf16_t* Ps = (bf16_t*)(smem + S_P);
    bf16_t* UTs = (bf16_t*)(smem + S_UT); bf16_t* STs = (bf16_t*)(smem + S_ST);
    const int L = smp ? 16 : 64, nch = smp ? 1 : 64, sidx = b * 8 + hd;
    const size_t row0 = smp ? (size_t)NPR + b * 16 : (size_t)b * 4096;
    f32x4 accS[2];
    accS[0] = (f32x4){0.f, 0.f, 0.f, 0.f}; accS[1] = accS[0];
    if (smp) {
        const float* S0 = p.in[7] + (size_t)sidx * 128 * 128;
#pragma unroll
        for (int mt = 0; mt < 2; ++mt)
#pragma unroll
            for (int j = 0; j < 4; ++j) accS[mt][j] = S0[(size_t)(32 * wid + 16 * mt + 4 * fq + j) * 128 + es * 16 + fr];
    }
    __syncthreads();
#pragma unroll
    for (int mt = 0; mt < 2; ++mt) *(u32x2*)(STs + fr * 136 + 32 * wid + 16 * mt + 4 * fq) = pack4(accS[mt]);
    u32x4 wv[4], qv[4], ktv[4], pv[2]; u32x2 u0; float eg = 1.f;
    auto load = [&](int c) __attribute__((always_inline)) {
        const size_t r0 = row0 + (size_t)c * 64;
{
            const int r = tid >> 2, qt = tid & 3, d = tid >> 1, half = tid & 1, rc = r < L ? r : L - 1;
            const bf16_t* wp = Wb + (r0 + rc) * 1024 + hd * 128 + qt * 32;
            const bf16_t* qp = BIG + (r0 + rc) * 4096 + hd * 128 + qt * 32;
            const bf16_t* pp = PB + (r0 + rc) * 512 + hd * 64 + qt * 16;
#pragma unroll
            for (int i = 0; i < 4; ++i) {
                wv[i] = *(const u32x4*)(wp + i * 8); qv[i] = *(const u32x4*)(qp + i * 8);
                if (r >= L) { wv[i] = (u32x4){0u, 0u, 0u, 0u}; qv[i] = (u32x4){0u, 0u, 0u, 0u}; }
                const int rr = half * 32 + i * 8, rrc = rr < L ? rr : 0;
                const int e = d * L + rrc;
                ktv[i] = *(const u32x4*)(BIG + (r0 + (e >> 7)) * 4096 + 1024 + hd * 128 + (e & 127));
                if (rr >= L) ktv[i] = (u32x4){0u, 0u, 0u, 0u};
            }
#pragma unroll
            for (int i = 0; i < 2; ++i) { pv[i] = *(const u32x4*)(pp + i * 8); if (r >= L) pv[i] = (u32x4){0u, 0u, 0u, 0u}; }
        }
        const int s = 16 * wid + fr, sc_ = s < L ? s : L - 1;
        u0 = *(const u32x2*)(BIG + (r0 + sc_) * 4096 + 2048 + hd * 128 + es * 16 + 4 * fq);
        if (s >= L) u0 = (u32x2){0u, 0u};
        eg = egl[(smp ? 256 + b : b * 64 + c) * 8 + hd];
    };
    load(0);
    for (int c = 0; c < nch; ++c) {
        __syncthreads();
{
            const int r = tid >> 2, qt = tid & 3, d = tid >> 1, half = tid & 1;
#pragma unroll
            for (int i = 0; i < 4; ++i) {
                *(u32x4*)(Ws + r * 136 + qt * 32 + i * 8) = wv[i]; *(u32x4*)(Qs + r * 136 + qt * 32 + i * 8) = qv[i];
                *(u32x4*)(KTs + d * 72 + half * 32 + i * 8) = ktv[i];
            }
#pragma unroll
            for (int i = 0; i < 2; ++i) *(u32x4*)(Ps + r * 72 + qt * 16 + i * 8) = pv[i];
        }
        const u32x2 u0c = u0; const float egc = eg;
        if (c + 1 < nch) load(c + 1);
        __syncthreads();
        const int s = 16 * wid + fr;
        {
            f32x4 w4 = (f32x4){0.f, 0.f, 0.f, 0.f};
#pragma unroll
            for (int kk = 0; kk < 4; ++kk) w4 = mfma16(ldfrag(STs, 136, fr, kk * 32 + fq * 8), ldfrag(Ws, 136, s, kk * 32 + fq * 8), w4);
            const float uf[4] = {lo2f(u0c.x) - w4[0], hi2f(u0c.x) - w4[1], lo2f(u0c.y) - w4[2], hi2f(u0c.y) - w4[3]};
#pragma unroll
            for (int j = 0; j < 4; ++j) UTs[(4 * fq + j) * 72 + s] = f2bf(uf[j]);
        }
        __syncthreads();
        {
            f32x4 o4 = (f32x4){0.f, 0.f, 0.f, 0.f};
#pragma unroll
            for (int kk = 0; kk < 4; ++kk) o4 = mfma16(ldfrag(STs, 136, fr, kk * 32 + fq * 8), ldfrag(Qs, 136, s, kk * 32 + fq * 8), o4);
#pragma unroll
            for (int kk = 0; kk < 2; ++kk) o4 = mfma16(ldfrag(UTs, 72, fr, kk * 32 + fq * 8), ldfrag(Ps, 72, s, kk * 32 + fq * 8), o4);
            if (s < L) *(u32x2*)(BIG + (row0 + (size_t)c * 64 + s) * 4096 + 2048 + hd * 128 + es * 16 + 4 * fq) = pack4(o4);
#pragma unroll
            for (int mt = 0; mt < 2; ++mt) {
                accS[mt] *= egc;
#pragma unroll
                for (int kk = 0; kk < 2; ++kk) accS[mt] = mfma16(ldfrag(KTs, 72, 32 * wid + 16 * mt + fr, kk * 32 + fq * 8), ldfrag(UTs, 72, fr, kk * 32 + fq * 8), accS[mt]);
            }
        }
        __syncthreads();
#pragma unroll
        for (int mt = 0; mt < 2; ++mt) *(u32x2*)(STs + fr * 136 + 32 * wid + 16 * mt + 4 * fq) = pack4(accS[mt]);
    }
    float* So = p.out + (smp ? OFF_SG : OFF_PG) + (size_t)sidx * 128 * 128;
#pragma unroll
    for (int mt = 0; mt < 2; ++mt)
#pragma unroll
        for (int j = 0; j < 4; ++j) So[(size_t)(32 * wid + 16 * mt + 4 * fq + j) * 128 + es * 16 + fr] = accS[mt][j];
}

DI void phase_post_l1(const Params& p, bf16_t* BIG) {
    const int tid_ = get_tid(), lane = tid_ & 63, gw = blockIdx.x * 4 + (tid_ >> 6), nw = gridDim.x * 4;
    const int hd = lane >> 3, e0 = (lane & 7) * 16;
    for (int row = gw; row < NTOK; row += nw) {
        bf16_t* op = BIG + (size_t)row * 4096 + 2048 + hd * 128 + e0;
        const bf16_t* zp = BIG + (size_t)row * 4096 + 3072 + hd * 128 + e0;
        float x[16], z[16];
        unpack8(*(const u32x4*)op, x); unpack8(*(const u32x4*)(op + 8), x + 8);
        unpack8(*(const u32x4*)zp, z); unpack8(*(const u32x4*)(zp + 8), z + 8);
        float ss = 0.f;
#pragma unroll
        for (int j = 0; j < 16; ++j) ss += x[j] * x[j];
        ss += __shfl_xor(ss, 1); ss += __shfl_xor(ss, 2); ss += __shfl_xor(ss, 4);
        const float r = rsqrtf(ss * (1.f / 128.f) + 1e-6f);
        float y[16];
#pragma unroll
        for (int j = 0; j < 16; ++j) y[j] = x[j] * r * p.in[30][e0 + j] * siluf(z[j]);
        *(u32x4*)op = pack8(y); *(u32x4*)(op + 8) = pack8(y + 8);
    }
}

__global__ void __launch_bounds__(256, 2) fwd_megakernel(Params p) {
    __shared__ __attribute__((aligned(16))) char smem[LDS_BYTES];
    cg::grid_group grid = cg::this_grid();
    char* ws = p.ws;
    bf16_t* WGU = (bf16_t*)(ws + WS_WGU); bf16_t* WD = (bf16_t*)(ws + WS_WD); bf16_t* WIN = (bf16_t*)(ws + WS_WIN); bf16_t* WOUT = (bf16_t*)(ws + WS_WOUT);
    bf16_t* H = (bf16_t*)(ws + WS_H); bf16_t* BIG = (bf16_t*)(ws + WS_BIG); float* GATES = (float*)(ws + WS_GATES); bf16_t* HALO = (bf16_t*)(ws + WS_HALO); float* EGL = (float*)(ws + WS_EGL);
    bf16_t* PB = BIG + (size_t)NTOK * 4096;
    float* X = p.out; float* XS = p.out + (size_t)NPR * 1024;
    const float* ng = p.in[9];
    const size_t FW = (size_t)1024 * 2816;
    Epi e{};
    phase_norm(p.in[0], p.in[1], ng, H);
    cvt_job(p.in[11], 1024, 2816, WGU, 1, 0, smem);
    cvt_job(p.in[12], 1024, 2816, WGU, 2, 100, smem);
    cvt_job(p.in[13], 2816, 1024, WD, 0, 200, smem);
    cvt_job(p.in[14], 1024, 5656, WIN, 3, 300, smem);
    cvt_job(p.in[15], 2048, 1024, WOUT, 0, 400, smem);
    grid.sync();
    e.o16 = BIG; e.ldc = 2816;
    gemm_phase<EPI_GU>(H, 1024, WGU, 1024, 44, e, smem);
    grid.sync();
    e.o32 = X; e.rp = p.in[0]; e.rs = p.in[1]; e.scale = 0.5f;
    gemm_phase<EPI_RES>(BIG, 2816, WD, 2816, 8, e, smem);
    grid.sync();
    phase_norm(X, XS, ng + 1024, H);
    cvt_job(p.in[11] + FW, 1024, 2816, WGU, 1, 0, smem);
    cvt_job(p.in[12] + FW, 1024, 2816, WGU, 2, 100, smem);
    cvt_job(p.in[13] + FW, 2816, 1024, WD, 0, 200, smem);
    grid.sync();
    e.o16 = BIG; e.ldc = 5632; e.gates = GATES; e.halo = HALO; e.cv0 = 4096; e.cv1 = 5632;
    gemm_phase<EPI_PROJ>(H, 1024, WIN, 1024, 45, e, smem);
    grid.sync();
#if PHM & 1
    phase_conv_ssd(p, BIG, HALO);
#endif
    grid.sync();
#if PHM & 2
    phase_scan_l0(p, BIG, GATES, smem);
#endif
    grid.sync();
    phase_post_l0(p, BIG);
    grid.sync();
    e.o32 = X; e.rp = X; e.rs = XS; e.scale = 1.0f;
    gemm_phase<EPI_RES>(BIG + 1024, 5632, WOUT, 2048, 8, e, smem);
    grid.sync();
    phase_norm(X, XS, ng + 2048, H);
    grid.sync();
    e.o16 = BIG; e.ldc = 2816;
    gemm_phase<EPI_GU>(H, 1024, WGU, 1024, 44, e, smem);
    grid.sync();
    e.scale = 0.5f;
    gemm_phase<EPI_RES>(BIG, 2816, WD, 2816, 8, e, smem);
    grid.sync();
    phase_norm(X, XS, ng + 3072, H);
    cvt_job(p.in[11] + 2 * FW, 1024, 2816, WGU, 1, 0, smem);
    cvt_job(p.in[12] + 2 * FW, 1024, 2816, WGU, 2, 100, smem);
    cvt_job(p.in[13] + 2 * FW, 2816, 1024, WD, 0, 200, smem);
    cvt_job(p.in[25], 1024, 4112, WIN, 0, 300, smem);
    cvt_job(p.in[26], 1024, 1024, WOUT, 0, 400, smem);
    grid.sync();
    gemm_phase<EPI_GU>(H, 1024, WGU, 1024, 44, e, smem);
    grid.sync();
    gemm_phase<EPI_RES>(BIG, 2816, WD, 2816, 8, e, smem);
    grid.sync();
    phase_norm(X, XS, ng + 4096, H);
    fill_cache_halo(p.in[8], 3072, HALO);
    cvt_job(p.in[11] + 3 * FW, 1024, 2816, WGU, 1, 0, smem);
    cvt_job(p.in[12] + 3 * FW, 1024, 2816, WGU, 2, 100, smem);
    cvt_job(p.in[13] + 3 * FW, 2816, 1024, WD, 0, 200, smem);
    grid.sync();
    e.o16 = BIG; e.ldc = 4096; e.cv0 = 0; e.cv1 = 3072;
    gemm_phase<EPI_PROJ>(H, 1024, WIN, 1024, 33, e, smem);
    grid.sync();
#if PHM & 4
    for (int it = blockIdx.x; it < 264 * 8; it += gridDim.x) gdn_g1_item(p, BIG, H, PB, GATES, HALO, EGL, it >> 3, it & 7, smem);
#endif
    grid.sync();
#if PHM & 8
    for (int it = blockIdx.x; it < 768; it += gridDim.x) {
        const bool smp = it >= 256; const int j = smp ? it - 256 : it;
        gdn_chain(p, BIG, H, PB, EGL, j >> 6, (j >> 3) & 7, j & 7, smp, smem);
    }
#endif
    grid.sync();
    phase_post_l1(p, BIG);
    grid.sync();
    e.scale = 1.0f;
    gemm_phase<EPI_RES>(BIG + 2048, 4096, WOUT, 1024, 8, e, smem);
    grid.sync();
    phase_norm(X, XS, ng + 5120, H);
    grid.sync();
    e.o16 = BIG; e.ldc = 2816;
    gemm_phase<EPI_GU>(H, 1024, WGU, 1024, 44, e, smem);
    grid.sync();
    e.scale = 0.5f;
    gemm_phase<EPI_RES>(BIG, 2816, WD, 2816, 8, e, smem);
    grid.sync();
    phase_final_norm(X, p.in[10]);
}

extern "C" void kernel_launch(void* const* d_in, const int* in_sizes, int n_in, void* d_out, int out_size, void* d_ws, size_t ws_size, hipStream_t stream) {
    static int grid_blocks = 0;
    if (!grid_blocks) {
        int dev = 0, cus = 0, per_cu = 0;
        hipGetDevice(&dev);
        hipDeviceGetAttribute(&cus, hipDeviceAttributeMultiprocessorCount, dev);
        hipOccupancyMaxActiveBlocksPerMultiprocessor(&per_cu, fwd_megakernel, 256, 0);
        if (per_cu > 2) per_cu = 2;
        if (per_cu < 1) per_cu = 1;
        grid_blocks = cus * per_cu;
    }
    Params p{};
    for (int i = 0; i < 31; ++i) p.in[i] = (const float*)d_in[i];
    p.out = (float*)d_out;
    p.ws = (char*)d_ws;
    void* args[] = {&p};
    hipError_t err = hipLaunchCooperativeKernel((void*)fwd_megakernel, dim3(grid_blocks), dim3(256), args, 0, stream);
    if (err != hipSuccess) fprintf(stderr, "cooperative launch failed: %s (grid %d)\n", hipGetErrorString(err), grid_blocks);
}
```

```cpp
#include <hip/hip_runtime.h>
#include <hip/hip_cooperative_groups.h>
#include <cstdio>
namespace cg = cooperative_groups;

typedef unsigned short bf16_t;
typedef short bf16x8 __attribute__((ext_vector_type(8)));
typedef float f32x4 __attribute__((ext_vector_type(4)));
typedef unsigned u32x2 __attribute__((ext_vector_type(2)));
typedef unsigned u32x4 __attribute__((ext_vector_type(4)));

#define DI __device__ __forceinline__
#define NTOK 16512
#define NPR 16384
#define LDS_BYTES 75776
#ifndef PHM
#define PHM 15
#endif

#define WS_WGU   0ull
#define WS_WD    (WS_WGU + 5632ull * 1024 * 2)
#define WS_WIN   (WS_WD + 1024ull * 2816 * 2)
#define WS_WOUT  (WS_WIN + 5760ull * 1024 * 2)
#define WS_H     (WS_WOUT + 1024ull * 2048 * 2)
#define WS_BIG   (WS_H + 16512ull * 1024 * 2)
#define WS_GATES (WS_BIG + 16512ull * 5632 * 2)
#define WS_HALO  (WS_GATES + 16512ull * 32 * 4)
#define WS_EGL   (WS_HALO + 272ull * 3 * 3072 * 2)
#define WS_BAR   (WS_EGL + 272ull * 8 * 4)
#define WS_END   (WS_BAR + 16384ull)

struct Params {
    const float* in[31];
    float* out;
    char* ws;
};

DI int get_tid() { int t = threadIdx.x; asm volatile("" : "+v"(t)); return t; }
DI bf16_t f2bf(float f) { unsigned u = __float_as_uint(f); u += 0x7fffu + ((u >> 16) & 1u); return (bf16_t)(u >> 16); }
DI float bf2f(bf16_t h) { return __uint_as_float(((unsigned)h) << 16); }
DI unsigned pack2(float lo, float hi) { return (unsigned)f2bf(lo) | ((unsigned)f2bf(hi) << 16); }
DI float lo2f(unsigned u) { return __uint_as_float(u << 16); }
DI float hi2f(unsigned u) { return __uint_as_float(u & 0xffff0000u); }
DI float siluf(float x) { return x / (1.f + __expf(-x)); }
DI float sigmf(float x) { return 1.f / (1.f + __expf(-x)); }
DI float softplusf(float x) { return fmaxf(x, 0.f) + log1pf(__expf(-fabsf(x))); }
DI f32x4 mfma16(bf16x8 a, bf16x8 b, f32x4 c) { return __builtin_amdgcn_mfma_f32_16x16x32_bf16(a, b, c, 0, 0, 0); }
DI bf16x8 ldfrag(const bf16_t* base, int ld, int row, int k) { return *(const bf16x8*)(base + row * ld + k); }
DI void unpack8(u32x4 v, float* f) {
    f[0] = lo2f(v.x); f[1] = hi2f(v.x); f[2] = lo2f(v.y); f[3] = hi2f(v.y);
    f[4] = lo2f(v.z); f[5] = hi2f(v.z); f[6] = lo2f(v.w); f[7] = hi2f(v.w);
}
DI float wave_sum(float v) {
#pragma unroll
    for (int o = 32; o >= 1; o >>= 1) v += __shfl_xor(v, o);
    return v;
}


#define XB_TMO      128
#define XB_XCNT(j)  (256  + 64 * (j))
#define XB_XSUB(j)  (1280 + 64 * (j))
#define XB_XGEN(j)  (2304 + 64 * (j))
#define XB_TOP      3328
#define XB_TOPGEN   3392
#define XCD_BAR_WORDS 3456
#define XB_SPIN_CAP (1u << 18)
#define LAS __attribute__((address_space(3)))
DI unsigned xb_ld(unsigned* p)              { return __hip_atomic_load(p, __ATOMIC_RELAXED, __HIP_MEMORY_SCOPE_AGENT); }
DI unsigned xb_add(unsigned* p, unsigned v) { return __hip_atomic_fetch_add(p, v, __ATOMIC_RELAXED, __HIP_MEMORY_SCOPE_AGENT); }
DI unsigned xb_xcc_id() { return (unsigned)__builtin_amdgcn_s_getreg((3 << 11) | 20) & 0xFu; }
#define XB_SPIN(cond, bar) do { unsigned _sp = 0; while (cond) { __builtin_amdgcn_s_sleep(1); \
    if ((++_sp & 255u) == 0u) { if (xb_ld(&(bar)[XB_TMO])) break; if (_sp > XB_SPIN_CAP) { atomicAdd(&(bar)[XB_TMO], 1u); break; } } } } while (0)
struct XcdBarrier { unsigned* bar; unsigned x; volatile LAS unsigned* st; };
DI XcdBarrier xcd_barrier_post(unsigned* bar, volatile LAS unsigned* st) {
    XcdBarrier b; b.bar = bar; b.x = xb_xcc_id(); b.st = st;
    if (threadIdx.x == 0) (void)xb_add(&bar[XB_XCNT(b.x)], 1u);
    return b;
}
DI void xcd_barrier_complete(unsigned* bar, unsigned x, unsigned& nloc, unsigned& nx) {
    const unsigned G = gridDim.x * gridDim.y * gridDim.z;
    unsigned sum, cnt, mine, sp = 0u;
    for (;;) {
        sum = 0u; cnt = 0u; mine = 0u;
#pragma unroll
        for (unsigned j = 0; j < 16; ++j) { const unsigned c = xb_ld(&bar[XB_XCNT(j)]); sum += c; cnt += (c > 0u) ? 1u : 0u; mine = (j == x) ? c : mine; }
        if (sum == G) break;
        __builtin_amdgcn_s_sleep(1);
        if ((++sp & 255u) == 0u) { if (xb_ld(&bar[XB_TMO])) break; if (sp > XB_SPIN_CAP) { atomicAdd(&bar[XB_TMO], 1u); break; } }
    }
    nloc = mine > 0u ? mine : 1u; nx = cnt > 0u ? cnt : 1u;
}
DI void xcd_barrier(const XcdBarrier& b) {
    asm volatile("s_waitcnt vmcnt(0)" ::: "memory");
    __syncthreads();
    if (threadIdx.x == 0) {
        unsigned* bar = b.bar;
        __builtin_amdgcn_s_waitcnt(0);
        unsigned nloc = b.st[0], nx = b.st[1];
        if (nloc == 0u) { xcd_barrier_complete(bar, b.x, nloc, nx); b.st[0] = nloc; b.st[1] = nx; }
        const unsigned old = xb_add(&bar[XB_XSUB(b.x)], 1u);
        const unsigned gen = old / nloc;
        if (old + 1u == (gen + 1u) * nloc) {
            __builtin_amdgcn_fence(__ATOMIC_RELEASE, "agent");
            asm volatile("s_waitcnt vmcnt(0)" ::: "memory");
            const unsigned og = xb_add(&bar[XB_TOP], 1u);
            const unsigned tg = og / nx;
            if (og + 1u == (tg + 1u) * nx) xb_add(&bar[XB_TOPGEN], 1u);
            else XB_SPIN(xb_ld(&bar[XB_TOPGEN]) == tg, bar);
            __builtin_amdgcn_fence(__ATOMIC_ACQUIRE, "agent");
            xb_add(&bar[XB_XGEN(b.x)], 1u);
            asm volatile("s_waitcnt vmcnt(0)" ::: "memory");
        } else {
            XB_SPIN(xb_ld(&bar[XB_XGEN(b.x)]) == gen, bar);
            __builtin_amdgcn_fence(__ATOMIC_ACQUIRE, "agent");
            asm volatile("s_waitcnt vmcnt(0)" ::: "memory");
        }
    }
    __syncthreads();
}

DI void phase_norm(const float* xp, const float* xs, const float* g, bf16_t* h) {
    const int tid_ = get_tid(), lane = tid_ & 63, gw = blockIdx.x * 4 + (tid_ >> 6), nw = gridDim.x * 4;
    for (int row = gw; row < NTOK; row += nw) {
        const float* src = row < NPR ? xp + (size_t)row * 1024 : xs + (size_t)(row - NPR) * 1024;
        float4 v[4]; float ss = 0.f;
#pragma unroll
        for (int i = 0; i < 4; ++i) { v[i] = *(const float4*)(src + i * 256 + lane * 4); ss += v[i].x * v[i].x + v[i].y * v[i].y + v[i].z * v[i].z + v[i].w * v[i].w; }
        ss = wave_sum(ss);
        const float r = rsqrtf(ss * (1.f / 1024.f) + 1e-6f);
#pragma unroll
        for (int i = 0; i < 4; ++i) {
            const float4 gg = *(const float4*)(g + i * 256 + lane * 4);
            u32x2 o; o.x = pack2(v[i].x * r * gg.x, v[i].y * r * gg.y); o.y = pack2(v[i].z * r * gg.z, v[i].w * r * gg.w);
            *(u32x2*)(h + (size_t)row * 1024 + i * 256 + lane * 4) = o;
        }
    }
}
DI void phase_final_norm(float* x, const float* g) {
    const int tid_ = get_tid(), lane = tid_ & 63, gw = blockIdx.x * 4 + (tid_ >> 6), nw = gridDim.x * 4;
    for (int row = gw; row < NTOK; row += nw) {
        float* src = x + (size_t)row * 1024;
        float4 v[4]; float ss = 0.f;
#pragma unroll
        for (int i = 0; i < 4; ++i) { v[i] = *(const float4*)(src + i * 256 + lane * 4); ss += v[i].x * v[i].x + v[i].y * v[i].y + v[i].z * v[i].z + v[i].w * v[i].w; }
        ss = wave_sum(ss);
        const float r = rsqrtf(ss * (1.f / 1024.f) + 1e-6f);
#pragma unroll
        for (int i = 0; i < 4; ++i) {
            const float4 gg = *(const float4*)(g + i * 256 + lane * 4);
            float4 o; o.x = v[i].x * r * gg.x; o.y = v[i].y * r * gg.y; o.z = v[i].z * r * gg.z; o.w = v[i].w * r * gg.w;
            *(float4*)(src + i * 256 + lane * 4) = o;
        }
    }
}

DI int map_row(int mode, int n) {
    if (mode == 0) return n;
    if (mode == 1) return ((n >> 4) << 5) + (n & 15);
    if (mode == 2) return ((n >> 4) << 5) + 16 + (n & 15);
    if (n < 2048) return n;
    if (n < 3072) return n + 1024;
    if (n < 3080) return n - 3072 + 5632;
    if (n < 4104) return n - 3080 + 2048;
    if (n < 5640) return n - 4104 + 4096;
    return n;
}
DI void cvt_job(const float* src, int K, int N, bf16_t* dst, int mode, int rot, char* smem) {
    float* tile = (float*)smem;
    const int tid = get_tid(), nkt = K >> 6, nnt = (N + 63) >> 6, ntiles = nkt * nnt;
    for (int t = (int)((blockIdx.x + rot) % gridDim.x); t < ntiles; t += gridDim.x) {
        const int kt = t % nkt, nt = t / nkt;
        __syncthreads();
#pragma unroll
        for (int i = 0; i < 4; ++i) {
            const int kl = (tid >> 4) + 16 * i, nl = (tid & 15) * 4, n = nt * 64 + nl;
            float4 v = make_float4(0.f, 0.f, 0.f, 0.f);
            if (n < N) v = *(const float4*)(src + (size_t)(kt * 64 + kl) * N + n);
            tile[kl * 65 + nl] = v.x; tile[kl * 65 + nl + 1] = v.y; tile[kl * 65 + nl + 2] = v.z; tile[kl * 65 + nl + 3] = v.w;
        }
        __syncthreads();
        const int nl = tid >> 2, kq = (tid & 3) * 16, n = nt * 64 + nl;
        if (n < N) {
            u32x4 o0, o1;
            o0.x = pack2(tile[(kq + 0) * 65 + nl], tile[(kq + 1) * 65 + nl]);   o0.y = pack2(tile[(kq + 2) * 65 + nl], tile[(kq + 3) * 65 + nl]);
            o0.z = pack2(tile[(kq + 4) * 65 + nl], tile[(kq + 5) * 65 + nl]);   o0.w = pack2(tile[(kq + 6) * 65 + nl], tile[(kq + 7) * 65 + nl]);
            o1.x = pack2(tile[(kq + 8) * 65 + nl], tile[(kq + 9) * 65 + nl]);   o1.y = pack2(tile[(kq + 10) * 65 + nl], tile[(kq + 11) * 65 + nl]);
            o1.z = pack2(tile[(kq + 12) * 65 + nl], tile[(kq + 13) * 65 + nl]); o1.w = pack2(tile[(kq + 14) * 65 + nl], tile[(kq + 15) * 65 + nl]);
            bf16_t* d = dst + (size_t)map_row(mode, n) * K + kt * 64 + kq;
            *(u32x4*)d = o0; *(u32x4*)(d + 8) = o1;
        }
    }
    __syncthreads();
}

struct Epi {
    bf16_t* o16; int ldc;
    float* o32;
    const float* rp; const float* rs; float scale;
    float* gates; bf16_t* halo; int cv0, cv1;
};
enum { EPI_GU = 0, EPI_RES = 1, EPI_PROJ = 2 };

template <int EPI>
DI void gemm_phase(const bf16_t* A, int lda, const bf16_t* Bt, int K, int nN, const Epi& e, char* smem) {
    const int tid = get_tid(), wid = tid >> 6, lane = tid & 63, wr = wid >> 1, wc = wid & 1, fr = lane & 15, fq = lane >> 4;
    const int G8 = gridDim.x >> 3, full = 8 * nN, ntiles = 129 * nN;
    for (int i = 0;; ++i) {
        const int Lt = (i * 8 + ((int)blockIdx.x & 7)) * G8 + ((int)blockIdx.x >> 3);
        if (i * (int)gridDim.x >= ntiles) break;
        if (Lt >= ntiles) continue;
        const int srow = Lt / full, rem = Lt - srow * full, hgt = (srow == 16) ? 1 : 8;
        const int scol = rem / (hgt * 8), rem2 = rem - scol * hgt * 8;
        const int pm = srow * 8 + rem2 % hgt, pn = scol * 8 + rem2 / hgt;
        f32x4 acc[4][4];
#pragma unroll
        for (int n = 0; n < 4; ++n)
#pragma unroll
            for (int m = 0; m < 4; ++m) acc[n][m] = (f32x4){0.f, 0.f, 0.f, 0.f};
        const bf16_t* Ab = A + (size_t)(pm * 128) * lda;
        const bf16_t* Bb = Bt + (size_t)(pn * 128) * K;
        const int nk = K >> 6;
        const int sr = tid >> 3, sgc = ((tid & 7) ^ (sr & 7)) * 8;
        const bf16_t* ap = Ab + (size_t)sr * lda + sgc;
        const bf16_t* bp = Bb + (size_t)sr * K + sgc;
        const size_t a32 = (size_t)32 * lda, b32 = (size_t)32 * K;
        __attribute__((address_space(3))) char* lbase = (__attribute__((address_space(3))) char*)smem + tid * 16;
#define GEMM_STAGE(BUF)                                                                                                         \
        {                                                                                                                        \
            _Pragma("unroll") for (int ii = 0; ii < 4; ++ii) {                                                                   \
                __builtin_amdgcn_global_load_lds((const unsigned*)(ap + ii * a32), (__attribute__((address_space(3))) unsigned*)(lbase + (BUF) * 32768 + ii * 4096), 16, 0, 0);          \
                __builtin_amdgcn_global_load_lds((const unsigned*)(bp + ii * b32), (__attribute__((address_space(3))) unsigned*)(lbase + (BUF) * 32768 + 16384 + ii * 4096), 16, 0, 0);  \
            }                                                                                                                    \
            ap += 64; bp += 64;                                                                                                  \
        }
#define GEMM_COMPUTE(BUF)                                                                                                       \
        {                                                                                                                        \
            const char* SA = smem + (BUF) * 32768; const char* SB = SA + 16384;                                                  \
            _Pragma("unroll") for (int ks = 0; ks < 2; ++ks) {                                                                   \
                bf16x8 af[4], bf[4];                                                                                             \
                const int sw = ((ks * 4 + fq) ^ (fr & 7)) << 4;                                                                  \
                _Pragma("unroll") for (int m = 0; m < 4; ++m) af[m] = *(const bf16x8*)(SA + (wr * 64 + m * 16 + fr) * 128 + sw); \
                _Pragma("unroll") for (int n = 0; n < 4; ++n) bf[n] = *(const bf16x8*)(SB + (wc * 64 + n * 16 + fr) * 128 + sw); \
                _Pragma("unroll") for (int n = 0; n < 4; ++n)                                                                    \
                    _Pragma("unroll") for (int m = 0; m < 4; ++m) acc[n][m] = mfma16(bf[n], af[m], acc[n][m]);                   \
            }                                                                                                                    \
        }
        __syncthreads();
        GEMM_STAGE(0)
        for (int kt = 0; kt < nk; kt += 2) {
            asm volatile("s_waitcnt vmcnt(0)" ::: "memory");
            __syncthreads();
            GEMM_STAGE(1)
            GEMM_COMPUTE(0)
            asm volatile("s_waitcnt vmcnt(0)" ::: "memory");
            __syncthreads();
            if (kt + 2 < nk) GEMM_STAGE(0)
            GEMM_COMPUTE(1)
        }
#pragma unroll
        for (int m = 0; m < 4; ++m) {
            const int row = pm * 128 + wr * 64 + m * 16 + fr;
            if (EPI == EPI_GU) {
#pragma unroll
                for (int i = 0; i < 2; ++i) {
                    const f32x4 g = acc[2 * i][m], u = acc[2 * i + 1][m];
                    u32x2 o; o.x = pack2(siluf(g[0]) * u[0], siluf(g[1]) * u[1]); o.y = pack2(siluf(g[2]) * u[2], siluf(g[3]) * u[3]);
                    *(u32x2*)(e.o16 + (size_t)row * e.ldc + pn * 64 + wc * 32 + i * 16 + 4 * fq) = o;
                }
            } else if (EPI == EPI_RES) {
                const float* rsrc = row < NPR ? e.rp + (size_t)row * 1024 : e.rs + (size_t)(row - NPR) * 1024;
#pragma unroll
                for (int n = 0; n < 4; ++n) {
                    const int col = pn * 128 + wc * 64 + n * 16 + 4 * fq;
                    const float4 r4 = *(const float4*)(rsrc + col);
                    float4 o; o.x = r4.x + e.scale * acc[n][m][0]; o.y = r4.y + e.scale * acc[n][m][1]; o.z = r4.z + e.scale * acc[n][m][2]; o.w = r4.w + e.scale * acc[n][m][3];
                    *(float4*)(e.o32 + (size_t)row * 1024 + col) = o;
                }
            } else {
                if (pn < nN - 1) {
                    int hr, unit;
                    if (row < NPR) { hr = (row & 63) - 61; unit = row >> 6; } else { hr = ((row - NPR) & 15) - 13; unit = 256 + ((row - NPR) >> 4); }
#pragma unroll
                    for (int n = 0; n < 4; ++n) {
                        const int col = pn * 128 + wc * 64 + n * 16 + 4 * fq;
                        u32x2 o; o.x = pack2(acc[n][m][0], acc[n][m][1]); o.y = pack2(acc[n][m][2], acc[n][m][3]);
                        *(u32x2*)(e.o16 + (size_t)row * e.ldc + col) = o;
                        if (hr >= 0 && col >= e.cv0 && col < e.cv1) *(u32x2*)(e.halo + ((size_t)unit * 3 + hr) * 3072 + (col - e.cv0)) = o;
                    }
                } else if (wc == 0) {
#pragma unroll
                    for (int n = 0; n < 2; ++n) {
                        float4 o; o.x = acc[n][m][0]; o.y = acc[n][m][1]; o.z = acc[n][m][2]; o.w = acc[n][m][3];
                        *(float4*)(e.gates + (size_t)row * 32 + n * 16 + 4 * fq) = o;
                    }
                }
            }
        }
    }
}


#define OFF_YS   16777216
#define OFF_PC   16908288
#define OFF_PN   17432576
#define OFF_PM   17434624
#define OFF_PSSD 17434640
#define OFF_PSC  17958928
#define OFF_PG   17977360
#define OFF_PGC  18501648
#define OFF_SC   18538512
#define OFF_SN   19587088
#define OFF_SM   19591184
#define OFF_SSSD 19591216
#define OFF_SSC  20639792
#define OFF_SG   20676656
#define OFF_SGC  21725232

DI float scan_add(float v, int lane) {
#pragma unroll
    for (int o = 1; o < 64; o <<= 1) { const float t = __shfl_up(v, o); if (lane >= o) v += t; }
    return v;
}
DI float scan_max(float v, int lane) {
#pragma unroll
    for (int o = 1; o < 64; o <<= 1) { const float t = __shfl_up(v, o); if (lane >= o) v = fmaxf(v, t); }
    return v;
}
DI u32x2 pack4(f32x4 v) { u32x2 o; o.x = pack2(v[0], v[1]); o.y = pack2(v[2], v[3]); return o; }
DI u32x4 pack8(const float* f) { u32x4 o; o.x = pack2(f[0], f[1]); o.y = pack2(f[2], f[3]); o.z = pack2(f[4], f[5]); o.w = pack2(f[6], f[7]); return o; }

DI void fill_cache_halo(const float* cache, int width, bf16_t* halo) {
    for (int i = blockIdx.x * 256 + get_tid(); i < 8 * 3 * width; i += gridDim.x * 256) {
        const int s = i / (3 * width), rem = i % (3 * width), r = rem / width, col = rem % width;
        halo[((size_t)(264 + s) * 3 + r) * 3072 + col] = f2bf(cache[i]);
    }
}

DI void phase_conv_ssd(const Params& p, bf16_t* BIG, const bf16_t* halo) {
    const int tid = get_tid(), cv = tid & 31, tg = tid >> 5;
    const float* cw = p.in[19]; const float* cb = p.in[20];
    for (int it = blockIdx.x; it < 264 * 6; it += gridDim.x) {
        const int unit = it / 6, cblk = it % 6, col = cblk * 256 + cv * 8;
        const bool smp = unit >= 256;
        const int L = smp ? 16 : 64, c = unit & 63, s = unit - 256;
        const size_t row0 = smp ? (size_t)NPR + s * 16 : (size_t)unit * 64;
        const bool act = tg * 8 < L;
        float x[11][8];
        if (act) {
#pragma unroll
            for (int i = 0; i < 11; ++i) {
                const int rl = tg * 8 - 3 + i;
                if (rl >= 0) { const u32x4 v = *(const u32x4*)(BIG + (row0 + rl) * 5632 + 4096 + col); unpack8(v, x[i]); }
                else if (!smp) {
                    if (c == 0) {
#pragma unroll
                        for (int j = 0; j < 8; ++j) x[i][j] = 0.f;
                    } else { const u32x4 v = *(const u32x4*)(halo + ((size_t)(unit - 1) * 3 + (rl + 3)) * 3072 + col); unpack8(v, x[i]); }
                } else {
                    const float* src = p.in[6] + ((size_t)s * 3 + (rl + 3)) * 1536 + col;
                    const float4 a = *(const float4*)src, b = *(const float4*)(src + 4);
                    x[i][0] = a.x; x[i][1] = a.y; x[i][2] = a.z; x[i][3] = a.w; x[i][4] = b.x; x[i][5] = b.y; x[i][6] = b.z; x[i][7] = b.w;
                }
            }
        }
        __syncthreads();
        if (act) {
            float w[4][8], bb[8];
#pragma unroll
            for (int i = 0; i < 4; ++i) {
                const float4 a = *(const float4*)(cw + i * 1536 + col), b = *(const float4*)(cw + i * 1536 + col + 4);
                w[i][0] = a.x; w[i][1] = a.y; w[i][2] = a.z; w[i][3] = a.w; w[i][4] = b.x; w[i][5] = b.y; w[i][6] = b.z; w[i][7] = b.w;
            }
            { const float4 a = *(const float4*)(cb + col), b = *(const float4*)(cb + col + 4);
              bb[0] = a.x; bb[1] = a.y; bb[2] = a.z; bb[3] = a.w; bb[4] = b.x; bb[5] = b.y; bb[6] = b.z; bb[7] = b.w; }
#pragma unroll
            for (int t = 0; t < 8; ++t) {
                float o[8];
#pragma unroll
                for (int j = 0; j < 8; ++j) { const float a = bb[j] + w[0][j] * x[t][j] + w[1][j] * x[t + 1][j] + w[2][j] * x[t + 2][j] + w[3][j] * x[t + 3][j]; o[j] = siluf(a); }
                *(u32x4*)(BIG + (row0 + tg * 8 + t) * 5632 + 4096 + col) = pack8(o);
            }
        }
        if ((smp || c == 63) && tid < 96) {
            const int i = tid >> 5;
            float f[8]; unpack8(*(const u32x4*)(halo + ((size_t)unit * 3 + i) * 3072 + col), f);
            float* dst = smp ? p.out + OFF_SSC + ((size_t)s * 3 + i) * 1536 + col : p.out + OFF_PSC + ((size_t)(unit >> 6) * 3 + i) * 1536 + col;
            *(float4*)dst = make_float4(f[0], f[1], f[2], f[3]); *(float4*)(dst + 4) = make_float4(f[4], f[5], f[6], f[7]);
        }
        __syncthreads();
    }
}

#define L_Q   0
#define L_K   17408
#define L_KT  34816
#define L_VT  53248
#define L_VW  55552
#define L_P   57856
#define L_ST  67072
#define L_F   71424

DI void mlstm_chain(const Params& p, bf16_t* BIG, const float* gates, int b, int hd, int es, bool smp, char* smem) {
    const int tid = get_tid(), wid = tid >> 6, lane = tid & 63, fr = lane & 15, fq = lane >> 4;
    bf16_t* Qs = (bf16_t*)(smem + L_Q); bf16_t* Ks = (bf16_t*)(smem + L_K); bf16_t* KTs = (bf16_t*)(smem + L_KT); bf16_t* VTs = (bf16_t*)(smem + L_VT);
    bf16_t* VWs = (bf16_t*)(smem + L_VW); bf16_t* Ps = (bf16_t*)(smem + L_P); bf16_t* STs = (bf16_t*)(smem + L_ST);
    float* fl = (float*)(smem + L_F);
    float* as_ = fl; float* Ms = fl + 64; float* bs = fl + 128; float* wrs = fl + 192; float* rsum = fl + 256; float* qns = fl + 320; float* ns = fl + 384; float* sc = fl + 512;
    const int L = smp ? 16 : 64, nch = smp ? 1 : 64, sidx = b * 4 + hd;
    const size_t row0 = smp ? (size_t)NPR + b * 16 : (size_t)b * 4096;
    const float bi = p.in[16][hd], bfg = p.in[17][hd];
    float m = 0.f, nreg = 0.f;
    f32x4 accC[2];
    accC[0] = (f32x4){0.f, 0.f, 0.f, 0.f}; accC[1] = accC[0];
    if (smp) {
        const float* C0 = p.in[2] + (size_t)sidx * 128 * 256;
#pragma unroll
        for (int mt = 0; mt < 2; ++mt)
#pragma unroll
            for (int j = 0; j < 4; ++j) accC[mt][j] = C0[(size_t)(32 * wid + 16 * mt + 4 * fq + j) * 256 + es * 16 + fr];
        if (tid < 128) nreg = p.in[3][sidx * 128 + tid];
        m = p.in[4][sidx];
    }
    __syncthreads();
#pragma unroll
    for (int mt = 0; mt < 2; ++mt) *(u32x2*)(STs + fr * 136 + 32 * wid + 16 * mt + 4 * fq) = pack4(accC[mt]);
    if (tid < 128) ns[tid] = nreg;

    u32x4 qv[4], kv[4], vv; float gi = 0.f, gf = 0.f;
    auto load = [&](int c) __attribute__((always_inline)) {
        const size_t r0 = row0 + (size_t)c * 64;
{
            const int r = tid >> 2, qt = tid & 3, rc = r < L ? r : L - 1;
            const bf16_t* qp = BIG + (r0 + rc) * 5632 + hd * 128 + qt * 32;
#pragma unroll
            for (int i = 0; i < 4; ++i) {
                qv[i] = *(const u32x4*)(qp + i * 8); kv[i] = *(const u32x4*)(qp + 512 + i * 8);
                if (r >= L) { qv[i] = (u32x4){0u, 0u, 0u, 0u}; kv[i] = (u32x4){0u, 0u, 0u, 0u}; }
            }
        }
        { const int r = (tid & 127) >> 1, cc = tid & 1, rc = r < L ? r : L - 1;
          vv = *(const u32x4*)(BIG + (r0 + rc) * 5632 + 1024 + hd * 256 + es * 16 + cc * 8);
          if (r >= L) vv = (u32x4){0u, 0u, 0u, 0u}; }
        { const int lc = lane < L ? lane : L - 1; gi = gates[(r0 + lc) * 32 + hd]; gf = gates[(r0 + lc) * 32 + 4 + hd]; }
    };
    load(0);
    for (int c = 0; c < nch; ++c) {
        __syncthreads();
        if (wid == 0) {
            float ig = -1e30f, lf = 0.f;
            if (lane < L) { ig = gi + bi; const float x = gf + bfg; lf = fminf(x, 0.f) - log1pf(__expf(-fabsf(x))); }
            const float bc = scan_add(lf, lane);
            const float a = ig - bc;
            const float pm = scan_max(a, lane);
            const float M = fmaxf(m, pm);
            const float Mlast = __shfl(M, L - 1), bL = __shfl(bc, L - 1);
            as_[lane] = a; Ms[lane] = M; bs[lane] = bc; wrs[lane] = lane < L ? __expf(a - Mlast) : 0.f;
            if (lane == 0) { sc[0] = Mlast; sc[1] = bL; }
        }
        __syncthreads();
{
            const int r = tid >> 2, qt = tid & 3;
            bf16_t* qd = Qs + r * 136 + qt * 32; bf16_t* kd = Ks + r * 136 + qt * 32; bf16_t* ktd = KTs + (qt * 32) * 72 + r;
#pragma unroll
            for (int i = 0; i < 4; ++i) {
                *(u32x4*)(qd + i * 8) = qv[i];
                float kf[8]; unpack8(kv[i], kf);
#pragma unroll
                for (int j = 0; j < 8; ++j) { kf[j] *= 0.08838834764831845f; ktd[(i * 8 + j) * 72] = f2bf(kf[j]); }
                *(u32x4*)(kd + i * 8) = pack8(kf);
            }
        }
        if (tid < 128) {
            const int r = tid >> 1, cc = tid & 1; const float w = wrs[r];
            float vf[8]; unpack8(vv, vf);
#pragma unroll
            for (int j = 0; j < 8; ++j) { VTs[(cc * 8 + j) * 72 + r] = f2bf(vf[j]); VWs[(cc * 8 + j) * 72 + r] = f2bf(vf[j] * w); }
        }
        if (c + 1 < nch) load(c + 1);
        __syncthreads();
        {
            f32x4 s4[4];
#pragma unroll
            for (int nt = 0; nt < 4; ++nt) s4[nt] = (f32x4){0.f, 0.f, 0.f, 0.f};
#pragma unroll 1
            for (int kk = 0; kk < 4; ++kk) {
                const bf16x8 qf = ldfrag(Qs, 136, 16 * wid + fr, kk * 32 + fq * 8);
#pragma unroll
                for (int nt = 0; nt < 4; ++nt) s4[nt] = mfma16(ldfrag(Ks, 136, 16 * nt + fr, kk * 32 + fq * 8), qf, s4[nt]);
            }
            const int s = 16 * wid + fr; const float Msv = Ms[s]; float rs = 0.f;
#pragma unroll
            for (int nt = 0; nt < 4; ++nt) {
                f32x4 pv;
#pragma unroll
                for (int j = 0; j < 4; ++j) { const int r = 16 * nt + 4 * fq + j; const float d = (r <= s) ? __expf(as_[r] - Msv) : 0.f; pv[j] = s4[nt][j] * d; rs += pv[j]; }
                *(u32x2*)(Ps + s * 72 + 16 * nt + 4 * fq) = pack4(pv);
            }
            rs += __shfl_xor(rs, 16); rs += __shfl_xor(rs, 32);
            if (fq == 0) rsum[s] = rs;
            const int s2 = tid >> 2, part = tid & 3; float qa = 0.f;
#pragma unroll
            for (int j = 0; j < 4; ++j) { float qf8[8]; unpack8(*(const u32x4*)(Qs + s2 * 136 + part * 32 + j * 8), qf8);
#pragma unroll
                for (int i = 0; i < 8; ++i) qa += qf8[i] * ns[part * 32 + j * 8 + i]; }
            qa += __shfl_xor(qa, 1); qa += __shfl_xor(qa, 2);
            if (part == 0) qns[s2] = qa;
        }
        __syncthreads();
        const float Mlast = sc[0], bL = sc[1];
        {
            f32x4 h1 = (f32x4){0.f, 0.f, 0.f, 0.f}, h2 = h1;
#pragma unroll
            for (int kk = 0; kk < 2; ++kk) h1 = mfma16(ldfrag(VTs, 72, fr, kk * 32 + fq * 8), ldfrag(Ps, 72, 16 * wid + fr, kk * 32 + fq * 8), h1);
#pragma unroll
            for (int kk = 0; kk < 4; ++kk) h2 = mfma16(ldfrag(STs, 136, fr, kk * 32 + fq * 8), ldfrag(Qs, 136, 16 * wid + fr, kk * 32 + fq * 8), h2);
            const int s = 16 * wid + fr; const float Msv = Ms[s], wi = __expf(m - Msv);
            const float den = rsum[s] + wi * qns[s], ms = bs[s] + Msv, inv = 1.f / fmaxf(fabsf(den), __expf(-ms));
            f32x4 hv;
#pragma unroll
            for (int j = 0; j < 4; ++j) hv[j] = (h1[j] + wi * h2[j]) * inv;
            if (s < L) *(u32x2*)(BIG + (row0 + (size_t)c * 64 + s) * 5632 + 1024 + hd * 256 + es * 16 + 4 * fq) = pack4(hv);
        }
        {
            const float decay = __expf(m - Mlast);
#pragma unroll
            for (int mt = 0; mt < 2; ++mt) {
                accC[mt] *= decay;
#pragma unroll
                for (int kk = 0; kk < 2; ++kk) accC[mt] = mfma16(ldfrag(KTs, 72, 32 * wid + 16 * mt + fr, kk * 32 + fq * 8), ldfrag(VWs, 72, fr, kk * 32 + fq * 8), accC[mt]);
            }
            if (tid < 128) {
                float sn = 0.f;
#pragma unroll
                for (int r8 = 0; r8 < 8; ++r8) { float kf[8]; unpack8(*(const u32x4*)(KTs + tid * 72 + r8 * 8), kf);
#pragma unroll
                    for (int i = 0; i < 8; ++i) sn += kf[i] * wrs[r8 * 8 + i]; }
                nreg = decay * nreg + sn;
            }
        }
        m = bL + Mlast;
        __syncthreads();
#pragma unroll
        for (int mt = 0; mt < 2; ++mt) *(u32x2*)(STs + fr * 136 + 32 * wid + 16 * mt + 4 * fq) = pack4(accC[mt]);
        if (tid < 128) ns[tid] = nreg;
    }
    float* Co = p.out + (smp ? OFF_SC : OFF_PC) + (size_t)sidx * 128 * 256;
#pragma unroll
    for (int mt = 0; mt < 2; ++mt)
#pragma unroll
        for (int j = 0; j < 4; ++j) Co[(size_t)(32 * wid + 16 * mt + 4 * fq + j) * 256 + es * 16 + fr] = accC[mt][j];
    if (es == 0) {
        if (tid < 128) p.out[(smp ? OFF_SN : OFF_PN) + sidx * 128 + tid] = nreg;
        if (tid == 0) p.out[(smp ? OFF_SM : OFF_PM) + sidx] = m;
    }
}

DI void ssd_chain(const Params& p, bf16_t* BIG, const float* gates, int b, int hd, int ps, bool smp, char* smem) {
    const int tid = get_tid(), wid = tid >> 6, lane = tid & 63, fr = lane & 15, fq = lane >> 4;
    bf16_t* Cs = (bf16_t*)(smem + L_Q); bf16_t* Bs = (bf16_t*)(smem + L_K); bf16_t* BTs = (bf16_t*)(smem + L_KT); bf16_t* XTs = (bf16_t*)(smem + L_VT);
    bf16_t* XWs = (bf16_t*)(smem + L_VW); bf16_t* Ps = (bf16_t*)(smem + L_P); bf16_t* STs = (bf16_t*)(smem + L_ST);
    float* fl = (float*)(smem + L_F);
    float* bs = fl; float* dts = fl + 64; float* wrs = fl + 128; float* sc = fl + 192;
    const int L = smp ? 16 : 64, nch = smp ? 1 : 64, sidx = b * 16 + hd, g = hd >> 3;
    const size_t row0 = smp ? (size_t)NPR + b * 16 : (size_t)b * 4096;
    const float dtb = p.in[21][hd], negA = -__expf(p.in[22][hd]), Dk = p.in[23][hd];
    f32x4 accS[2];
    accS[0] = (f32x4){0.f, 0.f, 0.f, 0.f}; accS[1] = accS[0];
    if (smp) {
        const float* S0 = p.in[5] + (size_t)sidx * 64 * 128;
#pragma unroll
        for (int i = 0; i < 2; ++i)
#pragma unroll
            for (int j = 0; j < 4; ++j) accS[i][j] = S0[(size_t)(ps * 16 + fr) * 128 + 16 * (2 * wid + i) + 4 * fq + j];
    }
    __syncthreads();
#pragma unroll
    for (int i = 0; i < 2; ++i) *(u32x2*)(STs + fr * 136 + 16 * (2 * wid + i) + 4 * fq) = pack4(accS[i]);

    u32x4 qv[4], kv[4], vv; float gd = 0.f;
    auto load = [&](int c) __attribute__((always_inline)) {
        const size_t r0 = row0 + (size_t)c * 64;
{
            const int r = tid >> 2, qt = tid & 3, rc = r < L ? r : L - 1;
            const bf16_t* bp = BIG + (r0 + rc) * 5632 + 5120 + g * 128 + qt * 32;
#pragma unroll
            for (int i = 0; i < 4; ++i) {
                qv[i] = *(const u32x4*)(bp + 256 + i * 8); kv[i] = *(const u32x4*)(bp + i * 8);
                if (r >= L) { qv[i] = (u32x4){0u, 0u, 0u, 0u}; kv[i] = (u32x4){0u, 0u, 0u, 0u}; }
            }
        }
        { const int r = (tid & 127) >> 1, cc = tid & 1, rc = r < L ? r : L - 1;
          vv = *(const u32x4*)(BIG + (r0 + rc) * 5632 + 4096 + hd * 64 + ps * 16 + cc * 8);
          if (r >= L) vv = (u32x4){0u, 0u, 0u, 0u}; }
        { const int lc = lane < L ? lane : L - 1; gd = gates[(r0 + lc) * 32 + 8 + hd]; }
    };
    load(0);
    for (int c = 0; c < nch; ++c) {
        __syncthreads();
        if (wid == 0) {
            float dtv = 0.f;
            if (lane < L) dtv = softplusf(gd + dtb);
            const float a = negA * dtv;
            const float bc = scan_add(a, lane);
            const float bL = __shfl(bc, L - 1);
            bs[lane] = bc; dts[lane] = dtv; wrs[lane] = __expf(bL - bc) * dtv;
            if (lane == 0) sc[1] = bL;
        }
        __syncthreads();
{
            const int r = tid >> 2, qt = tid & 3;
            bf16_t* qd = Cs + r * 136 + qt * 32; bf16_t* kd = Bs + r * 136 + qt * 32; bf16_t* ktd = BTs + (qt * 32) * 72 + r;
#pragma unroll
            for (int i = 0; i < 4; ++i) {
                *(u32x4*)(qd + i * 8) = qv[i];
                *(u32x4*)(kd + i * 8) = kv[i];
                const unsigned kw[4] = {kv[i].x, kv[i].y, kv[i].z, kv[i].w};
#pragma unroll
                for (int j = 0; j < 4; ++j) { ktd[(i * 8 + 2 * j) * 72] = (bf16_t)(kw[j] & 0xffffu); ktd[(i * 8 + 2 * j + 1) * 72] = (bf16_t)(kw[j] >> 16); }
            }
        }
        if (tid < 128) {
            const int r = tid >> 1, cc = tid & 1; const float w = wrs[r];
            float vf[8]; unpack8(vv, vf);
#pragma unroll
            for (int j = 0; j < 8; ++j) { XTs[(cc * 8 + j) * 72 + r] = f2bf(vf[j]); XWs[(cc * 8 + j) * 72 + r] = f2bf(vf[j] * w); }
        }
        if (c + 1 < nch) load(c + 1);
        __syncthreads();
        {
            f32x4 s4[4];
#pragma unroll
            for (int nt = 0; nt < 4; ++nt) s4[nt] = (f32x4){0.f, 0.f, 0.f, 0.f};
#pragma unroll 1
            for (int kk = 0; kk < 4; ++kk) {
                const bf16x8 qf = ldfrag(Cs, 136, 16 * wid + fr, kk * 32 + fq * 8);
#pragma unroll
                for (int nt = 0; nt < 4; ++nt) s4[nt] = mfma16(ldfrag(Bs, 136, 16 * nt + fr, kk * 32 + fq * 8), qf, s4[nt]);
            }
            const int s = 16 * wid + fr; const float bsv = bs[s];
#pragma unroll
            for (int nt = 0; nt < 4; ++nt) {
                f32x4 pv;
#pragma unroll
                for (int j = 0; j < 4; ++j) { const int r = 16 * nt + 4 * fq + j; const float d = (r <= s) ? __expf(bsv - bs[r]) * dts[r] : 0.f; pv[j] = s4[nt][j] * d; }
                *(u32x2*)(Ps + s * 72 + 16 * nt + 4 * fq) = pack4(pv);
            }
        }
        __syncthreads();
        const float bL = sc[1];
        {
            f32x4 h1 = (f32x4){0.f, 0.f, 0.f, 0.f}, h2 = h1;
#pragma unroll
            for (int kk = 0; kk < 2; ++kk) h1 = mfma16(ldfrag(XTs, 72, fr, kk * 32 + fq * 8), ldfrag(Ps, 72, 16 * wid + fr, kk * 32 + fq * 8), h1);
#pragma unroll
            for (int kk = 0; kk < 4; ++kk) h2 = mfma16(ldfrag(STs, 136, fr, kk * 32 + fq * 8), ldfrag(Cs, 136, 16 * wid + fr, kk * 32 + fq * 8), h2);
            const int s = 16 * wid + fr; const float eb = __expf(bs[s]);
            if (s < L) {
                bf16_t* zp = BIG + (row0 + (size_t)c * 64 + s) * 5632 + 2048 + hd * 64 + ps * 16 + 4 * fq;
                const u32x2 zr = *(const u32x2*)zp;
                const float zf[4] = {lo2f(zr.x), hi2f(zr.x), lo2f(zr.y), hi2f(zr.y)};
                f32x4 yv;
#pragma unroll
                for (int j = 0; j < 4; ++j) { const float xv = bf2f(XTs[(4 * fq + j) * 72 + s]); yv[j] = (h1[j] + eb * h2[j] + Dk * xv) * siluf(zf[j]); }
                *(u32x2*)zp = pack4(yv);
            }
        }
        {
            const float dec = __expf(bL);
#pragma unroll
            for (int i = 0; i < 2; ++i) {
                accS[i] *= dec;
#pragma unroll
                for (int kk = 0; kk < 2; ++kk) accS[i] = mfma16(ldfrag(BTs, 72, 16 * (2 * wid + i) + fr, kk * 32 + fq * 8), ldfrag(XWs, 72, fr, kk * 32 + fq * 8), accS[i]);
            }
        }
        __syncthreads();
#pragma unroll
        for (int i = 0; i < 2; ++i) *(u32x2*)(STs + fr * 136 + 16 * (2 * wid + i) + 4 * fq) = pack4(accS[i]);
    }
    float* So = p.out + (smp ? OFF_SSSD : OFF_PSSD) + (size_t)sidx * 64 * 128;
#pragma unroll
    for (int i = 0; i < 2; ++i) {
        float4 o; o.x = accS[i][0]; o.y = accS[i][1]; o.z = accS[i][2]; o.w = accS[i][3];
        *(float4*)(So + (size_t)(ps * 16 + fr) * 128 + 16 * (2 * wid + i) + 4 * fq) = o;
    }
}

DI void phase_scan_l0(const Params& p, bf16_t* BIG, const float* gates, char* smem) {
    for (int it = blockIdx.x; it < 1536; it += gridDim.x) {
        const bool smp = it >= 512;
        const int j = it & 255, k = smp ? (it - 512) & 511 : j;
#ifndef NO_MLSTM
        if (it < 256 || (smp && it < 1024)) mlstm_chain(p, BIG, gates, k >> 6, (k >> 4) & 3, k & 15, smp, smem);
#endif
#ifndef NO_SSD
        if ((it >= 256 && it < 512) || it >= 1024) ssd_chain(p, BIG, gates, k >> 6, (k >> 2) & 15, k & 3, smp, smem);
#endif
    }
}

DI void phase_post_l0(const Params& p, bf16_t* BIG) {
    const int tid_ = get_tid(), lane = tid_ & 63, gw = blockIdx.x * 4 + (tid_ >> 6), nw = gridDim.x * 4;
    for (int row = gw; row < NTOK; row += nw) {
        bf16_t* rp = BIG + (size_t)row * 5632;
#pragma unroll
        for (int hd = 0; hd < 4; ++hd) {
            const u32x2 rv = *(const u32x2*)(rp + 1024 + hd * 256 + lane * 4), ov = *(const u32x2*)(rp + 3072 + hd * 256 + lane * 4);
            const float x[4] = {lo2f(rv.x), hi2f(rv.x), lo2f(rv.y), hi2f(rv.y)}, o[4] = {lo2f(ov.x), hi2f(ov.x), lo2f(ov.y), hi2f(ov.y)};
            const float ss = wave_sum(x[0] * x[0] + x[1] * x[1] + x[2] * x[2] + x[3] * x[3]);
            const float r = rsqrtf(ss * (1.f / 256.f) + 1e-6f);
            const float4 gg = *(const float4*)(p.in[18] + hd * 256 + lane * 4);
            f32x4 y; y[0] = sigmf(o[0]) * x[0] * r * gg.x; y[1] = sigmf(o[1]) * x[1] * r * gg.y; y[2] = sigmf(o[2]) * x[2] * r * gg.z; y[3] = sigmf(o[3]) * x[3] * r * gg.w;
            *(u32x2*)(rp + 1024 + hd * 256 + lane * 4) = pack4(y);
        }
#pragma unroll
        for (int g = 0; g < 2; ++g) {
            float x[8]; unpack8(*(const u32x4*)(rp + 2048 + g * 512 + lane * 8), x);
            float ss = 0.f;
#pragma unroll
            for (int j = 0; j < 8; ++j) ss += x[j] * x[j];
            ss = wave_sum(ss);
            const float r = rsqrtf(ss * (1.f / 512.f) + 1e-6f);
            const float4 g0 = *(const float4*)(p.in[24] + g * 512 + lane * 8), g1 = *(const float4*)(p.in[24] + g * 512 + lane * 8 + 4);
            float y[8] = {x[0] * r * g0.x, x[1] * r * g0.y, x[2] * r * g0.z, x[3] * r * g0.w, x[4] * r * g1.x, x[5] * r * g1.y, x[6] * r * g1.z, x[7] * r * g1.w};
            *(u32x4*)(rp + 2048 + g * 512 + lane * 8) = pack8(y);
        }
    }
}

#define G_QN  0
#define G_KN  18432
#define G_VT  18432
#define G_AT  36864
#define G_VN  53504
#define G_TV  53504
#define G_TW  62720
#define G_F   71936
DI void gdn_g1_item(const Params& p, bf16_t* BIG, bf16_t* Wb, bf16_t* PB, const float* gates, const bf16_t* halo, float* egl, int unit, int hd, char* smem) {
    const int tid = get_tid(), wid = tid >> 6, lane = tid & 63, fr = lane & 15, fq = lane >> 4;
    bf16_t* Qn = (bf16_t*)(smem + G_QN); bf16_t* Kn = (bf16_t*)(smem + G_KN); bf16_t* KTs = (bf16_t*)(smem + G_QN); bf16_t* VTs = (bf16_t*)(smem + G_VT);
    bf16_t* Vn = (bf16_t*)(smem + G_VN);
    float* AT = (float*)(smem + G_AT); bf16_t* Tv = (bf16_t*)(smem + G_TV); bf16_t* Tw = (bf16_t*)(smem + G_TW);
    float* beta_s = (float*)(smem + G_F); float* gam_s = beta_s + 64;
    const bool smp = unit >= 256;
    const int L = smp ? 16 : 64, c = unit & 63, s_ = unit - 256;
    const size_t row0 = smp ? (size_t)NPR + s_ * 16 : (size_t)unit * 64;
    const int tok = tid >> 2, qt = tid & 3;
    const float* cw = p.in[27];
    const bf16_t* hp = halo + (size_t)(smp ? 264 + s_ : (unit > 0 ? unit - 1 : 0)) * 3 * 3072;
    const bool zh = !smp && c == 0;
    __syncthreads();
    if (wid == 0) {
        float beta = 0.f, g = 0.f;
        const int lc = lane < L ? lane : L - 1;
        const float br = gates[(row0 + lc) * 32 + hd], ar = gates[(row0 + lc) * 32 + 8 + hd];
        if (lane < L) { beta = sigmf(br); g = -__expf(p.in[29][hd]) * softplusf(ar + p.in[28][hd]); }
        const float gam = scan_add(g, lane);
        beta_s[lane] = beta; gam_s[lane] = gam;
        if (lane == L - 1) egl[unit * 8 + hd] = __expf(gam);
    }
#pragma unroll 1
    for (int mi = 0; mi < 3; ++mi) {
        float o[32];
#pragma unroll
        for (int j = 0; j < 4; ++j) {
            const int col = mi * 1024 + hd * 128 + qt * 32 + j * 8;
            float a8[8];
#pragma unroll
            for (int q = 0; q < 8; ++q) a8[q] = 0.f;
#pragma unroll
            for (int i = 0; i < 4; ++i) {
                const int tc = tok < L ? tok : L - 1, rlc = tc - 3 + i;
                const bf16_t* src = rlc >= 0 ? BIG + (row0 + rlc) * 4096 + col : hp + (rlc + 3) * 3072 + col;
                u32x4 xv = *(const u32x4*)src;
                if (rlc < 0 && zh) xv = (u32x4){0u, 0u, 0u, 0u};
                float xf[8]; unpack8(xv, xf);
                const float4 w0 = *(const float4*)(cw + i * 3072 + col), w1 = *(const float4*)(cw + i * 3072 + col + 4);
                a8[0] += w0.x * xf[0]; a8[1] += w0.y * xf[1]; a8[2] += w0.z * xf[2]; a8[3] += w0.w * xf[3];
                a8[4] += w1.x * xf[4]; a8[5] += w1.y * xf[5]; a8[6] += w1.z * xf[6]; a8[7] += w1.w * xf[7];
            }
#pragma unroll
            for (int q = 0; q < 8; ++q) o[j * 8 + q] = siluf(a8[q]);
        }
        if (mi < 2) {
            float ss = 0.f;
#pragma unroll
            for (int q = 0; q < 32; ++q) ss += o[q] * o[q];
            ss += __shfl_xor(ss, 1); ss += __shfl_xor(ss, 2);
            const float sc = rsqrtf(ss + 1e-6f) * (mi == 0 ? 0.08838834764831845f : 1.f);
#pragma unroll
            for (int q = 0; q < 32; ++q) o[q] *= sc;
        }
        if (tok >= L) {
#pragma unroll
            for (int q = 0; q < 32; ++q) o[q] = 0.f;
        }
        bf16_t* dst = (mi == 0 ? Qn : (mi == 1 ? Kn : Vn)) + tok * 136 + qt * 32;
#pragma unroll
        for (int j = 0; j < 4; ++j) *(u32x4*)(dst + j * 8) = pack8(o + j * 8);
    }
    __syncthreads();
    {
        f32x4 a4[4], p4[4];
#pragma unroll
        for (int nt = 0; nt < 4; ++nt) { a4[nt] = (f32x4){0.f, 0.f, 0.f, 0.f}; p4[nt] = a4[nt]; }
#pragma unroll 1
        for (int kk = 0; kk < 4; ++kk) {
            const bf16x8 qf = ldfrag(Qn, 136, 16 * wid + fr, kk * 32 + fq * 8), ksf = ldfrag(Kn, 136, 16 * wid + fr, kk * 32 + fq * 8);
#pragma unroll
            for (int nt = 0; nt < 4; ++nt) { const bf16x8 kf = ldfrag(Kn, 136, 16 * nt + fr, kk * 32 + fq * 8); a4[nt] = mfma16(kf, ksf, a4[nt]); p4[nt] = mfma16(kf, qf, p4[nt]); }
        }
        const int s = 16 * wid + fr; const float gs = gam_s[s], bsv = beta_s[s];
#pragma unroll
        for (int nt = 0; nt < 4; ++nt) {
            f32x4 pv;
#pragma unroll
            for (int j = 0; j < 4; ++j) {
                const int r = 16 * nt + 4 * fq + j;
                const float d = (r <= s) ? __expf(gs - gam_s[r]) : 0.f;
                pv[j] = p4[nt][j] * d;
                AT[s * 65 + r] = (r < s) ? a4[nt][j] * d * bsv : 0.f;
            }
            if (s < L) *(u32x2*)(PB + (row0 + s) * 512 + hd * 64 + 16 * nt + 4 * fq) = pack4(pv);
        }
    }
    __syncthreads();
    if (tok < L) {
        const float eg = __expf(gam_s[tok]);
#pragma unroll
        for (int j = 0; j < 4; ++j) {
            float qf8[8]; unpack8(*(const u32x4*)(Qn + tok * 136 + qt * 32 + j * 8), qf8);
#pragma unroll
            for (int q = 0; q < 8; ++q) qf8[q] *= eg;
            *(u32x4*)(BIG + (row0 + tok) * 4096 + hd * 128 + qt * 32 + j * 8) = pack8(qf8);
        }
    }
    __syncthreads();
    {
        u32x4 kk4[4];
#pragma unroll
        for (int j = 0; j < 4; ++j) kk4[j] = *(const u32x4*)(Kn + tok * 136 + qt * 32 + j * 8);
        bf16_t* ktd = KTs + (qt * 32) * 72 + tok;
#pragma unroll
        for (int j = 0; j < 4; ++j) {
            const unsigned kw[4] = {kk4[j].x, kk4[j].y, kk4[j].z, kk4[j].w};
#pragma unroll
            for (int q = 0; q < 4; ++q) { ktd[(j * 8 + 2 * q) * 72] = (bf16_t)(kw[q] & 0xffffu); ktd[(j * 8 + 2 * q + 1) * 72] = (bf16_t)(kw[q] >> 16); }
        }
    }
    __syncthreads();
    {
        u32x4 vv4[4];
#pragma unroll
        for (int j = 0; j < 4; ++j) vv4[j] = *(const u32x4*)(Vn + tok * 136 + qt * 32 + j * 8);
        bf16_t* vtd = VTs + (qt * 32) * 72 + tok;
#pragma unroll
        for (int j = 0; j < 4; ++j) {
            const unsigned vw[4] = {vv4[j].x, vv4[j].y, vv4[j].z, vv4[j].w};
#pragma unroll
            for (int q = 0; q < 4; ++q) { vtd[(j * 8 + 2 * q) * 72] = (bf16_t)(vw[q] & 0xffffu); vtd[(j * 8 + 2 * q + 1) * 72] = (bf16_t)(vw[q] >> 16); }
        }
    }
    __syncthreads();
    if (wid == 0) {
        const int j = lane;
        for (int s = 0; s < 64; ++s) {
            float acc = (s == j) ? 1.f : 0.f;
            for (int r = 0; r < s; ++r) acc -= AT[s * 65 + r] * AT[r * 65 + j];
            AT[s * 65 + j] = acc;
        }
        const float bj = beta_s[j], bej = bj * __expf(gam_s[j]);
        for (int s = 0; s < 64; ++s) { const float t = AT[s * 65 + j]; Tv[s * 72 + j] = f2bf(t * bj); Tw[s * 72 + j] = f2bf(t * bej); }
    }
    __syncthreads();
    {
        const int s = 16 * wid + fr;
        const bf16x8 tw0 = ldfrag(Tw, 72, s, fq * 8), tw1 = ldfrag(Tw, 72, s, 32 + fq * 8), tv0 = ldfrag(Tv, 72, s, fq * 8), tv1 = ldfrag(Tv, 72, s, 32 + fq * 8);
#pragma unroll 2
        for (int nt = 0; nt < 8; ++nt) {
            f32x4 w4 = (f32x4){0.f, 0.f, 0.f, 0.f}, u4 = w4;
            w4 = mfma16(ldfrag(KTs, 72, 16 * nt + fr, fq * 8), tw0, w4); w4 = mfma16(ldfrag(KTs, 72, 16 * nt + fr, 32 + fq * 8), tw1, w4);
            u4 = mfma16(ldfrag(VTs, 72, 16 * nt + fr, fq * 8), tv0, u4); u4 = mfma16(ldfrag(VTs, 72, 16 * nt + fr, 32 + fq * 8), tv1, u4);
            if (s < L) {
                *(u32x2*)(Wb + (row0 + s) * 1024 + hd * 128 + 16 * nt + 4 * fq) = pack4(w4);
                *(u32x2*)(BIG + (row0 + s) * 4096 + 2048 + hd * 128 + 16 * nt + 4 * fq) = pack4(u4);
            }
        }
        const float gL = gam_s[L - 1];
#pragma unroll
        for (int i = 0; i < 4; ++i) {
            const int idx = tid + 256 * i, d = idx >> 3, r8 = idx & 7;
            if (r8 * 8 < L) {
                float kf[8]; unpack8(*(const u32x4*)(KTs + d * 72 + r8 * 8), kf);
#pragma unroll
                for (int q = 0; q < 8; ++q) kf[q] *= __expf(gL - gam_s[r8 * 8 + q]);
                const int e = d * L + r8 * 8;
                *(u32x4*)(BIG + (row0 + (e >> 7)) * 4096 + 1024 + hd * 128 + (e & 127)) = pack8(kf);
            }
        }
        if ((smp || c == 63) && tid < 144) {
            const int i = tid / 48, rem = tid % 48, col = (rem >> 4) * 1024 + hd * 128 + (rem & 15) * 8;
            float f[8]; unpack8(*(const u32x4*)(halo + ((size_t)unit * 3 + i) * 3072 + col), f);
            float* dst = smp ? p.out + OFF_SGC + ((size_t)s_ * 3 + i) * 3072 + col : p.out + OFF_PGC + ((size_t)(unit >> 6) * 3 + i) * 3072 + col;
            *(float4*)dst = make_float4(f[0], f[1], f[2], f[3]); *(float4*)(dst + 4) = make_float4(f[4], f[5], f[6], f[7]);
        }
    }
}

struct GdnFrags { bf16x8 w[4], q[4], p[2], kt[2][2]; u32x2 u0; float eg; };
DI void gdn_chain(const Params& p, bf16_t* BIG, const bf16_t* Wb, const bf16_t* PB, const float* egl, int b, int hd, int es, bool smp, char* smem) {
    const int tid = get_tid(), wid = tid >> 6, lane = tid & 63, fr = lane & 15, fq = lane >> 4;
    bf16_t* UT0 = (bf16_t*)smem;
    bf16_t* ST0 = (bf16_t*)(smem + 4608);
    const int L = smp ? 16 : 64, nch = smp ? 1 : 64, sidx = b * 8 + hd;
    const size_t row0 = smp ? (size_t)NPR + b * 16 : (size_t)b * 4096;
    const bf16x8 z8 = (bf16x8){0, 0, 0, 0, 0, 0, 0, 0};
    f32x4 accS[2];
    accS[0] = (f32x4){0.f, 0.f, 0.f, 0.f}; accS[1] = accS[0];
    if (smp) {
        const float* S0 = p.in[7] + (size_t)sidx * 128 * 128;
#pragma unroll
        for (int mt = 0; mt < 2; ++mt)
#pragma unroll
            for (int j = 0; j < 4; ++j) accS[mt][j] = S0[(size_t)(32 * wid + 16 * mt + 4 * fq + j) * 128 + es * 16 + fr];
    }
    __syncthreads();
#pragma unroll
    for (int mt = 0; mt < 2; ++mt) *(u32x2*)(ST0 + fr * 136 + 32 * wid + 16 * mt + 4 * fq) = pack4(accS[mt]);
    const int s = 16 * wid + fr, sc_ = s < L ? s : L - 1;
    const bool valid = s < L;
    auto load = [&](int c, GdnFrags& F) __attribute__((always_inline)) {
        const size_t r0 = row0 + (size_t)c * 64;
        const bf16_t* wp = Wb + (r0 + sc_) * 1024 + hd * 128 + fq * 8;
        const bf16_t* qp = BIG + (r0 + sc_) * 4096 + hd * 128 + fq * 8;
        const bf16_t* pp = PB + (r0 + sc_) * 512 + hd * 64 + fq * 8;
#pragma unroll
        for (int kk = 0; kk < 4; ++kk) { F.w[kk] = *(const bf16x8*)(wp + kk * 32); F.q[kk] = *(const bf16x8*)(qp + kk * 32); if (!valid) { F.w[kk] = z8; F.q[kk] = z8; } }
#pragma unroll
        for (int kk = 0; kk < 2; ++kk) { F.p[kk] = *(const bf16x8*)(pp + kk * 32); if (!valid) F.p[kk] = z8; }
#pragma unroll
        for (int mt = 0; mt < 2; ++mt)
#pragma unroll
            for (int kk = 0; kk < 2; ++kk) {
                const int d = 32 * wid + 16 * mt + fr, r = kk * 32 + fq * 8, rc = r < L ? r : 0, e = d * L + rc;
                F.kt[mt][kk] = *(const bf16x8*)(BIG + (r0 + (e >> 7)) * 4096 + 1024 + hd * 128 + (e & 127));
                if (r >= L) F.kt[mt][kk] = z8;
            }
        F.u0 = *(const u32x2*)(BIG + (r0 + sc_) * 4096 + 2048 + hd * 128 + es * 16 + 4 * fq);
        if (!valid) F.u0 = (u32x2){0u, 0u};
        F.eg = egl[(smp ? 256 + b : b * 64 + c) * 8 + hd];
    };
    GdnFrags cur; load(0, cur);
    __syncthreads();
    for (int c = 0; c < nch; ++c) {
        GdnFrags nxt = cur;
        if (c + 1 < nch) load(c + 1, nxt);
        const bf16_t* STc = ST0 + (c & 1) * (16 * 136); bf16_t* STn = ST0 + ((c + 1) & 1) * (16 * 136);
        bf16_t* UTc = UT0 + (c & 1) * (16 * 72);
        bf16x8 sf[4];
#pragma unroll
        for (int kk = 0; kk < 4; ++kk) sf[kk] = ldfrag(STc, 136, fr, kk * 32 + fq * 8);
        {
            f32x4 w4 = (f32x4){0.f, 0.f, 0.f, 0.f};
#pragma unroll
            for (int kk = 0; kk < 4; ++kk) w4 = mfma16(sf[kk], cur.w[kk], w4);
            const float uf[4] = {lo2f(cur.u0.x) - w4[0], hi2f(cur.u0.x) - w4[1], lo2f(cur.u0.y) - w4[2], hi2f(cur.u0.y) - w4[3]};
#pragma unroll
            for (int j = 0; j < 4; ++j) UTc[(4 * fq + j) * 72 + s] = f2bf(uf[j]);
        }
        __syncthreads();
        {
            f32x4 o4 = (f32x4){0.f, 0.f, 0.f, 0.f};
#pragma unroll
            for (int kk = 0; kk < 4; ++kk) o4 = mfma16(sf[kk], cur.q[kk], o4);
            bf16x8 uf8[2];
#pragma unroll
            for (int kk = 0; kk < 2; ++kk) { uf8[kk] = ldfrag(UTc, 72, fr, kk * 32 + fq * 8); o4 = mfma16(uf8[kk], cur.p[kk], o4); }
            if (valid) *(u32x2*)(BIG + (row0 + (size_t)c * 64 + s) * 4096 + 2048 + hd * 128 + es * 16 + 4 * fq) = pack4(o4);
#pragma unroll
            for (int mt = 0; mt < 2; ++mt) {
                accS[mt] *= cur.eg;
#pragma unroll
                for (int kk = 0; kk < 2; ++kk) accS[mt] = mfma16(cur.kt[mt][kk], uf8[kk], accS[mt]);
                *(u32x2*)(STn + fr * 136 + 32 * wid + 16 * mt + 4 * fq) = pack4(accS[mt]);
            }
        }
        __syncthreads();
        cur = nxt;
    }
    float* So = p.out + (smp ? OFF_SG : OFF_PG) + (size_t)sidx * 128 * 128;
#pragma unroll
    for (int mt = 0; mt < 2; ++mt)
#pragma unroll
        for (int j = 0; j < 4; ++j) So[(size_t)(32 * wid + 16 * mt + 4 * fq + j) * 128 + es * 16 + fr] = accS[mt][j];
}

DI void phase_post_l1(const Params& p, bf16_t* BIG) {
    const int tid_ = get_tid(), lane = tid_ & 63, gw = blockIdx.x * 4 + (tid_ >> 6), nw = gridDim.x * 4;
    const int hd = lane >> 3, e0 = (lane & 7) * 16;
    for (int row = gw; row < NTOK; row += nw) {
        bf16_t* op = BIG + (size_t)row * 4096 + 2048 + hd * 128 + e0;
        const bf16_t* zp = BIG + (size_t)row * 4096 + 3072 + hd * 128 + e0;
        float x[16], z[16];
        unpack8(*(const u32x4*)op, x); unpack8(*(const u32x4*)(op + 8), x + 8);
        unpack8(*(const u32x4*)zp, z); unpack8(*(const u32x4*)(zp + 8), z + 8);
        float ss = 0.f;
#pragma unroll
        for (int j = 0; j < 16; ++j) ss += x[j] * x[j];
        ss += __shfl_xor(ss, 1); ss += __shfl_xor(ss, 2); ss += __shfl_xor(ss, 4);
        const float r = rsqrtf(ss * (1.f / 128.f) + 1e-6f);
        float y[16];
#pragma unroll
        for (int j = 0; j < 16; ++j) y[j] = x[j] * r * p.in[30][e0 + j] * siluf(z[j]);
        *(u32x4*)op = pack8(y); *(u32x4*)(op + 8) = pack8(y + 8);
    }
}

__global__ void __launch_bounds__(256, 2) fwd_megakernel(Params p) {
    __shared__ __attribute__((aligned(16))) char smem[LDS_BYTES];
    cg::grid_group grid = cg::this_grid();
    char* ws = p.ws;
    if (ws == nullptr) grid.sync();
    if (threadIdx.x < 4) ((volatile LAS unsigned*)(smem + LDS_BYTES - 16))[threadIdx.x] = 0u;
    __syncthreads();
    const XcdBarrier xb = xcd_barrier_post((unsigned*)(ws + WS_BAR), (volatile LAS unsigned*)(smem + LDS_BYTES - 16));
    bf16_t* WGU = (bf16_t*)(ws + WS_WGU); bf16_t* WD = (bf16_t*)(ws + WS_WD); bf16_t* WIN = (bf16_t*)(ws + WS_WIN); bf16_t* WOUT = (bf16_t*)(ws + WS_WOUT);
    bf16_t* H = (bf16_t*)(ws + WS_H); bf16_t* BIG = (bf16_t*)(ws + WS_BIG); float* GATES = (float*)(ws + WS_GATES); bf16_t* HALO = (bf16_t*)(ws + WS_HALO); float* EGL = (float*)(ws + WS_EGL);
    bf16_t* PB = BIG + (size_t)NTOK * 4096;
    float* X = p.out; float* XS = p.out + (size_t)NPR * 1024;
    const float* ng = p.in[9];
    const size_t FW = (size_t)1024 * 2816;
    Epi e{};
    phase_norm(p.in[0], p.in[1], ng, H);
    cvt_job(p.in[11], 1024, 2816, WGU, 1, 0, smem);
    cvt_job(p.in[12], 1024, 2816, WGU, 2, 100, smem);
    cvt_job(p.in[13], 2816, 1024, WD, 0, 200, smem);
    cvt_job(p.in[14], 1024, 5656, WIN, 3, 300, smem);
    cvt_job(p.in[15], 2048, 1024, WOUT, 0, 400, smem);
    xcd_barrier(xb);
    e.o16 = BIG; e.ldc = 2816;
    gemm_phase<EPI_GU>(H, 1024, WGU, 1024, 44, e, smem);
    xcd_barrier(xb);
    e.o32 = X; e.rp = p.in[0]; e.rs = p.in[1]; e.scale = 0.5f;
    gemm_phase<EPI_RES>(BIG, 2816, WD, 2816, 8, e, smem);
    xcd_barrier(xb);
    phase_norm(X, XS, ng + 1024, H);
    cvt_job(p.in[11] + FW, 1024, 2816, WGU, 1, 0, smem);
    cvt_job(p.in[12] + FW, 1024, 2816, WGU, 2, 100, smem);
    cvt_job(p.in[13] + FW, 2816, 1024, WD, 0, 200, smem);
    xcd_barrier(xb);
    e.o16 = BIG; e.ldc = 5632; e.gates = GATES; e.halo = HALO; e.cv0 = 4096; e.cv1 = 5632;
    gemm_phase<EPI_PROJ>(H, 1024, WIN, 1024, 45, e, smem);
    xcd_barrier(xb);
#if PHM & 1
    phase_conv_ssd(p, BIG, HALO);
#endif
    xcd_barrier(xb);
#if PHM & 2
    phase_scan_l0(p, BIG, GATES, smem);
#endif
    xcd_barrier(xb);
    phase_post_l0(p, BIG);
    xcd_barrier(xb);
    e.o32 = X; e.rp = X; e.rs = XS; e.scale = 1.0f;
    gemm_phase<EPI_RES>(BIG + 1024, 5632, WOUT, 2048, 8, e, smem);
    xcd_barrier(xb);
    phase_norm(X, XS, ng + 2048, H);
    xcd_barrier(xb);
    e.o16 = BIG; e.ldc = 2816;
    gemm_phase<EPI_GU>(H, 1024, WGU, 1024, 44, e, smem);
    xcd_barrier(xb);
    e.scale = 0.5f;
    gemm_phase<EPI_RES>(BIG, 2816, WD, 2816, 8, e, smem);
    xcd_barrier(xb);
    phase_norm(X, XS, ng + 3072, H);
    cvt_job(p.in[11] + 2 * FW, 1024, 2816, WGU, 1, 0, smem);
    cvt_job(p.in[12] + 2 * FW, 1024, 2816, WGU, 2, 100, smem);
    cvt_job(p.in[13] + 2 * FW, 2816, 1024, WD, 0, 200, smem);
    cvt_job(p.in[25], 1024, 4112, WIN, 0, 300, smem);
    cvt_job(p.in[26], 1024, 1024, WOUT, 0, 400, smem);
    xcd_barrier(xb);
    gemm_phase<EPI_GU>(H, 1024, WGU, 1024, 44, e, smem);
    xcd_barrier(xb);
    gemm_phase<EPI_RES>(BIG, 2816, WD, 2816, 8, e, smem);
    xcd_barrier(xb);
    phase_norm(X, XS, ng + 4096, H);
    fill_cache_halo(p.in[8], 3072, HALO);
    cvt_job(p.in[11] + 3 * FW, 1024, 2816, WGU, 1, 0, smem);
    cvt_job(p.in[12] + 3 * FW, 1024, 2816, WGU, 2, 100, smem);
    cvt_job(p.in[13] + 3 * FW, 2816, 1024, WD, 0, 200, smem);
    xcd_barrier(xb);
    e.o16 = BIG; e.ldc = 4096; e.cv0 = 0; e.cv1 = 3072;
    gemm_phase<EPI_PROJ>(H, 1024, WIN, 1024, 33, e, smem);
    xcd_barrier(xb);
#if PHM & 4
    for (int it = blockIdx.x; it < 264 * 8; it += gridDim.x) gdn_g1_item(p, BIG, H, PB, GATES, HALO, EGL, it >> 3, it & 7, smem);
#endif
    xcd_barrier(xb);
#if PHM & 8
    for (int it = blockIdx.x; it < 768; it += gridDim.x) {
        const bool smp = it >= 256; const int j = smp ? it - 256 : it;
        gdn_chain(p, BIG, H, PB, EGL, j >> 6, (j >> 3) & 7, j & 7, smp, smem);
    }
#endif
    xcd_barrier(xb);
    phase_post_l1(p, BIG);
    xcd_barrier(xb);
    e.scale = 1.0f;
    gemm_phase<EPI_RES>(BIG + 2048, 4096, WOUT, 1024, 8, e, smem);
    xcd_barrier(xb);
    phase_norm(X, XS, ng + 5120, H);
    xcd_barrier(xb);
    e.o16 = BIG; e.ldc = 2816;
    gemm_phase<EPI_GU>(H, 1024, WGU, 1024, 44, e, smem);
    xcd_barrier(xb);
    e.scale = 0.5f;
    gemm_phase<EPI_RES>(BIG, 2816, WD, 2816, 8, e, smem);
    xcd_barrier(xb);
    phase_final_norm(X, p.in[10]);
}

extern "C" void kernel_launch(void* const* d_in, const int* in_sizes, int n_in, void* d_out, int out_size, void* d_ws, size_t ws_size, hipStream_t stream) {
    static int grid_blocks = 0;
    if (!grid_blocks) {
        int dev = 0, cus = 0, per_cu = 0;
        hipGetDevice(&dev);
        hipDeviceGetAttribute(&cus, hipDeviceAttributeMultiprocessorCount, dev);
        hipOccupancyMaxActiveBlocksPerMultiprocessor(&per_cu, fwd_megakernel, 256, 0);
        if (per_cu > 2) per_cu = 2;
        if (per_cu < 1) per_cu = 1;
        grid_blocks = cus * per_cu;
    }
    Params p{};
    for (int i = 0; i < 31; ++i) p.in[i] = (const float*)d_in[i];
    p.out = (float*)d_out;
    p.ws = (char*)d_ws;
    (void)hipMemsetAsync((char*)d_ws + WS_BAR, 0, 16384, stream);
    void* args[] = {&p};
    hipError_t err = hipLaunchCooperativeKernel((void*)fwd_megakernel, dim3(grid_blocks), dim3(256), args, 0, stream);
    if (err != hipSuccess) fprintf(stderr, "cooperative launch failed: %s (grid %d)\n", hipGetErrorString(err), grid_blocks);
}
```

```cpp
#include <hip/hip_runtime.h>
#include <hip/hip_cooperative_groups.h>
#include <cstdio>
namespace cg = cooperative_groups;

typedef unsigned short bf16_t;
typedef short bf16x8 __attribute__((ext_vector_type(8)));
typedef float f32x4 __attribute__((ext_vector_type(4)));
typedef unsigned u32x2 __attribute__((ext_vector_type(2)));
typedef unsigned u32x4 __attribute__((ext_vector_type(4)));

#define DI __device__ __forceinline__
#define NTOK 16512
#define NPR 16384
#define LDS_BYTES 75776
#ifndef PHM
#define PHM 15
#endif

#define WS_WGU   0ull
#define WS_WD    (WS_WGU + 5632ull * 1024 * 2)
#define WS_WIN   (WS_WD + 1024ull * 2816 * 2)
#define WS_WOUT  (WS_WIN + 5760ull * 1024 * 2)
#define WS_H     (WS_WOUT + 1024ull * 2048 * 2)
#define WS_BIG   (WS_H + 16512ull * 1024 * 2)
#define WS_GATES (WS_BIG + 16512ull * 5632 * 2)
#define WS_HALO  (WS_GATES + 16512ull * 32 * 4)
#define WS_EGL   (WS_HALO + 272ull * 3 * 3072 * 2)
#define WS_BAR   (WS_EGL + 272ull * 8 * 4)
#define WS_END   (WS_BAR + 16384ull)

struct Params {
    const float* in[31];
    float* out;
    char* ws;
};

DI int get_tid() { int t = threadIdx.x; asm volatile("" : "+v"(t)); return t; }
DI bf16_t f2bf(float f) { unsigned u = __float_as_uint(f); u += 0x7fffu + ((u >> 16) & 1u); return (bf16_t)(u >> 16); }
DI float bf2f(bf16_t h) { return __uint_as_float(((unsigned)h) << 16); }
DI unsigned pack2(float lo, float hi) { return (unsigned)f2bf(lo) | ((unsigned)f2bf(hi) << 16); }
DI float lo2f(unsigned u) { return __uint_as_float(u << 16); }
DI float hi2f(unsigned u) { return __uint_as_float(u & 0xffff0000u); }
DI float siluf(float x) { return x / (1.f + __expf(-x)); }
DI float sigmf(float x) { return 1.f / (1.f + __expf(-x)); }
DI float softplusf(float x) { return fmaxf(x, 0.f) + log1pf(__expf(-fabsf(x))); }
DI f32x4 mfma16(bf16x8 a, bf16x8 b, f32x4 c) { return __builtin_amdgcn_mfma_f32_16x16x32_bf16(a, b, c, 0, 0, 0); }
DI bf16x8 ldfrag(const bf16_t* base, int ld, int row, int k) { return *(const bf16x8*)(base + row * ld + k); }
DI void unpack8(u32x4 v, float* f) {
    f[0] = lo2f(v.x); f[1] = hi2f(v.x); f[2] = lo2f(v.y); f[3] = hi2f(v.y);
    f[4] = lo2f(v.z); f[5] = hi2f(v.z); f[6] = lo2f(v.w); f[7] = hi2f(v.w);
}
DI float wave_sum(float v) {
#pragma unroll
    for (int o = 32; o >= 1; o >>= 1) v += __shfl_xor(v, o);
    return v;
}


#define XB_TMO      128
#define XB_XCNT(j)  (256  + 64 * (j))
#define XB_XSUB(j)  (1280 + 64 * (j))
#define XB_XGEN(j)  (2304 + 64 * (j))
#define XB_TOP      3328
#define XB_TOPGEN   3392
#define XCD_BAR_WORDS 3456
#define XB_SPIN_CAP (1u << 18)
#define LAS __attribute__((address_space(3)))
DI unsigned xb_ld(unsigned* p)              { return __hip_atomic_load(p, __ATOMIC_RELAXED, __HIP_MEMORY_SCOPE_AGENT); }
DI unsigned xb_add(unsigned* p, unsigned v) { return __hip_atomic_fetch_add(p, v, __ATOMIC_RELAXED, __HIP_MEMORY_SCOPE_AGENT); }
DI unsigned xb_xcc_id() { return (unsigned)__builtin_amdgcn_s_getreg((3 << 11) | 20) & 0xFu; }
#define XB_SPIN(cond, bar) do { unsigned _sp = 0; while (cond) { __builtin_amdgcn_s_sleep(1); \
    if ((++_sp & 255u) == 0u) { if (xb_ld(&(bar)[XB_TMO])) break; if (_sp > XB_SPIN_CAP) { atomicAdd(&(bar)[XB_TMO], 1u); break; } } } } while (0)
struct XcdBarrier { unsigned* bar; unsigned x; volatile LAS unsigned* st; };
DI XcdBarrier xcd_barrier_post(unsigned* bar, volatile LAS unsigned* st) {
    XcdBarrier b; b.bar = bar; b.x = xb_xcc_id(); b.st = st;
    if (threadIdx.x == 0) (void)xb_add(&bar[XB_XCNT(b.x)], 1u);
    return b;
}
DI void xcd_barrier_complete(unsigned* bar, unsigned x, unsigned& nloc, unsigned& nx) {
    const unsigned G = gridDim.x * gridDim.y * gridDim.z;
    unsigned sum, cnt, mine, sp = 0u;
    for (;;) {
        sum = 0u; cnt = 0u; mine = 0u;
#pragma unroll
        for (unsigned j = 0; j < 16; ++j) { const unsigned c = xb_ld(&bar[XB_XCNT(j)]); sum += c; cnt += (c > 0u) ? 1u : 0u; mine = (j == x) ? c : mine; }
        if (sum == G) break;
        __builtin_amdgcn_s_sleep(1);
        if ((++sp & 255u) == 0u) { if (xb_ld(&bar[XB_TMO])) break; if (sp > XB_SPIN_CAP) { atomicAdd(&bar[XB_TMO], 1u); break; } }
    }
    nloc = mine > 0u ? mine : 1u; nx = cnt > 0u ? cnt : 1u;
}
DI void xcd_barrier(const XcdBarrier& b) {
    asm volatile("s_waitcnt vmcnt(0)" ::: "memory");
    __syncthreads();
    if (threadIdx.x == 0) {
        unsigned* bar = b.bar;
        __builtin_amdgcn_s_waitcnt(0);
        unsigned nloc = b.st[0], nx = b.st[1];
        if (nloc == 0u) { xcd_barrier_complete(bar, b.x, nloc, nx); b.st[0] = nloc; b.st[1] = nx; }
        const unsigned old = xb_add(&bar[XB_XSUB(b.x)], 1u);
        const unsigned gen = old / nloc;
        if (old + 1u == (gen + 1u) * nloc) {
            __builtin_amdgcn_fence(__ATOMIC_RELEASE, "agent");
            asm volatile("s_waitcnt vmcnt(0)" ::: "memory");
            const unsigned og = xb_add(&bar[XB_TOP], 1u);
            const unsigned tg = og / nx;
            if (og + 1u == (tg + 1u) * nx) xb_add(&bar[XB_TOPGEN], 1u);
            else XB_SPIN(xb_ld(&bar[XB_TOPGEN]) == tg, bar);
            __builtin_amdgcn_fence(__ATOMIC_ACQUIRE, "agent");
            xb_add(&bar[XB_XGEN(b.x)], 1u);
            asm volatile("s_waitcnt vmcnt(0)" ::: "memory");
        } else {
            XB_SPIN(xb_ld(&bar[XB_XGEN(b.x)]) == gen, bar);
            __builtin_amdgcn_fence(__ATOMIC_ACQUIRE, "agent");
            asm volatile("s_waitcnt vmcnt(0)" ::: "memory");
        }
    }
    __syncthreads();
}

DI void phase_norm(const float* xp, const float* xs, const float* g, bf16_t* h) {
    const int tid_ = get_tid(), lane = tid_ & 63, gw = blockIdx.x * 4 + (tid_ >> 6), nw = gridDim.x * 4;
    for (int row = gw; row < NTOK; row += nw) {
        const float* src = row < NPR ? xp + (size_t)row * 1024 : xs + (size_t)(row - NPR) * 1024;
        float4 v[4]; float ss = 0.f;
#pragma unroll
        for (int i = 0; i < 4; ++i) { v[i] = *(const float4*)(src + i * 256 + lane * 4); ss += v[i].x * v[i].x + v[i].y * v[i].y + v[i].z * v[i].z + v[i].w * v[i].w; }
        ss = wave_sum(ss);
        const float r = rsqrtf(ss * (1.f / 1024.f) + 1e-6f);
#pragma unroll
        for (int i = 0; i < 4; ++i) {
            const float4 gg = *(const float4*)(g + i * 256 + lane * 4);
            u32x2 o; o.x = pack2(v[i].x * r * gg.x, v[i].y * r * gg.y); o.y = pack2(v[i].z * r * gg.z, v[i].w * r * gg.w);
            *(u32x2*)(h + (size_t)row * 1024 + i * 256 + lane * 4) = o;
        }
    }
}
DI void phase_final_norm(float* x, const float* g) {
    const int tid_ = get_tid(), lane = tid_ & 63, gw = blockIdx.x * 4 + (tid_ >> 6), nw = gridDim.x * 4;
    for (int row = gw; row < NTOK; row += nw) {
        float* src = x + (size_t)row * 1024;
        float4 v[4]; float ss = 0.f;
#pragma unroll
        for (int i = 0; i < 4; ++i) { v[i] = *(const float4*)(src + i * 256 + lane * 4); ss += v[i].x * v[i].x + v[i].y * v[i].y + v[i].z * v[i].z + v[i].w * v[i].w; }
        ss = wave_sum(ss);
        const float r = rsqrtf(ss * (1.f / 1024.f) + 1e-6f);
#pragma unroll
        for (int i = 0; i < 4; ++i) {
            const float4 gg = *(const float4*)(g + i * 256 + lane * 4);
            float4 o; o.x = v[i].x * r * gg.x; o.y = v[i].y * r * gg.y; o.z = v[i].z * r * gg.z; o.w = v[i].w * r * gg.w;
            *(float4*)(src + i * 256 + lane * 4) = o;
        }
    }
}

DI int map_row(int mode, int n) {
    if (mode == 0) return n;
    if (mode == 1) return ((n >> 4) << 5) + (n & 15);
    if (mode == 2) return ((n >> 4) << 5) + 16 + (n & 15);
    if (n < 2048) return n;
    if (n < 3072) return n + 1024;
    if (n < 3080) return n - 3072 + 5632;
    if (n < 4104) return n - 3080 + 2048;
    if (n < 5640) return n - 4104 + 4096;
    return n;
}
DI void cvt_job(const float* src, int K, int N, bf16_t* dst, int mode, int rot, char* smem) {
    float* tile = (float*)smem;
    const int tid = get_tid(), nkt = K >> 6, nnt = (N + 63) >> 6, ntiles = nkt * nnt;
    for (int t = (int)((blockIdx.x + rot) % gridDim.x); t < ntiles; t += gridDim.x) {
        const int kt = t % nkt, nt = t / nkt;
        __syncthreads();
#pragma unroll
        for (int i = 0; i < 4; ++i) {
            const int kl = (tid >> 4) + 16 * i, nl = (tid & 15) * 4, n = nt * 64 + nl;
            float4 v = make_float4(0.f, 0.f, 0.f, 0.f);
            if (n < N) v = *(const float4*)(src + (size_t)(kt * 64 + kl) * N + n);
            tile[kl * 65 + nl] = v.x; tile[kl * 65 + nl + 1] = v.y; tile[kl * 65 + nl + 2] = v.z; tile[kl * 65 + nl + 3] = v.w;
        }
        __syncthreads();
        const int nl = tid >> 2, kq = (tid & 3) * 16, n = nt * 64 + nl;
        if (n < N) {
            u32x4 o0, o1;
            o0.x = pack2(tile[(kq + 0) * 65 + nl], tile[(kq + 1) * 65 + nl]);   o0.y = pack2(tile[(kq + 2) * 65 + nl], tile[(kq + 3) * 65 + nl]);
            o0.z = pack2(tile[(kq + 4) * 65 + nl], tile[(kq + 5) * 65 + nl]);   o0.w = pack2(tile[(kq + 6) * 65 + nl], tile[(kq + 7) * 65 + nl]);
            o1.x = pack2(tile[(kq + 8) * 65 + nl], tile[(kq + 9) * 65 + nl]);   o1.y = pack2(tile[(kq + 10) * 65 + nl], tile[(kq + 11) * 65 + nl]);
            o1.z = pack2(tile[(kq + 12) * 65 + nl], tile[(kq + 13) * 65 + nl]); o1.w = pack2(tile[(kq + 14) * 65 + nl], tile[(kq + 15) * 65 + nl]);
            bf16_t* d = dst + (size_t)map_row(mode, n) * K + kt * 64 + kq;
            *(u32x4*)d = o0; *(u32x4*)(d + 8) = o1;
        }
    }
    __syncthreads();
}

struct Epi {
    bf16_t* o16; int ldc;
    float* o32;
    const float* rp; const float* rs; float scale;
    float* gates; bf16_t* halo; int cv0, cv1;
};
enum { EPI_GU = 0, EPI_RES = 1, EPI_PROJ = 2 };

template <int EPI>
DI void gemm_phase(const bf16_t* A, int lda, const bf16_t* Bt, int K, int nN, const Epi& e, char* smem) {
    const int tid = get_tid(), wid = tid >> 6, lane = tid & 63, wr = wid >> 1, wc = wid & 1, fr = lane & 15, fq = lane >> 4;
    const int G8 = gridDim.x >> 3, full = 8 * nN, ntiles = 129 * nN;
    for (int i = 0;; ++i) {
        const int Lt = (i * 8 + ((int)blockIdx.x & 7)) * G8 + ((int)blockIdx.x >> 3);
        if (i * (int)gridDim.x >= ntiles) break;
        if (Lt >= ntiles) continue;
        const int srow = Lt / full, rem = Lt - srow * full, hgt = (srow == 16) ? 1 : 8;
        const int scol = rem / (hgt * 8), rem2 = rem - scol * hgt * 8;
        const int pm = srow * 8 + rem2 % hgt, pn = scol * 8 + rem2 / hgt;
        f32x4 acc[4][4];
#pragma unroll
        for (int n = 0; n < 4; ++n)
#pragma unroll
            for (int m = 0; m < 4; ++m) acc[n][m] = (f32x4){0.f, 0.f, 0.f, 0.f};
        const bf16_t* Ab = A + (size_t)(pm * 128) * lda;
        const bf16_t* Bb = Bt + (size_t)(pn * 128) * K;
        const int nk = K >> 6;
        const int sr = tid >> 3, sgc = ((tid & 7) ^ (sr & 7)) * 8;
        const bf16_t* ap = Ab + (size_t)sr * lda + sgc;
        const bf16_t* bp = Bb + (size_t)sr * K + sgc;
        const size_t a32 = (size_t)32 * lda, b32 = (size_t)32 * K;
        __attribute__((address_space(3))) char* lbase = (__attribute__((address_space(3))) char*)smem + tid * 16;
#define GEMM_STAGE(BUF)                                                                                                         \
        {                                                                                                                        \
            _Pragma("unroll") for (int ii = 0; ii < 4; ++ii) {                                                                   \
                __builtin_amdgcn_global_load_lds((const unsigned*)(ap + ii * a32), (__attribute__((address_space(3))) unsigned*)(lbase + (BUF) * 32768 + ii * 4096), 16, 0, 0);          \
                __builtin_amdgcn_global_load_lds((const unsigned*)(bp + ii * b32), (__attribute__((address_space(3))) unsigned*)(lbase + (BUF) * 32768 + 16384 + ii * 4096), 16, 0, 0);  \
            }                                                                                                                    \
            ap += 64; bp += 64;                                                                                                  \
        }
#define GEMM_COMPUTE(BUF)                                                                                                       \
        {                                                                                                                        \
            const char* SA = smem + (BUF) * 32768; const char* SB = SA + 16384;                                                  \
            _Pragma("unroll") for (int ks = 0; ks < 2; ++ks) {                                                                   \
                bf16x8 af[4], bf[4];                                                                                             \
                const int sw = ((ks * 4 + fq) ^ (fr & 7)) << 4;                                                                  \
                _Pragma("unroll") for (int m = 0; m < 4; ++m) af[m] = *(const bf16x8*)(SA + (wr * 64 + m * 16 + fr) * 128 + sw); \
                _Pragma("unroll") for (int n = 0; n < 4; ++n) bf[n] = *(const bf16x8*)(SB + (wc * 64 + n * 16 + fr) * 128 + sw); \
                _Pragma("unroll") for (int n = 0; n < 4; ++n)                                                                    \
                    _Pragma("unroll") for (int m = 0; m < 4; ++m) acc[n][m] = mfma16(bf[n], af[m], acc[n][m]);                   \
            }                                                                                                                    \
        }
        __syncthreads();
        GEMM_STAGE(0)
        for (int kt = 0; kt < nk; kt += 2) {
            asm volatile("s_waitcnt vmcnt(0)" ::: "memory");
            __syncthreads();
            GEMM_STAGE(1)
            GEMM_COMPUTE(0)
            asm volatile("s_waitcnt vmcnt(0)" ::: "memory");
            __syncthreads();
            if (kt + 2 < nk) GEMM_STAGE(0)
            GEMM_COMPUTE(1)
        }
#pragma unroll
        for (int m = 0; m < 4; ++m) {
            const int row = pm * 128 + wr * 64 + m * 16 + fr;
            if (EPI == EPI_GU) {
#pragma unroll
                for (int i = 0; i < 2; ++i) {
                    const f32x4 g = acc[2 * i][m], u = acc[2 * i + 1][m];
                    u32x2 o; o.x = pack2(siluf(g[0]) * u[0], siluf(g[1]) * u[1]); o.y = pack2(siluf(g[2]) * u[2], siluf(g[3]) * u[3]);
                    *(u32x2*)(e.o16 + (size_t)row * e.ldc + pn * 64 + wc * 32 + i * 16 + 4 * fq) = o;
                }
            } else if (EPI == EPI_RES) {
                const float* rsrc = row < NPR ? e.rp + (size_t)row * 1024 : e.rs + (size_t)(row - NPR) * 1024;
#pragma unroll
                for (int n = 0; n < 4; ++n) {
                    const int col = pn * 128 + wc * 64 + n * 16 + 4 * fq;
                    const float4 r4 = *(const float4*)(rsrc + col);
                    float4 o; o.x = r4.x + e.scale * acc[n][m][0]; o.y = r4.y + e.scale * acc[n][m][1]; o.z = r4.z + e.scale * acc[n][m][2]; o.w = r4.w + e.scale * acc[n][m][3];
                    *(float4*)(e.o32 + (size_t)row * 1024 + col) = o;
                }
            } else {
                if (pn < nN - 1) {
                    int hr, unit;
                    if (row < NPR) { hr = (row & 63) - 61; unit = row >> 6; } else { hr = ((row - NPR) & 15) - 13; unit = 256 + ((row - NPR) >> 4); }
#pragma unroll
                    for (int n = 0; n < 4; ++n) {
                        const int col = pn * 128 + wc * 64 + n * 16 + 4 * fq;
                        u32x2 o; o.x = pack2(acc[n][m][0], acc[n][m][1]); o.y = pack2(acc[n][m][2], acc[n][m][3]);
                        *(u32x2*)(e.o16 + (size_t)row * e.ldc + col) = o;
                        if (hr >= 0 && col >= e.cv0 && col < e.cv1) *(u32x2*)(e.halo + ((size_t)unit * 3 + hr) * 3072 + (col - e.cv0)) = o;
                    }
                } else if (wc == 0) {
#pragma unroll
                    for (int n = 0; n < 2; ++n) {
                        float4 o; o.x = acc[n][m][0]; o.y = acc[n][m][1]; o.z = acc[n][m][2]; o.w = acc[n][m][3];
                        *(float4*)(e.gates + (size_t)row * 32 + n * 16 + 4 * fq) = o;
                    }
                }
            }
        }
    }
}


#define OFF_YS   16777216
#define OFF_PC   16908288
#define OFF_PN   17432576
#define OFF_PM   17434624
#define OFF_PSSD 17434640
#define OFF_PSC  17958928
#define OFF_PG   17977360
#define OFF_PGC  18501648
#define OFF_SC   18538512
#define OFF_SN   19587088
#define OFF_SM   19591184
#define OFF_SSSD 19591216
#define OFF_SSC  20639792
#define OFF_SG   20676656
#define OFF_SGC  21725232

DI float scan_add(float v, int lane) {
#pragma unroll
    for (int o = 1; o < 64; o <<= 1) { const float t = __shfl_up(v, o); if (lane >= o) v += t; }
    return v;
}
DI float scan_max(float v, int lane) {
#pragma unroll
    for (int o = 1; o < 64; o <<= 1) { const float t = __shfl_up(v, o); if (lane >= o) v = fmaxf(v, t); }
    return v;
}
DI u32x2 pack4(f32x4 v) { u32x2 o; o.x = pack2(v[0], v[1]); o.y = pack2(v[2], v[3]); return o; }
DI u32x4 pack8(const float* f) { u32x4 o; o.x = pack2(f[0], f[1]); o.y = pack2(f[2], f[3]); o.z = pack2(f[4], f[5]); o.w = pack2(f[6], f[7]); return o; }

DI void fill_cache_halo(const float* cache, int width, bf16_t* halo) {
    for (int i = blockIdx.x * 256 + get_tid(); i < 8 * 3 * width; i += gridDim.x * 256) {
        const int s = i / (3 * width), rem = i % (3 * width), r = rem / width, col = rem % width;
        halo[((size_t)(264 + s) * 3 + r) * 3072 + col] = f2bf(cache[i]);
    }
}

DI void phase_conv_ssd(const Params& p, bf16_t* BIG, const bf16_t* halo) {
    const int tid = get_tid(), cv = tid & 31, tg = tid >> 5;
    const float* cw = p.in[19]; const float* cb = p.in[20];
    for (int it = blockIdx.x; it < 264 * 6; it += gridDim.x) {
        const int unit = it / 6, cblk = it % 6, col = cblk * 256 + cv * 8;
        const bool smp = unit >= 256;
        const int L = smp ? 16 : 64, c = unit & 63, s = unit - 256;
        const size_t row0 = smp ? (size_t)NPR + s * 16 : (size_t)unit * 64;
        const bool act = tg * 8 < L;
        float x[11][8];
        if (act) {
#pragma unroll
            for (int i = 0; i < 11; ++i) {
                const int rl = tg * 8 - 3 + i;
                if (rl >= 0) { const u32x4 v = *(const u32x4*)(BIG + (row0 + rl) * 5632 + 4096 + col); unpack8(v, x[i]); }
                else if (!smp) {
                    if (c == 0) {
#pragma unroll
                        for (int j = 0; j < 8; ++j) x[i][j] = 0.f;
                    } else { const u32x4 v = *(const u32x4*)(halo + ((size_t)(unit - 1) * 3 + (rl + 3)) * 3072 + col); unpack8(v, x[i]); }
                } else {
                    const float* src = p.in[6] + ((size_t)s * 3 + (rl + 3)) * 1536 + col;
                    const float4 a = *(const float4*)src, b = *(const float4*)(src + 4);
                    x[i][0] = a.x; x[i][1] = a.y; x[i][2] = a.z; x[i][3] = a.w; x[i][4] = b.x; x[i][5] = b.y; x[i][6] = b.z; x[i][7] = b.w;
                }
            }
        }
        __syncthreads();
        if (act) {
            float w[4][8], bb[8];
#pragma unroll
            for (int i = 0; i < 4; ++i) {
                const float4 a = *(const float4*)(cw + i * 1536 + col), b = *(const float4*)(cw + i * 1536 + col + 4);
                w[i][0] = a.x; w[i][1] = a.y; w[i][2] = a.z; w[i][3] = a.w; w[i][4] = b.x; w[i][5] = b.y; w[i][6] = b.z; w[i][7] = b.w;
            }
            { const float4 a = *(const float4*)(cb + col), b = *(const float4*)(cb + col + 4);
              bb[0] = a.x; bb[1] = a.y; bb[2] = a.z; bb[3] = a.w; bb[4] = b.x; bb[5] = b.y; bb[6] = b.z; bb[7] = b.w; }
#pragma unroll
            for (int t = 0; t < 8; ++t) {
                float o[8];
#pragma unroll
                for (int j = 0; j < 8; ++j) { const float a = bb[j] + w[0][j] * x[t][j] + w[1][j] * x[t + 1][j] + w[2][j] * x[t + 2][j] + w[3][j] * x[t + 3][j]; o[j] = siluf(a); }
                *(u32x4*)(BIG + (row0 + tg * 8 + t) * 5632 + 4096 + col) = pack8(o);
            }
        }
        if ((smp || c == 63) && tid < 96) {
            const int i = tid >> 5;
            float f[8]; unpack8(*(const u32x4*)(halo + ((size_t)unit * 3 + i) * 3072 + col), f);
            float* dst = smp ? p.out + OFF_SSC + ((size_t)s * 3 + i) * 1536 + col : p.out + OFF_PSC + ((size_t)(unit >> 6) * 3 + i) * 1536 + col;
            *(float4*)dst = make_float4(f[0], f[1], f[2], f[3]); *(float4*)(dst + 4) = make_float4(f[4], f[5], f[6], f[7]);
        }
        __syncthreads();
    }
}

#define L_Q   0
#define L_K   17408
#define L_KT  34816
#define L_VT  53248
#define L_VW  55552
#define L_P   57856
#define L_ST  67072
#define L_F   71424

DI void mlstm_chain(const Params& p, bf16_t* BIG, const float* gates, int b, int hd, int es, bool smp, char* smem, bool live) {
    const int tid = get_tid(), wid = tid >> 6, lane = tid & 63, fr = lane & 15, fq = lane >> 4;
    bf16_t* Qs = (bf16_t*)(smem + L_Q); bf16_t* Ks = (bf16_t*)(smem + L_K); bf16_t* KTs = (bf16_t*)(smem + L_KT); bf16_t* VTs = (bf16_t*)(smem + L_VT);
    bf16_t* VWs = (bf16_t*)(smem + L_VW); bf16_t* Ps = (bf16_t*)(smem + L_P); bf16_t* STs = (bf16_t*)(smem + L_ST);
    float* fl = (float*)(smem + L_F);
    float* as_ = fl; float* Ms = fl + 64; float* bs = fl + 128; float* wrs = fl + 192; float* rsum = fl + 256; float* qns = fl + 320; float* ns = fl + 384; float* sc = fl + 512;
    const int L = smp ? 16 : 64, nch = smp ? 1 : 64, sidx = b * 4 + hd;
    const size_t row0 = smp ? (size_t)NPR + b * 16 : (size_t)b * 4096;
    const float bi = p.in[16][hd], bfg = p.in[17][hd];
    float m = 0.f, nreg = 0.f;
    f32x4 accC[2];
    accC[0] = (f32x4){0.f, 0.f, 0.f, 0.f}; accC[1] = accC[0];
    if (smp) {
        const float* C0 = p.in[2] + (size_t)sidx * 128 * 256;
#pragma unroll
        for (int mt = 0; mt < 2; ++mt)
#pragma unroll
            for (int j = 0; j < 4; ++j) accC[mt][j] = C0[(size_t)(32 * wid + 16 * mt + 4 * fq + j) * 256 + es * 16 + fr];
        if (tid < 128) nreg = p.in[3][sidx * 128 + tid];
        m = p.in[4][sidx];
    }
    __syncthreads();
#pragma unroll
    for (int mt = 0; mt < 2; ++mt) *(u32x2*)(STs + fr * 136 + 32 * wid + 16 * mt + 4 * fq) = pack4(accC[mt]);
    if (tid < 128) ns[tid] = nreg;

    u32x4 qv[4], kv[4], vv; float gi = 0.f, gf = 0.f;
    auto load = [&](int c) __attribute__((always_inline)) {
        const size_t r0 = row0 + (size_t)c * 64;
{
            const int r = tid >> 2, qt = tid & 3, rc = r < L ? r : L - 1;
            const bf16_t* qp = BIG + (r0 + rc) * 5632 + hd * 128 + qt * 32;
#pragma unroll
            for (int i = 0; i < 4; ++i) {
                qv[i] = *(const u32x4*)(qp + i * 8); kv[i] = *(const u32x4*)(qp + 512 + i * 8);
                if (r >= L) { qv[i] = (u32x4){0u, 0u, 0u, 0u}; kv[i] = (u32x4){0u, 0u, 0u, 0u}; }
            }
        }
        { const int r = (tid & 127) >> 1, cc = tid & 1, rc = r < L ? r : L - 1;
          vv = *(const u32x4*)(BIG + (r0 + rc) * 5632 + 1024 + hd * 256 + es * 16 + cc * 8);
          if (r >= L) vv = (u32x4){0u, 0u, 0u, 0u}; }
        { const int lc = lane < L ? lane : L - 1; gi = gates[(r0 + lc) * 32 + hd]; gf = gates[(r0 + lc) * 32 + 4 + hd]; }
    };
    load(0);
    for (int c = 0; c < nch; ++c) {
        __syncthreads();
        if (wid == 0) {
            float ig = -1e30f, lf = 0.f;
            if (lane < L) { ig = gi + bi; const float x = gf + bfg; lf = fminf(x, 0.f) - log1pf(__expf(-fabsf(x))); }
            const float bc = scan_add(lf, lane);
            const float a = ig - bc;
            const float pm = scan_max(a, lane);
            const float M = fmaxf(m, pm);
            const float Mlast = __shfl(M, L - 1), bL = __shfl(bc, L - 1);
            as_[lane] = a; Ms[lane] = M; bs[lane] = bc; wrs[lane] = lane < L ? __expf(a - Mlast) : 0.f;
            if (lane == 0) { sc[0] = Mlast; sc[1] = bL; }
        }
        __syncthreads();
{
            const int r = tid >> 2, qt = tid & 3;
            bf16_t* qd = Qs + r * 136 + qt * 32; bf16_t* kd = Ks + r * 136 + qt * 32; bf16_t* ktd = KTs + (qt * 32) * 72 + r;
#pragma unroll
            for (int i = 0; i < 4; ++i) {
                *(u32x4*)(qd + i * 8) = qv[i];
                float kf[8]; unpack8(kv[i], kf);
#pragma unroll
                for (int j = 0; j < 8; ++j) { kf[j] *= 0.08838834764831845f; ktd[(i * 8 + j) * 72] = f2bf(kf[j]); }
                *(u32x4*)(kd + i * 8) = pack8(kf);
            }
        }
        if (tid < 128) {
            const int r = tid >> 1, cc = tid & 1; const float w = wrs[r];
            float vf[8]; unpack8(vv, vf);
#pragma unroll
            for (int j = 0; j < 8; ++j) { VTs[(cc * 8 + j) * 72 + r] = f2bf(vf[j]); VWs[(cc * 8 + j) * 72 + r] = f2bf(vf[j] * w); }
        }
        if (c + 1 < nch) load(c + 1);
        __syncthreads();
        {
            f32x4 s4[4];
#pragma unroll
            for (int nt = 0; nt < 4; ++nt) s4[nt] = (f32x4){0.f, 0.f, 0.f, 0.f};
#pragma unroll 1
            for (int kk = 0; kk < 4; ++kk) {
                const bf16x8 qf = ldfrag(Qs, 136, 16 * wid + fr, kk * 32 + fq * 8);
#pragma unroll
                for (int nt = 0; nt < 4; ++nt) s4[nt] = mfma16(ldfrag(Ks, 136, 16 * nt + fr, kk * 32 + fq * 8), qf, s4[nt]);
            }
            const int s = 16 * wid + fr; const float Msv = Ms[s]; float rs = 0.f;
#pragma unroll
            for (int nt = 0; nt < 4; ++nt) {
                f32x4 pv;
#pragma unroll
                for (int j = 0; j < 4; ++j) { const int r = 16 * nt + 4 * fq + j; const float d = (r <= s) ? __expf(as_[r] - Msv) : 0.f; pv[j] = s4[nt][j] * d; rs += pv[j]; }
                *(u32x2*)(Ps + s * 72 + 16 * nt + 4 * fq) = pack4(pv);
            }
            rs += __shfl_xor(rs, 16); rs += __shfl_xor(rs, 32);
            if (fq == 0) rsum[s] = rs;
            const int s2 = tid >> 2, part = tid & 3; float qa = 0.f;
#pragma unroll
            for (int j = 0; j < 4; ++j) { float qf8[8]; unpack8(*(const u32x4*)(Qs + s2 * 136 + part * 32 + j * 8), qf8);
#pragma unroll
                for (int i = 0; i < 8; ++i) qa += qf8[i] * ns[part * 32 + j * 8 + i]; }
            qa += __shfl_xor(qa, 1); qa += __shfl_xor(qa, 2);
            if (part == 0) qns[s2] = qa;
        }
        __syncthreads();
        const float Mlast = sc[0], bL = sc[1];
        {
            f32x4 h1 = (f32x4){0.f, 0.f, 0.f, 0.f}, h2 = h1;
#pragma unroll
            for (int kk = 0; kk < 2; ++kk) h1 = mfma16(ldfrag(VTs, 72, fr, kk * 32 + fq * 8), ldfrag(Ps, 72, 16 * wid + fr, kk * 32 + fq * 8), h1);
#pragma unroll
            for (int kk = 0; kk < 4; ++kk) h2 = mfma16(ldfrag(STs, 136, fr, kk * 32 + fq * 8), ldfrag(Qs, 136, 16 * wid + fr, kk * 32 + fq * 8), h2);
            const int s = 16 * wid + fr; const float Msv = Ms[s], wi = __expf(m - Msv);
            const float den = rsum[s] + wi * qns[s], ms = bs[s] + Msv, inv = 1.f / fmaxf(fabsf(den), __expf(-ms));
            f32x4 hv;
#pragma unroll
            for (int j = 0; j < 4; ++j) hv[j] = (h1[j] + wi * h2[j]) * inv;
            if (s < L && live) *(u32x2*)(BIG + (row0 + (size_t)c * 64 + s) * 5632 + 1024 + hd * 256 + es * 16 + 4 * fq) = pack4(hv);
        }
        {
            const float decay = __expf(m - Mlast);
#pragma unroll
            for (int mt = 0; mt < 2; ++mt) {
                accC[mt] *= decay;
#pragma unroll
                for (int kk = 0; kk < 2; ++kk) accC[mt] = mfma16(ldfrag(KTs, 72, 32 * wid + 16 * mt + fr, kk * 32 + fq * 8), ldfrag(VWs, 72, fr, kk * 32 + fq * 8), accC[mt]);
            }
            if (tid < 128) {
                float sn = 0.f;
#pragma unroll
                for (int r8 = 0; r8 < 8; ++r8) { float kf[8]; unpack8(*(const u32x4*)(KTs + tid * 72 + r8 * 8), kf);
#pragma unroll
                    for (int i = 0; i < 8; ++i) sn += kf[i] * wrs[r8 * 8 + i]; }
                nreg = decay * nreg + sn;
            }
        }
        m = bL + Mlast;
        __syncthreads();
#pragma unroll
        for (int mt = 0; mt < 2; ++mt) *(u32x2*)(STs + fr * 136 + 32 * wid + 16 * mt + 4 * fq) = pack4(accC[mt]);
        if (tid < 128) ns[tid] = nreg;
    }
    if (!live) return;
    float* Co = p.out + (smp ? OFF_SC : OFF_PC) + (size_t)sidx * 128 * 256;
#pragma unroll
    for (int mt = 0; mt < 2; ++mt)
#pragma unroll
        for (int j = 0; j < 4; ++j) Co[(size_t)(32 * wid + 16 * mt + 4 * fq + j) * 256 + es * 16 + fr] = accC[mt][j];
    if (es == 0) {
        if (tid < 128) p.out[(smp ? OFF_SN : OFF_PN) + sidx * 128 + tid] = nreg;
        if (tid == 0) p.out[(smp ? OFF_SM : OFF_PM) + sidx] = m;
    }
}

DI void ssd_chain(const Params& p, bf16_t* BIG, const float* gates, int b, int hd, int ps, bool smp, char* smem, bool live) {
    const int tid = get_tid(), wid = tid >> 6, lane = tid & 63, fr = lane & 15, fq = lane >> 4;
    bf16_t* Cs = (bf16_t*)(smem + L_Q); bf16_t* Bs = (bf16_t*)(smem + L_K); bf16_t* BTs = (bf16_t*)(smem + L_KT); bf16_t* XTs = (bf16_t*)(smem + L_VT);
    bf16_t* XWs = (bf16_t*)(smem + L_VW); bf16_t* Ps = (bf16_t*)(smem + L_P); bf16_t* STs = (bf16_t*)(smem + L_ST);
    float* fl = (float*)(smem + L_F);
    float* bs = fl; float* dts = fl + 64; float* wrs = fl + 128; float* sc = fl + 192;
    const int L = smp ? 16 : 64, nch = smp ? 1 : 64, sidx = b * 16 + hd, g = hd >> 3;
    const size_t row0 = smp ? (size_t)NPR + b * 16 : (size_t)b * 4096;
    const float dtb = p.in[21][hd], negA = -__expf(p.in[22][hd]), Dk = p.in[23][hd];
    f32x4 accS[2];
    accS[0] = (f32x4){0.f, 0.f, 0.f, 0.f}; accS[1] = accS[0];
    if (smp) {
        const float* S0 = p.in[5] + (size_t)sidx * 64 * 128;
#pragma unroll
        for (int i = 0; i < 2; ++i)
#pragma unroll
            for (int j = 0; j < 4; ++j) accS[i][j] = S0[(size_t)(ps * 16 + fr) * 128 + 16 * (2 * wid + i) + 4 * fq + j];
    }
    __syncthreads();
#pragma unroll
    for (int i = 0; i < 2; ++i) *(u32x2*)(STs + fr * 136 + 16 * (2 * wid + i) + 4 * fq) = pack4(accS[i]);

    u32x4 qv[4], kv[4], vv; float gd = 0.f;
    auto load = [&](int c) __attribute__((always_inline)) {
        const size_t r0 = row0 + (size_t)c * 64;
{
            const int r = tid >> 2, qt = tid & 3, rc = r < L ? r : L - 1;
            const bf16_t* bp = BIG + (r0 + rc) * 5632 + 5120 + g * 128 + qt * 32;
#pragma unroll
            for (int i = 0; i < 4; ++i) {
                qv[i] = *(const u32x4*)(bp + 256 + i * 8); kv[i] = *(const u32x4*)(bp + i * 8);
                if (r >= L) { qv[i] = (u32x4){0u, 0u, 0u, 0u}; kv[i] = (u32x4){0u, 0u, 0u, 0u}; }
            }
        }
        { const int r = (tid & 127) >> 1, cc = tid & 1, rc = r < L ? r : L - 1;
          vv = *(const u32x4*)(BIG + (r0 + rc) * 5632 + 4096 + hd * 64 + ps * 16 + cc * 8);
          if (r >= L) vv = (u32x4){0u, 0u, 0u, 0u}; }
        { const int lc = lane < L ? lane : L - 1; gd = gates[(r0 + lc) * 32 + 8 + hd]; }
    };
    load(0);
    for (int c = 0; c < nch; ++c) {
        __syncthreads();
        if (wid == 0) {
            float dtv = 0.f;
            if (lane < L) dtv = softplusf(gd + dtb);
            const float a = negA * dtv;
            const float bc = scan_add(a, lane);
            const float bL = __shfl(bc, L - 1);
            bs[lane] = bc; dts[lane] = dtv; wrs[lane] = __expf(bL - bc) * dtv;
            if (lane == 0) sc[1] = bL;
        }
        __syncthreads();
{
            const int r = tid >> 2, qt = tid & 3;
            bf16_t* qd = Cs + r * 136 + qt * 32; bf16_t* kd = Bs + r * 136 + qt * 32; bf16_t* ktd = BTs + (qt * 32) * 72 + r;
#pragma unroll
            for (int i = 0; i < 4; ++i) {
                *(u32x4*)(qd + i * 8) = qv[i];
                *(u32x4*)(kd + i * 8) = kv[i];
                const unsigned kw[4] = {kv[i].x, kv[i].y, kv[i].z, kv[i].w};
#pragma unroll
                for (int j = 0; j < 4; ++j) { ktd[(i * 8 + 2 * j) * 72] = (bf16_t)(kw[j] & 0xffffu); ktd[(i * 8 + 2 * j + 1) * 72] = (bf16_t)(kw[j] >> 16); }
            }
        }
        if (tid < 128) {
            const int r = tid >> 1, cc = tid & 1; const float w = wrs[r];
            float vf[8]; unpack8(vv, vf);
#pragma unroll
            for (int j = 0; j < 8; ++j) { XTs[(cc * 8 + j) * 72 + r] = f2bf(vf[j]); XWs[(cc * 8 + j) * 72 + r] = f2bf(vf[j] * w); }
        }
        if (c + 1 < nch) load(c + 1);
        __syncthreads();
        {
            f32x4 s4[4];
#pragma unroll
            for (int nt = 0; nt < 4; ++nt) s4[nt] = (f32x4){0.f, 0.f, 0.f, 0.f};
#pragma unroll 1
            for (int kk = 0; kk < 4; ++kk) {
                const bf16x8 qf = ldfrag(Cs, 136, 16 * wid + fr, kk * 32 + fq * 8);
#pragma unroll
                for (int nt = 0; nt < 4; ++nt) s4[nt] = mfma16(ldfrag(Bs, 136, 16 * nt + fr, kk * 32 + fq * 8), qf, s4[nt]);
            }
            const int s = 16 * wid + fr; const float bsv = bs[s];
#pragma unroll
            for (int nt = 0; nt < 4; ++nt) {
                f32x4 pv;
#pragma unroll
                for (int j = 0; j < 4; ++j) { const int r = 16 * nt + 4 * fq + j; const float d = (r <= s) ? __expf(bsv - bs[r]) * dts[r] : 0.f; pv[j] = s4[nt][j] * d; }
                *(u32x2*)(Ps + s * 72 + 16 * nt + 4 * fq) = pack4(pv);
            }
        }
        __syncthreads();
        const float bL = sc[1];
        {
            f32x4 h1 = (f32x4){0.f, 0.f, 0.f, 0.f}, h2 = h1;
#pragma unroll
            for (int kk = 0; kk < 2; ++kk) h1 = mfma16(ldfrag(XTs, 72, fr, kk * 32 + fq * 8), ldfrag(Ps, 72, 16 * wid + fr, kk * 32 + fq * 8), h1);
#pragma unroll
            for (int kk = 0; kk < 4; ++kk) h2 = mfma16(ldfrag(STs, 136, fr, kk * 32 + fq * 8), ldfrag(Cs, 136, 16 * wid + fr, kk * 32 + fq * 8), h2);
            const int s = 16 * wid + fr; const float eb = __expf(bs[s]);
            if (s < L && live) {
                bf16_t* zp = BIG + (row0 + (size_t)c * 64 + s) * 5632 + 2048 + hd * 64 + ps * 16 + 4 * fq;
                const u32x2 zr = *(const u32x2*)zp;
                const float zf[4] = {lo2f(zr.x), hi2f(zr.x), lo2f(zr.y), hi2f(zr.y)};
                f32x4 yv;
#pragma unroll
                for (int j = 0; j < 4; ++j) { const float xv = bf2f(XTs[(4 * fq + j) * 72 + s]); yv[j] = (h1[j] + eb * h2[j] + Dk * xv) * siluf(zf[j]); }
                *(u32x2*)zp = pack4(yv);
            }
        }
        {
            const float dec = __expf(bL);
#pragma unroll
            for (int i = 0; i < 2; ++i) {
                accS[i] *= dec;
#pragma unroll
                for (int kk = 0; kk < 2; ++kk) accS[i] = mfma16(ldfrag(BTs, 72, 16 * (2 * wid + i) + fr, kk * 32 + fq * 8), ldfrag(XWs, 72, fr, kk * 32 + fq * 8), accS[i]);
            }
        }
        __syncthreads();
#pragma unroll
        for (int i = 0; i < 2; ++i) *(u32x2*)(STs + fr * 136 + 16 * (2 * wid + i) + 4 * fq) = pack4(accS[i]);
    }
    if (!live) return;
    float* So = p.out + (smp ? OFF_SSSD : OFF_PSSD) + (size_t)sidx * 64 * 128;
#pragma unroll
    for (int i = 0; i < 2; ++i) {
        float4 o; o.x = accS[i][0]; o.y = accS[i][1]; o.z = accS[i][2]; o.w = accS[i][3];
        *(float4*)(So + (size_t)(ps * 16 + fr) * 128 + 16 * (2 * wid + i) + 4 * fq) = o;
    }
}

DI void phase_scan_l0(const Params& p, bf16_t* BIG, const float* gates, char* smem, bool live) {
    for (int it = blockIdx.x; it < 1536; it += gridDim.x) {
        const bool smp = it >= 512;
        const int j = it & 255, k = smp ? (it - 512) & 511 : j;
#ifndef NO_MLSTM
        if (it < 256 || (smp && it < 1024)) mlstm_chain(p, BIG, gates, k >> 6, (k >> 4) & 3, k & 15, smp, smem, live);
#endif
#ifndef NO_SSD
        if ((it >= 256 && it < 512) || it >= 1024) ssd_chain(p, BIG, gates, k >> 6, (k >> 2) & 15, k & 3, smp, smem, live);
#endif
    }
}

DI void phase_post_l0(const Params& p, bf16_t* BIG) {
    const int tid_ = get_tid(), lane = tid_ & 63, gw = blockIdx.x * 4 + (tid_ >> 6), nw = gridDim.x * 4;
    for (int row = gw; row < NTOK; row += nw) {
        bf16_t* rp = BIG + (size_t)row * 5632;
#pragma unroll
        for (int hd = 0; hd < 4; ++hd) {
            const u32x2 rv = *(const u32x2*)(rp + 1024 + hd * 256 + lane * 4), ov = *(const u32x2*)(rp + 3072 + hd * 256 + lane * 4);
            const float x[4] = {lo2f(rv.x), hi2f(rv.x), lo2f(rv.y), hi2f(rv.y)}, o[4] = {lo2f(ov.x), hi2f(ov.x), lo2f(ov.y), hi2f(ov.y)};
            const float ss = wave_sum(x[0] * x[0] + x[1] * x[1] + x[2] * x[2] + x[3] * x[3]);
            const float r = rsqrtf(ss * (1.f / 256.f) + 1e-6f);
            const float4 gg = *(const float4*)(p.in[18] + hd * 256 + lane * 4);
            f32x4 y; y[0] = sigmf(o[0]) * x[0] * r * gg.x; y[1] = sigmf(o[1]) * x[1] * r * gg.y; y[2] = sigmf(o[2]) * x[2] * r * gg.z; y[3] = sigmf(o[3]) * x[3] * r * gg.w;
            *(u32x2*)(rp + 1024 + hd * 256 + lane * 4) = pack4(y);
        }
#pragma unroll
        for (int g = 0; g < 2; ++g) {
            float x[8]; unpack8(*(const u32x4*)(rp + 2048 + g * 512 + lane * 8), x);
            float ss = 0.f;
#pragma unroll
            for (int j = 0; j < 8; ++j) ss += x[j] * x[j];
            ss = wave_sum(ss);
            const float r = rsqrtf(ss * (1.f / 512.f) + 1e-6f);
            const float4 g0 = *(const float4*)(p.in[24] + g * 512 + lane * 8), g1 = *(const float4*)(p.in[24] + g * 512 + lane * 8 + 4);
            float y[8] = {x[0] * r * g0.x, x[1] * r * g0.y, x[2] * r * g0.z, x[3] * r * g0.w, x[4] * r * g1.x, x[5] * r * g1.y, x[6] * r * g1.z, x[7] * r * g1.w};
            *(u32x4*)(rp + 2048 + g * 512 + lane * 8) = pack8(y);
        }
    }
}

#define G_QN  0
#define G_KN  18432
#define G_VT  18432
#define G_AT  36864
#define G_VN  53504
#define G_TV  53504
#define G_TW  62720
#define G_F   71936
DI void gdn_g1_item(const Params& p, bf16_t* BIG, bf16_t* Wb, bf16_t* PB, const float* gates, const bf16_t* halo, float* egl, int unit, int hd, char* smem, bool live) {
    const int tid = get_tid(), wid = tid >> 6, lane = tid & 63, fr = lane & 15, fq = lane >> 4;
    bf16_t* Qn = (bf16_t*)(smem + G_QN); bf16_t* Kn = (bf16_t*)(smem + G_KN); bf16_t* KTs = (bf16_t*)(smem + G_QN); bf16_t* VTs = (bf16_t*)(smem + G_VT);
    bf16_t* Vn = (bf16_t*)(smem + G_VN);
    float* AT = (float*)(smem + G_AT); bf16_t* Tv = (bf16_t*)(smem + G_TV); bf16_t* Tw = (bf16_t*)(smem + G_TW);
    float* beta_s = (float*)(smem + G_F); float* gam_s = beta_s + 64;
    const bool smp = unit >= 256;
    const int L = smp ? 16 : 64, c = unit & 63, s_ = unit - 256;
    const size_t row0 = smp ? (size_t)NPR + s_ * 16 : (size_t)unit * 64;
    const int tok = tid >> 2, qt = tid & 3;
    const float* cw = p.in[27];
    const bf16_t* hp = halo + (size_t)(smp ? 264 + s_ : (unit > 0 ? unit - 1 : 0)) * 3 * 3072;
    const bool zh = !smp && c == 0;
    __syncthreads();
    if (wid == 0) {
        float beta = 0.f, g = 0.f;
        const int lc = lane < L ? lane : L - 1;
        const float br = gates[(row0 + lc) * 32 + hd], ar = gates[(row0 + lc) * 32 + 8 + hd];
        if (lane < L) { beta = sigmf(br); g = -__expf(p.in[29][hd]) * softplusf(ar + p.in[28][hd]); }
        const float gam = scan_add(g, lane);
        beta_s[lane] = beta; gam_s[lane] = gam;
        if (lane == L - 1 && live) egl[unit * 8 + hd] = __expf(gam);
    }
#pragma unroll 1
    for (int mi = 0; mi < 3; ++mi) {
        float o[32];
#pragma unroll
        for (int j = 0; j < 4; ++j) {
            const int col = mi * 1024 + hd * 128 + qt * 32 + j * 8;
            float a8[8];
#pragma unroll
            for (int q = 0; q < 8; ++q) a8[q] = 0.f;
#pragma unroll
            for (int i = 0; i < 4; ++i) {
                const int tc = tok < L ? tok : L - 1, rlc = tc - 3 + i;
                const bf16_t* src = rlc >= 0 ? BIG + (row0 + rlc) * 4096 + col : hp + (rlc + 3) * 3072 + col;
                u32x4 xv = *(const u32x4*)src;
                if (rlc < 0 && zh) xv = (u32x4){0u, 0u, 0u, 0u};
                float xf[8]; unpack8(xv, xf);
                const float4 w0 = *(const float4*)(cw + i * 3072 + col), w1 = *(const float4*)(cw + i * 3072 + col + 4);
                a8[0] += w0.x * xf[0]; a8[1] += w0.y * xf[1]; a8[2] += w0.z * xf[2]; a8[3] += w0.w * xf[3];
                a8[4] += w1.x * xf[4]; a8[5] += w1.y * xf[5]; a8[6] += w1.z * xf[6]; a8[7] += w1.w * xf[7];
            }
#pragma unroll
            for (int q = 0; q < 8; ++q) o[j * 8 + q] = siluf(a8[q]);
        }
        if (mi < 2) {
            float ss = 0.f;
#pragma unroll
            for (int q = 0; q < 32; ++q) ss += o[q] * o[q];
            ss += __shfl_xor(ss, 1); ss += __shfl_xor(ss, 2);
            const float sc = rsqrtf(ss + 1e-6f) * (mi == 0 ? 0.08838834764831845f : 1.f);
#pragma unroll
            for (int q = 0; q < 32; ++q) o[q] *= sc;
        }
        if (tok >= L) {
#pragma unroll
            for (int q = 0; q < 32; ++q) o[q] = 0.f;
        }
        bf16_t* dst = (mi == 0 ? Qn : (mi == 1 ? Kn : Vn)) + tok * 136 + qt * 32;
#pragma unroll
        for (int j = 0; j < 4; ++j) *(u32x4*)(dst + j * 8) = pack8(o + j * 8);
    }
    __syncthreads();
    {
        f32x4 a4[4], p4[4];
#pragma unroll
        for (int nt = 0; nt < 4; ++nt) { a4[nt] = (f32x4){0.f, 0.f, 0.f, 0.f}; p4[nt] = a4[nt]; }
#pragma unroll 1
        for (int kk = 0; kk < 4; ++kk) {
            const bf16x8 qf = ldfrag(Qn, 136, 16 * wid + fr, kk * 32 + fq * 8), ksf = ldfrag(Kn, 136, 16 * wid + fr, kk * 32 + fq * 8);
#pragma unroll
            for (int nt = 0; nt < 4; ++nt) { const bf16x8 kf = ldfrag(Kn, 136, 16 * nt + fr, kk * 32 + fq * 8); a4[nt] = mfma16(kf, ksf, a4[nt]); p4[nt] = mfma16(kf, qf, p4[nt]); }
        }
        const int s = 16 * wid + fr; const float gs = gam_s[s], bsv = beta_s[s];
#pragma unroll
        for (int nt = 0; nt < 4; ++nt) {
            f32x4 pv;
#pragma unroll
            for (int j = 0; j < 4; ++j) {
                const int r = 16 * nt + 4 * fq + j;
                const float d = (r <= s) ? __expf(gs - gam_s[r]) : 0.f;
                pv[j] = p4[nt][j] * d;
                AT[s * 65 + r] = (r < s) ? a4[nt][j] * d * bsv : 0.f;
            }
            if (s < L && live) *(u32x2*)(PB + (row0 + s) * 512 + hd * 64 + 16 * nt + 4 * fq) = pack4(pv);
        }
    }
    __syncthreads();
    if (tok < L && live) {
        const float eg = __expf(gam_s[tok]);
#pragma unroll
        for (int j = 0; j < 4; ++j) {
            float qf8[8]; unpack8(*(const u32x4*)(Qn + tok * 136 + qt * 32 + j * 8), qf8);
#pragma unroll
            for (int q = 0; q < 8; ++q) qf8[q] *= eg;
            *(u32x4*)(BIG + (row0 + tok) * 4096 + hd * 128 + qt * 32 + j * 8) = pack8(qf8);
        }
    }
    __syncthreads();
    {
        u32x4 kk4[4];
#pragma unroll
        for (int j = 0; j < 4; ++j) kk4[j] = *(const u32x4*)(Kn + tok * 136 + qt * 32 + j * 8);
        bf16_t* ktd = KTs + (qt * 32) * 72 + tok;
#pragma unroll
        for (int j = 0; j < 4; ++j) {
            const unsigned kw[4] = {kk4[j].x, kk4[j].y, kk4[j].z, kk4[j].w};
#pragma unroll
            for (int q = 0; q < 4; ++q) { ktd[(j * 8 + 2 * q) * 72] = (bf16_t)(kw[q] & 0xffffu); ktd[(j * 8 + 2 * q + 1) * 72] = (bf16_t)(kw[q] >> 16); }
        }
    }
    __syncthreads();
    {
        u32x4 vv4[4];
#pragma unroll
        for (int j = 0; j < 4; ++j) vv4[j] = *(const u32x4*)(Vn + tok * 136 + qt * 32 + j * 8);
        bf16_t* vtd = VTs + (qt * 32) * 72 + tok;
#pragma unroll
        for (int j = 0; j < 4; ++j) {
            const unsigned vw[4] = {vv4[j].x, vv4[j].y, vv4[j].z, vv4[j].w};
#pragma unroll
            for (int q = 0; q < 4; ++q) { vtd[(j * 8 + 2 * q) * 72] = (bf16_t)(vw[q] & 0xffffu); vtd[(j * 8 + 2 * q + 1) * 72] = (bf16_t)(vw[q] >> 16); }
        }
    }
    __syncthreads();
    {
        if (lane < 16) {
            const int o = 16 * wid; float t[16];
#pragma unroll
            for (int s = 0; s < 16; ++s) {
                float acc = (s == lane) ? 1.f : 0.f;
#pragma unroll
                for (int r = 0; r < s; ++r) acc -= AT[(o + s) * 65 + o + r] * t[r];
                t[s] = acc;
            }
#pragma unroll
            for (int s = 0; s < 16; ++s) AT[(o + s) * 65 + o + lane] = t[s];
        }
        __syncthreads();
        const int r = tid >> 4, cq = tid & 15;
        float bv[6];
        {
            int idx = 0;
#pragma unroll
            for (int i = 1; i < 4; ++i)
#pragma unroll
                for (int jb = 0; jb < i; ++jb) {
                    float acc = 0.f;
#pragma unroll
                    for (int t = 0; t < 16; ++t) acc += AT[(16 * i + r) * 65 + 16 * i + t] * AT[(16 * i + t) * 65 + 16 * jb + cq];
                    bv[idx++] = acc;
                }
        }
        __syncthreads();
        {
            int idx = 0;
#pragma unroll
            for (int i = 1; i < 4; ++i)
#pragma unroll
                for (int jb = 0; jb < i; ++jb) AT[(16 * i + r) * 65 + 16 * jb + cq] = bv[idx++];
        }
        __syncthreads();
#pragma unroll
        for (int i = 1; i < 4; ++i) {
            float tv[3];
#pragma unroll
            for (int jb = 0; jb < i; ++jb) {
                float acc = 0.f;
#pragma unroll
                for (int m = 16 * jb; m < 16 * i; ++m) acc += AT[(16 * i + r) * 65 + m] * AT[m * 65 + 16 * jb + cq];
                tv[jb] = -acc;
            }
            __syncthreads();
#pragma unroll
            for (int jb = 0; jb < i; ++jb) AT[(16 * i + r) * 65 + 16 * jb + cq] = tv[jb];
            __syncthreads();
        }
        const int s = tid >> 2, j0 = (tid & 3) * 16;
#pragma unroll
        for (int jj = 0; jj < 16; ++jj) {
            const int j = j0 + jj; const float t = AT[s * 65 + j], bj = beta_s[j];
            Tv[s * 72 + j] = f2bf(t * bj); Tw[s * 72 + j] = f2bf(t * bj * __expf(gam_s[j]));
        }
    }
    __syncthreads();
    {
        const int s = 16 * wid + fr;
        const bf16x8 tw0 = ldfrag(Tw, 72, s, fq * 8), tw1 = ldfrag(Tw, 72, s, 32 + fq * 8), tv0 = ldfrag(Tv, 72, s, fq * 8), tv1 = ldfrag(Tv, 72, s, 32 + fq * 8);
#pragma unroll 2
        for (int nt = 0; nt < 8; ++nt) {
            f32x4 w4 = (f32x4){0.f, 0.f, 0.f, 0.f}, u4 = w4;
            w4 = mfma16(ldfrag(KTs, 72, 16 * nt + fr, fq * 8), tw0, w4); w4 = mfma16(ldfrag(KTs, 72, 16 * nt + fr, 32 + fq * 8), tw1, w4);
            u4 = mfma16(ldfrag(VTs, 72, 16 * nt + fr, fq * 8), tv0, u4); u4 = mfma16(ldfrag(VTs, 72, 16 * nt + fr, 32 + fq * 8), tv1, u4);
            if (s < L && live) {
                *(u32x2*)(Wb + (row0 + s) * 1024 + hd * 128 + 16 * nt + 4 * fq) = pack4(w4);
                *(u32x2*)(BIG + (row0 + s) * 4096 + 2048 + hd * 128 + 16 * nt + 4 * fq) = pack4(u4);
            }
        }
        const float gL = gam_s[L - 1];
#pragma unroll
        for (int i = 0; i < 4; ++i) {
            const int idx = tid + 256 * i, d = idx >> 3, r8 = idx & 7;
            if (r8 * 8 < L && live) {
                float kf[8]; unpack8(*(const u32x4*)(KTs + d * 72 + r8 * 8), kf);
#pragma unroll
                for (int q = 0; q < 8; ++q) kf[q] *= __expf(gL - gam_s[r8 * 8 + q]);
                const int e = d * L + r8 * 8;
                *(u32x4*)(BIG + (row0 + (e >> 7)) * 4096 + 1024 + hd * 128 + (e & 127)) = pack8(kf);
            }
        }
        if ((smp || c == 63) && tid < 144 && live) {
            const int i = tid / 48, rem = tid % 48, col = (rem >> 4) * 1024 + hd * 128 + (rem & 15) * 8;
            float f[8]; unpack8(*(const u32x4*)(halo + ((size_t)unit * 3 + i) * 3072 + col), f);
            float* dst = smp ? p.out + OFF_SGC + ((size_t)s_ * 3 + i) * 3072 + col : p.out + OFF_PGC + ((size_t)(unit >> 6) * 3 + i) * 3072 + col;
            *(float4*)dst = make_float4(f[0], f[1], f[2], f[3]); *(float4*)(dst + 4) = make_float4(f[4], f[5], f[6], f[7]);
        }
    }
}

struct GdnFrags { bf16x8 w[4], q[4], p[2], kt[2][2]; u32x2 u0; float eg; };
DI void gdn_chain(const Params& p, bf16_t* BIG, const bf16_t* Wb, const bf16_t* PB, const float* egl, int b, int hd, int es, bool smp, char* smem, bool live) {
    const int tid = get_tid(), wid = tid >> 6, lane = tid & 63, fr = lane & 15, fq = lane >> 4;
    bf16_t* UT0 = (bf16_t*)smem;
    bf16_t* ST0 = (bf16_t*)(smem + 4608);
    const int L = smp ? 16 : 64, nch = smp ? 1 : 64, sidx = b * 8 + hd;
    const size_t row0 = smp ? (size_t)NPR + b * 16 : (size_t)b * 4096;
    const bf16x8 z8 = (bf16x8){0, 0, 0, 0, 0, 0, 0, 0};
    f32x4 accS[2];
    accS[0] = (f32x4){0.f, 0.f, 0.f, 0.f}; accS[1] = accS[0];
    if (smp) {
        const float* S0 = p.in[7] + (size_t)sidx * 128 * 128;
#pragma unroll
        for (int mt = 0; mt < 2; ++mt)
#pragma unroll
            for (int j = 0; j < 4; ++j) accS[mt][j] = S0[(size_t)(32 * wid + 16 * mt + 4 * fq + j) * 128 + es * 16 + fr];
    }
    __syncthreads();
#pragma unroll
    for (int mt = 0; mt < 2; ++mt) *(u32x2*)(ST0 + fr * 136 + 32 * wid + 16 * mt + 4 * fq) = pack4(accS[mt]);
    const int s = 16 * wid + fr, sc_ = s < L ? s : L - 1;
    const bool valid = s < L;
    auto load = [&](int c, GdnFrags& F) __attribute__((always_inline)) {
        const size_t r0 = row0 + (size_t)c * 64;
        const bf16_t* wp = Wb + (r0 + sc_) * 1024 + hd * 128 + fq * 8;
        const bf16_t* qp = BIG + (r0 + sc_) * 4096 + hd * 128 + fq * 8;
        const bf16_t* pp = PB + (r0 + sc_) * 512 + hd * 64 + fq * 8;
#pragma unroll
        for (int kk = 0; kk < 4; ++kk) { F.w[kk] = *(const bf16x8*)(wp + kk * 32); F.q[kk] = *(const bf16x8*)(qp + kk * 32); if (!valid) { F.w[kk] = z8; F.q[kk] = z8; } }
#pragma unroll
        for (int kk = 0; kk < 2; ++kk) { F.p[kk] = *(const bf16x8*)(pp + kk * 32); if (!valid) F.p[kk] = z8; }
#pragma unroll
        for (int mt = 0; mt < 2; ++mt)
#pragma unroll
            for (int kk = 0; kk < 2; ++kk) {
                const int d = 32 * wid + 16 * mt + fr, r = kk * 32 + fq * 8, rc = r < L ? r : 0, e = d * L + rc;
                F.kt[mt][kk] = *(const bf16x8*)(BIG + (r0 + (e >> 7)) * 4096 + 1024 + hd * 128 + (e & 127));
                if (r >= L) F.kt[mt][kk] = z8;
            }
        F.u0 = *(const u32x2*)(BIG + (r0 + sc_) * 4096 + 2048 + hd * 128 + es * 16 + 4 * fq);
        if (!valid) F.u0 = (u32x2){0u, 0u};
        F.eg = egl[(smp ? 256 + b : b * 64 + c) * 8 + hd];
    };
    GdnFrags cur; load(0, cur);
    __syncthreads();
    for (int c = 0; c < nch; ++c) {
        GdnFrags nxt = cur;
        if (c + 1 < nch) load(c + 1, nxt);
        const bf16_t* STc = ST0 + (c & 1) * (16 * 136); bf16_t* STn = ST0 + ((c + 1) & 1) * (16 * 136);
        bf16_t* UTc = UT0 + (c & 1) * (16 * 72);
        bf16x8 sf[4];
#pragma unroll
        for (int kk = 0; kk < 4; ++kk) sf[kk] = ldfrag(STc, 136, fr, kk * 32 + fq * 8);
        {
            f32x4 w4 = (f32x4){0.f, 0.f, 0.f, 0.f};
#pragma unroll
            for (int kk = 0; kk < 4; ++kk) w4 = mfma16(sf[kk], cur.w[kk], w4);
            const float uf[4] = {lo2f(cur.u0.x) - w4[0], hi2f(cur.u0.x) - w4[1], lo2f(cur.u0.y) - w4[2], hi2f(cur.u0.y) - w4[3]};
#pragma unroll
            for (int j = 0; j < 4; ++j) UTc[(4 * fq + j) * 72 + s] = f2bf(uf[j]);
        }
        __syncthreads();
        {
            f32x4 o4 = (f32x4){0.f, 0.f, 0.f, 0.f};
#pragma unroll
            for (int kk = 0; kk < 4; ++kk) o4 = mfma16(sf[kk], cur.q[kk], o4);
            bf16x8 uf8[2];
#pragma unroll
            for (int kk = 0; kk < 2; ++kk) { uf8[kk] = ldfrag(UTc, 72, fr, kk * 32 + fq * 8); o4 = mfma16(uf8[kk], cur.p[kk], o4); }
            if (valid && live) *(u32x2*)(BIG + (row0 + (size_t)c * 64 + s) * 4096 + 2048 + hd * 128 + es * 16 + 4 * fq) = pack4(o4);
#pragma unroll
            for (int mt = 0; mt < 2; ++mt) {
                accS[mt] *= cur.eg;
#pragma unroll
                for (int kk = 0; kk < 2; ++kk) accS[mt] = mfma16(cur.kt[mt][kk], uf8[kk], accS[mt]);
                *(u32x2*)(STn + fr * 136 + 32 * wid + 16 * mt + 4 * fq) = pack4(accS[mt]);
            }
        }
        __syncthreads();
        cur = nxt;
    }
    if (!live) return;
    float* So = p.out + (smp ? OFF_SG : OFF_PG) + (size_t)sidx * 128 * 128;
#pragma unroll
    for (int mt = 0; mt < 2; ++mt)
#pragma unroll
        for (int j = 0; j < 4; ++j) So[(size_t)(32 * wid + 16 * mt + 4 * fq + j) * 128 + es * 16 + fr] = accS[mt][j];
}

DI void phase_post_l1(const Params& p, bf16_t* BIG) {
    const int tid_ = get_tid(), lane = tid_ & 63, gw = blockIdx.x * 4 + (tid_ >> 6), nw = gridDim.x * 4;
    const int hd = lane >> 3, e0 = (lane & 7) * 16;
    for (int row = gw; row < NTOK; row += nw) {
        bf16_t* op = BIG + (size_t)row * 4096 + 2048 + hd * 128 + e0;
        const bf16_t* zp = BIG + (size_t)row * 4096 + 3072 + hd * 128 + e0;
        float x[16], z[16];
        unpack8(*(const u32x4*)op, x); unpack8(*(const u32x4*)(op + 8), x + 8);
        unpack8(*(const u32x4*)zp, z); unpack8(*(const u32x4*)(zp + 8), z + 8);
        float ss = 0.f;
#pragma unroll
        for (int j = 0; j < 16; ++j) ss += x[j] * x[j];
        ss += __shfl_xor(ss, 1); ss += __shfl_xor(ss, 2); ss += __shfl_xor(ss, 4);
        const float r = rsqrtf(ss * (1.f / 128.f) + 1e-6f);
        float y[16];
#pragma unroll
        for (int j = 0; j < 16; ++j) y[j] = x[j] * r * p.in[30][e0 + j] * siluf(z[j]);
        *(u32x4*)op = pack8(y); *(u32x4*)(op + 8) = pack8(y + 8);
    }
}

__global__ void __launch_bounds__(256, 2) fwd_megakernel(Params p) {
    __shared__ __attribute__((aligned(16))) char smem[LDS_BYTES];
    cg::grid_group grid = cg::this_grid();
    char* ws = p.ws;
    if (ws == nullptr) grid.sync();
    if (threadIdx.x < 4) ((volatile LAS unsigned*)(smem + LDS_BYTES - 16))[threadIdx.x] = 0u;
    __syncthreads();
    const XcdBarrier xb = xcd_barrier_post((unsigned*)(ws + WS_BAR), (volatile LAS unsigned*)(smem + LDS_BYTES - 16));
    bf16_t* WGU = (bf16_t*)(ws + WS_WGU); bf16_t* WD = (bf16_t*)(ws + WS_WD); bf16_t* WIN = (bf16_t*)(ws + WS_WIN); bf16_t* WOUT = (bf16_t*)(ws + WS_WOUT);
    bf16_t* H = (bf16_t*)(ws + WS_H); bf16_t* BIG = (bf16_t*)(ws + WS_BIG); float* GATES = (float*)(ws + WS_GATES); bf16_t* HALO = (bf16_t*)(ws + WS_HALO); float* EGL = (float*)(ws + WS_EGL);
    bf16_t* PB = BIG + (size_t)NTOK * 4096;
    float* X = p.out; float* XS = p.out + (size_t)NPR * 1024;
    const float* ng = p.in[9];
    const size_t FW = (size_t)1024 * 2816;
    Epi e{};
    phase_norm(p.in[0], p.in[1], ng, H);
    cvt_job(p.in[11], 1024, 2816, WGU, 1, 0, smem);
    cvt_job(p.in[12], 1024, 2816, WGU, 2, 100, smem);
    cvt_job(p.in[13], 2816, 1024, WD, 0, 200, smem);
    cvt_job(p.in[14], 1024, 5656, WIN, 3, 300, smem);
    cvt_job(p.in[15], 2048, 1024, WOUT, 0, 400, smem);
    xcd_barrier(xb);
    e.o16 = BIG; e.ldc = 2816;
    gemm_phase<EPI_GU>(H, 1024, WGU, 1024, 44, e, smem);
    xcd_barrier(xb);
    e.o32 = X; e.rp = p.in[0]; e.rs = p.in[1]; e.scale = 0.5f;
    gemm_phase<EPI_RES>(BIG, 2816, WD, 2816, 8, e, smem);
    xcd_barrier(xb);
    phase_norm(X, XS, ng + 1024, H);
    cvt_job(p.in[11] + FW, 1024, 2816, WGU, 1, 0, smem);
    cvt_job(p.in[12] + FW, 1024, 2816, WGU, 2, 100, smem);
    cvt_job(p.in[13] + FW, 2816, 1024, WD, 0, 200, smem);
    xcd_barrier(xb);
    e.o16 = BIG; e.ldc = 5632; e.gates = GATES; e.halo = HALO; e.cv0 = 4096; e.cv1 = 5632;
    gemm_phase<EPI_PROJ>(H, 1024, WIN, 1024, 45, e, smem);
    xcd_barrier(xb);
#if PHM & 1
    phase_conv_ssd(p, BIG, HALO);
#endif
    xcd_barrier(xb);
#if PHM & 2
#ifdef PROBE_L0
    phase_scan_l0(p, BIG, GATES, smem, p.ws == nullptr);
    xcd_barrier(xb);
#endif
    phase_scan_l0(p, BIG, GATES, smem, true);
#endif
    xcd_barrier(xb);
    phase_post_l0(p, BIG);
    xcd_barrier(xb);
    e.o32 = X; e.rp = X; e.rs = XS; e.scale = 1.0f;
    gemm_phase<EPI_RES>(BIG + 1024, 5632, WOUT, 2048, 8, e, smem);
    xcd_barrier(xb);
    phase_norm(X, XS, ng + 2048, H);
    xcd_barrier(xb);
    e.o16 = BIG; e.ldc = 2816;
    gemm_phase<EPI_GU>(H, 1024, WGU, 1024, 44, e, smem);
    xcd_barrier(xb);
    e.scale = 0.5f;
    gemm_phase<EPI_RES>(BIG, 2816, WD, 2816, 8, e, smem);
    xcd_barrier(xb);
    phase_norm(X, XS, ng + 3072, H);
    cvt_job(p.in[11] + 2 * FW, 1024, 2816, WGU, 1, 0, smem);
    cvt_job(p.in[12] + 2 * FW, 1024, 2816, WGU, 2, 100, smem);
    cvt_job(p.in[13] + 2 * FW, 2816, 1024, WD, 0, 200, smem);
    cvt_job(p.in[25], 1024, 4112, WIN, 0, 300, smem);
    cvt_job(p.in[26], 1024, 1024, WOUT, 0, 400, smem);
    xcd_barrier(xb);
    gemm_phase<EPI_GU>(H, 1024, WGU, 1024, 44, e, smem);
    xcd_barrier(xb);
    gemm_phase<EPI_RES>(BIG, 2816, WD, 2816, 8, e, smem);
    xcd_barrier(xb);
    phase_norm(X, XS, ng + 4096, H);
    fill_cache_halo(p.in[8], 3072, HALO);
    cvt_job(p.in[11] + 3 * FW, 1024, 2816, WGU, 1, 0, smem);
    cvt_job(p.in[12] + 3 * FW, 1024, 2816, WGU, 2, 100, smem);
    cvt_job(p.in[13] + 3 * FW, 2816, 1024, WD, 0, 200, smem);
    xcd_barrier(xb);
    e.o16 = BIG; e.ldc = 4096; e.cv0 = 0; e.cv1 = 3072;
    gemm_phase<EPI_PROJ>(H, 1024, WIN, 1024, 33, e, smem);
    xcd_barrier(xb);
#if PHM & 4
#ifdef PROBE_G1
    for (int it = blockIdx.x; it < 264 * 8; it += gridDim.x) gdn_g1_item(p, BIG, H, PB, GATES, HALO, EGL, it >> 3, it & 7, smem, p.ws == nullptr);
    xcd_barrier(xb);
#endif
    for (int it = blockIdx.x; it < 264 * 8; it += gridDim.x) gdn_g1_item(p, BIG, H, PB, GATES, HALO, EGL, it >> 3, it & 7, smem, true);
#endif
    xcd_barrier(xb);
#if PHM & 8
#ifdef PROBE_GDN
    for (int it = blockIdx.x; it < 768; it += gridDim.x) {
        const bool smp = it >= 256; const int j = smp ? it - 256 : it;
        gdn_chain(p, BIG, H, PB, EGL, j >> 6, (j >> 3) & 7, j & 7, smp, smem, p.ws == nullptr);
    }
    xcd_barrier(xb);
#endif
    for (int it = blockIdx.x; it < 768; it += gridDim.x) {
        const bool smp = it >= 256; const int j = smp ? it - 256 : it;
        gdn_chain(p, BIG, H, PB, EGL, j >> 6, (j >> 3) & 7, j & 7, smp, smem, true);
    }
#endif
    xcd_barrier(xb);
    phase_post_l1(p, BIG);
    xcd_barrier(xb);
    e.scale = 1.0f;
    gemm_phase<EPI_RES>(BIG + 2048, 4096, WOUT, 1024, 8, e, smem);
    xcd_barrier(xb);
    phase_norm(X, XS, ng + 5120, H);
    xcd_barrier(xb);
    e.o16 = BIG; e.ldc = 2816;
    gemm_phase<EPI_GU>(H, 1024, WGU, 1024, 44, e, smem);
    xcd_barrier(xb);
    e.scale = 0.5f;
    gemm_phase<EPI_RES>(BIG, 2816, WD, 2816, 8, e, smem);
    xcd_barrier(xb);
    phase_final_norm(X, p.in[10]);
}

extern "C" void kernel_launch(void* const* d_in, const int* in_sizes, int n_in, void* d_out, int out_size, void* d_ws, size_t ws_size, hipStream_t stream) {
    static int grid_blocks = 0;
    if (!grid_blocks) {
        int dev = 0, cus = 0, per_cu = 0;
        hipGetDevice(&dev);
        hipDeviceGetAttribute(&cus, hipDeviceAttributeMultiprocessorCount, dev);
        hipOccupancyMaxActiveBlocksPerMultiprocessor(&per_cu, fwd_megakernel, 256, 0);
        if (per_cu > 2) per_cu = 2;
        if (per_cu < 1) per_cu = 1;
        grid_blocks = cus * per_cu;
    }
    Params p{};
    for (int i = 0; i < 31; ++i) p.in[i] = (const float*)d_in[i];
    p.out = (float*)d_out;
    p.ws = (char*)d_ws;
    (void)hipMemsetAsync((char*)d_ws + WS_BAR, 0, 16384, stream);
    void* args[] = {&p};
    hipError_t err = hipLaunchCooperativeKernel((void*)fwd_megakernel, dim3(grid_blocks), dim3(256), args, 0, stream);
    if (err != hipSuccess) fprintf(stderr, "cooperative launch failed: %s (grid %d)\n", hipGetErrorString(err), grid_blocks);
}
```

```cpp
#include <hip/hip_runtime.h>
#include <hip/hip_cooperative_groups.h>
#include <cstdio>
namespace cg = cooperative_groups;

typedef unsigned short bf16_t;
typedef short bf16x8 __attribute__((ext_vector_type(8)));
typedef float f32x4 __attribute__((ext_vector_type(4)));
typedef unsigned u32x2 __attribute__((ext_vector_type(2)));
typedef unsigned u32x4 __attribute__((ext_vector_type(4)));

#define DI __device__ __forceinline__
#define NTOK 16512
#define NPR 16384
#define LDS_SUB 75776
#define LDS_BYTES (2 * LDS_SUB + 16)
#ifndef PHM
#define PHM 15
#endif

#define WS_WGU   0ull
#define WS_WD    (WS_WGU + 5632ull * 1024 * 2)
#define WS_WIN   (WS_WD + 1024ull * 2816 * 2)
#define WS_WOUT  (WS_WIN + 5760ull * 1024 * 2)
#define WS_H     (WS_WOUT + 1024ull * 2048 * 2)
#define WS_BIG   (WS_H + 16512ull * 1024 * 2)
#define WS_GATES (WS_BIG + 16512ull * 5632 * 2)
#define WS_HALO  (WS_GATES + 16512ull * 32 * 4)
#define WS_EGL   (WS_HALO + 272ull * 3 * 3072 * 2)
#define WS_BAR   (WS_EGL + 272ull * 8 * 4)
#define WS_END   (WS_BAR + 16384ull)

struct Params {
    const float* in[31];
    float* out;
    char* ws;
};

DI int get_tid() { int t = threadIdx.x & 255; asm volatile("" : "+v"(t)); return t; }
DI int get_sub() { return __builtin_amdgcn_readfirstlane((int)(threadIdx.x >> 8)); }
#define VB ((int)blockIdx.x * 2 + get_sub())
#define NVB ((int)gridDim.x * 2)
typedef __bf16 hwbf16x2 __attribute__((ext_vector_type(2)));
typedef float hwf32x2 __attribute__((ext_vector_type(2)));
DI unsigned pack2(float lo, float hi) { hwf32x2 v = {lo, hi}; hwbf16x2 b = __builtin_convertvector(v, hwbf16x2); return __builtin_bit_cast(unsigned, b); }
DI bf16_t f2bf(float f) { return (bf16_t)(pack2(f, f) & 0xffffu); }
DI float bf2f(bf16_t h) { return __uint_as_float(((unsigned)h) << 16); }
DI float lo2f(unsigned u) { return __uint_as_float(u << 16); }
DI float hi2f(unsigned u) { return __uint_as_float(u & 0xffff0000u); }
DI float siluf(float x) { return x * __builtin_amdgcn_rcpf(1.f + __expf(-x)); }
DI float sigmf(float x) { return __builtin_amdgcn_rcpf(1.f + __expf(-x)); }
DI float softplusf(float x) { return fmaxf(x, 0.f) + log1pf(__expf(-fabsf(x))); }
DI f32x4 mfma16(bf16x8 a, bf16x8 b, f32x4 c) { return __builtin_amdgcn_mfma_f32_16x16x32_bf16(a, b, c, 0, 0, 0); }
DI bf16x8 ldfrag(const bf16_t* base, int ld, int row, int k) { return *(const bf16x8*)(base + row * ld + k); }
typedef short s16x4 __attribute__((ext_vector_type(4)));
DI bf16x8 ldfrag_tr(const bf16_t* T, int ld, int k0, int c0, int fr, int fq) {
    const bf16_t* p0 = T + (k0 + 8 * fq + (fr >> 2)) * ld + c0 + 4 * (fr & 3);
    const s16x4 a = __builtin_amdgcn_ds_read_tr16_b64_v4i16((__attribute__((address_space(3))) s16x4*)p0);
    const s16x4 b = __builtin_amdgcn_ds_read_tr16_b64_v4i16((__attribute__((address_space(3))) s16x4*)(p0 + 4 * ld));
    return (bf16x8){a[0], a[1], a[2], a[3], b[0], b[1], b[2], b[3]};
}
DI void unpack8(u32x4 v, float* f) {
    f[0] = lo2f(v.x); f[1] = hi2f(v.x); f[2] = lo2f(v.y); f[3] = hi2f(v.y);
    f[4] = lo2f(v.z); f[5] = hi2f(v.z); f[6] = lo2f(v.w); f[7] = hi2f(v.w);
}
DI u32x4 pack8(const float* f) { u32x4 o; o.x = pack2(f[0], f[1]); o.y = pack2(f[2], f[3]); o.z = pack2(f[4], f[5]); o.w = pack2(f[6], f[7]); return o; }
DI u32x2 pack4(f32x4 v) { u32x2 o; o.x = pack2(v[0], v[1]); o.y = pack2(v[2], v[3]); return o; }
DI float wave_sum(float v) {
#pragma unroll
    for (int o = 32; o >= 1; o >>= 1) v += __shfl_xor(v, o);
    return v;
}


#define XB_TMO      128
#define XB_XCNT(j)  (256  + 64 * (j))
#define XB_XSUB(j)  (1280 + 64 * (j))
#define XB_XGEN(j)  (2304 + 64 * (j))
#define XB_TOP      3328
#define XB_TOPGEN   3392
#define XCD_BAR_WORDS 3456
#define XB_SPIN_CAP (1u << 18)
#define LAS __attribute__((address_space(3)))
DI unsigned xb_ld(unsigned* p)              { return __hip_atomic_load(p, __ATOMIC_RELAXED, __HIP_MEMORY_SCOPE_AGENT); }
DI unsigned xb_add(unsigned* p, unsigned v) { return __hip_atomic_fetch_add(p, v, __ATOMIC_RELAXED, __HIP_MEMORY_SCOPE_AGENT); }
DI unsigned xb_xcc_id() { return (unsigned)__builtin_amdgcn_s_getreg((3 << 11) | 20) & 0xFu; }
#define XB_SPIN(cond, bar) do { unsigned _sp = 0; while (cond) { __builtin_amdgcn_s_sleep(1); \
    if ((++_sp & 255u) == 0u) { if (xb_ld(&(bar)[XB_TMO])) break; if (_sp > XB_SPIN_CAP) { atomicAdd(&(bar)[XB_TMO], 1u); break; } } } } while (0)
struct XcdBarrier { unsigned* bar; unsigned x; volatile LAS unsigned* st; };
DI XcdBarrier xcd_barrier_post(unsigned* bar, volatile LAS unsigned* st) {
    XcdBarrier b; b.bar = bar; b.x = xb_xcc_id(); b.st = st;
    if (threadIdx.x == 0) (void)xb_add(&bar[XB_XCNT(b.x)], 1u);
    return b;
}
DI void xcd_barrier_complete(unsigned* bar, unsigned x, unsigned& nloc, unsigned& nx) {
    const unsigned G = gridDim.x * gridDim.y * gridDim.z;
    unsigned sum, cnt, mine, sp = 0u;
    for (;;) {
        sum = 0u; cnt = 0u; mine = 0u;
#pragma unroll
        for (unsigned j = 0; j < 16; ++j) { const unsigned c = xb_ld(&bar[XB_XCNT(j)]); sum += c; cnt += (c > 0u) ? 1u : 0u; mine = (j == x) ? c : mine; }
        if (sum == G) break;
        __builtin_amdgcn_s_sleep(1);
        if ((++sp & 255u) == 0u) { if (xb_ld(&bar[XB_TMO])) break; if (sp > XB_SPIN_CAP) { atomicAdd(&bar[XB_TMO], 1u); break; } }
    }
    nloc = mine > 0u ? mine : 1u; nx = cnt > 0u ? cnt : 1u;
}
DI void xcd_barrier(const XcdBarrier& b) {
    asm volatile("s_waitcnt vmcnt(0)" ::: "memory");
    __syncthreads();
    if (threadIdx.x == 0) {
        unsigned* bar = b.bar;
        __builtin_amdgcn_s_waitcnt(0);
        unsigned nloc = b.st[0], nx = b.st[1];
        if (nloc == 0u) { xcd_barrier_complete(bar, b.x, nloc, nx); b.st[0] = nloc; b.st[1] = nx; }
        const unsigned old = xb_add(&bar[XB_XSUB(b.x)], 1u);
        const unsigned gen = old / nloc;
        if (old + 1u == (gen + 1u) * nloc) {
            __builtin_amdgcn_fence(__ATOMIC_RELEASE, "agent");
            asm volatile("s_waitcnt vmcnt(0)" ::: "memory");
            const unsigned og = xb_add(&bar[XB_TOP], 1u);
            const unsigned tg = og / nx;
            if (og + 1u == (tg + 1u) * nx) xb_add(&bar[XB_TOPGEN], 1u);
            else XB_SPIN(xb_ld(&bar[XB_TOPGEN]) == tg, bar);
            __builtin_amdgcn_fence(__ATOMIC_ACQUIRE, "agent");
            xb_add(&bar[XB_XGEN(b.x)], 1u);
            asm volatile("s_waitcnt vmcnt(0)" ::: "memory");
        } else {
            XB_SPIN(xb_ld(&bar[XB_XGEN(b.x)]) == gen, bar);
            __builtin_amdgcn_fence(__ATOMIC_ACQUIRE, "agent");
            asm volatile("s_waitcnt vmcnt(0)" ::: "memory");
        }
    }
    __syncthreads();
}

DI void phase_norm(const float* xp, const float* xs, const float* g, bf16_t* h) {
    const int tid_ = get_tid(), lane = tid_ & 63, gw = VB * 4 + (tid_ >> 6), nw = NVB * 4;
    float4 gg[4];
#pragma unroll
    for (int i = 0; i < 4; ++i) gg[i] = *(const float4*)(g + i * 256 + lane * 4);
    for (int row = gw; row < NTOK; row += 2 * nw) {
        const int rowb = row + nw < NTOK ? row + nw : row;
        const float* sa = row < NPR ? xp + (size_t)row * 1024 : xs + (size_t)(row - NPR) * 1024;
        const float* sb = rowb < NPR ? xp + (size_t)rowb * 1024 : xs + (size_t)(rowb - NPR) * 1024;
        float4 va[4], vb[4]; float ssa = 0.f, ssb = 0.f;
#pragma unroll
        for (int i = 0; i < 4; ++i) { va[i] = *(const float4*)(sa + i * 256 + lane * 4); vb[i] = *(const float4*)(sb + i * 256 + lane * 4); }
#pragma unroll
        for (int i = 0; i < 4; ++i) {
            ssa += va[i].x * va[i].x + va[i].y * va[i].y + va[i].z * va[i].z + va[i].w * va[i].w;
            ssb += vb[i].x * vb[i].x + vb[i].y * vb[i].y + vb[i].z * vb[i].z + vb[i].w * vb[i].w;
        }
        ssa = wave_sum(ssa); ssb = wave_sum(ssb);
        const float ra = rsqrtf(ssa * (1.f / 1024.f) + 1e-6f), rb = rsqrtf(ssb * (1.f / 1024.f) + 1e-6f);
#pragma unroll
        for (int i = 0; i < 4; ++i) {
            u32x2 o; o.x = pack2(va[i].x * ra * gg[i].x, va[i].y * ra * gg[i].y); o.y = pack2(va[i].z * ra * gg[i].z, va[i].w * ra * gg[i].w);
            *(u32x2*)(h + (size_t)row * 1024 + i * 256 + lane * 4) = o;
            u32x2 q; q.x = pack2(vb[i].x * rb * gg[i].x, vb[i].y * rb * gg[i].y); q.y = pack2(vb[i].z * rb * gg[i].z, vb[i].w * rb * gg[i].w);
            *(u32x2*)(h + (size_t)rowb * 1024 + i * 256 + lane * 4) = q;
        }
    }
}
DI void phase_final_norm(float* x, const float* g) {
    const int tid_ = get_tid(), lane = tid_ & 63, gw = VB * 4 + (tid_ >> 6), nw = NVB * 4;
    float4 gg[4];
#pragma unroll
    for (int i = 0; i < 4; ++i) gg[i] = *(const float4*)(g + i * 256 + lane * 4);
    for (int row = gw; row < NTOK; row += 2 * nw) {
        const bool two = row + nw < NTOK;
        float* sa = x + (size_t)row * 1024; float* sb = x + (size_t)(two ? row + nw : row) * 1024;
        float4 va[4], vb[4]; float ssa = 0.f, ssb = 0.f;
#pragma unroll
        for (int i = 0; i < 4; ++i) { va[i] = *(const float4*)(sa + i * 256 + lane * 4); vb[i] = *(const float4*)(sb + i * 256 + lane * 4); }
#pragma unroll
        for (int i = 0; i < 4; ++i) {
            ssa += va[i].x * va[i].x + va[i].y * va[i].y + va[i].z * va[i].z + va[i].w * va[i].w;
            ssb += vb[i].x * vb[i].x + vb[i].y * vb[i].y + vb[i].z * vb[i].z + vb[i].w * vb[i].w;
        }
        ssa = wave_sum(ssa); ssb = wave_sum(ssb);
        const float ra = rsqrtf(ssa * (1.f / 1024.f) + 1e-6f), rb = rsqrtf(ssb * (1.f / 1024.f) + 1e-6f);
#pragma unroll
        for (int i = 0; i < 4; ++i) {
            float4 o; o.x = va[i].x * ra * gg[i].x; o.y = va[i].y * ra * gg[i].y; o.z = va[i].z * ra * gg[i].z; o.w = va[i].w * ra * gg[i].w;
            *(float4*)(sa + i * 256 + lane * 4) = o;
            if (two) { float4 q; q.x = vb[i].x * rb * gg[i].x; q.y = vb[i].y * rb * gg[i].y; q.z = vb[i].z * rb * gg[i].z; q.w = vb[i].w * rb * gg[i].w; *(float4*)(sb + i * 256 + lane * 4) = q; }
        }
    }
}

DI int map_row(int mode, int n) {
    if (mode == 0) return n;
    if (mode == 1 || mode == 2) {
        const int oc = n & 127;
        return ((n >> 7) << 8) + (((oc >> 2) & 1) << 7) + ((oc >> 5) << 5) + ((mode - 1) << 4) + (((oc >> 3) & 3) << 2) + (oc & 3);
    }
    if (n < 2048) return n;
    if (n < 3072) return n + 1024;
    if (n < 3080) return n - 3072 + 5632;
    if (n < 4104) return n - 3080 + 2048;
    if (n < 5640) return n - 4104 + 4096;
    return n;
}
DI void cvt_job(const float* src, int K, int N, bf16_t* dst, int mode, int rot, char* smem) {
    float* tile = (float*)smem;
    const int tid = get_tid(), nkt = K >> 6, nnt = (N + 63) >> 6, ntiles = nkt * nnt;
    const int kl0 = tid >> 4, nl4 = (tid & 15) * 4;
    float4 v[4];
    auto issue = [&](int t) __attribute__((always_inline)) {
        const int kt = t % nkt, nt = t / nkt, n = nt * 64 + nl4, nc = n < N ? n : 0;
#pragma unroll
        for (int i = 0; i < 4; ++i) {
            { const f32x4 t4 = __builtin_nontemporal_load((const f32x4*)(src + (size_t)(kt * 64 + kl0 + 16 * i) * N + nc)); v[i] = make_float4(t4[0], t4[1], t4[2], t4[3]); }
            if (n >= N) v[i] = make_float4(0.f, 0.f, 0.f, 0.f);
        }
    };
    int t = (int)((VB + rot) % NVB);
    if (t < ntiles) issue(t);
    while (t < ntiles) {
        const int kt = t % nkt, nt = t / nkt;
        __syncthreads();
#pragma unroll
        for (int i = 0; i < 4; ++i) {
            const int kl = kl0 + 16 * i;
            tile[kl * 65 + nl4] = v[i].x; tile[kl * 65 + nl4 + 1] = v[i].y; tile[kl * 65 + nl4 + 2] = v[i].z; tile[kl * 65 + nl4 + 3] = v[i].w;
        }
        const int tn = t + NVB;
        if (tn < ntiles) issue(tn);
        __syncthreads();
        const int nl = tid >> 2, kq = (tid & 3) * 16, n = nt * 64 + nl;
        if (n < N) {
            const float sc = (mode == 3 && n >= 512 && n < 1024) ? 0.08838834764831845f : 1.f;
            float tv[16];
#pragma unroll
            for (int q = 0; q < 16; ++q) tv[q] = tile[(kq + q) * 65 + nl] * sc;
            const u32x4 o0 = pack8(tv), o1 = pack8(tv + 8);
            bf16_t* d = dst + (size_t)map_row(mode, n) * K + kt * 64 + kq;
            *(u32x4*)d = o0; *(u32x4*)(d + 8) = o1;
        }
        t = tn;
    }
    __syncthreads();
}

struct Epi {
    bf16_t* o16; int ldc;
    float* o32;
    const float* rp; const float* rs; float scale;
    float* gates; bf16_t* halo; int cv0, cv1;
};
enum { EPI_GU = 0, EPI_RES = 1, EPI_PROJ = 2 };

template <int EPI>
DI void gemm_tail(const bf16_t* A, int lda, const bf16_t* Bt, int K, int nN, const Epi& e, char* smem) {
    const int tid = get_tid(), wid = tid >> 6, lane = tid & 63, wr = wid >> 1, wc = wid & 1, fr = lane & 15, fq = lane >> 4;
    const int nkt = K >> 6;
    const int nitems = EPI == EPI_GU ? nN : (EPI == EPI_PROJ ? nN + 128 : nN * (nkt >> 2));
    for (int it0 = 0; it0 < nitems; it0 += NVB) {
        int it = it0 + ((VB + (NVB >> 1)) % NVB); const bool act = it < nitems; if (!act) it = 0;
        int pm, pn, kbeg = 0, nk = nkt;
        if (EPI == EPI_GU) { pm = 128; pn = it; }
        else if (EPI == EPI_PROJ) { if (it < nN) { pm = 128; pn = it; } else { pm = it - nN; pn = nN - 1; } }
        else { pm = 128; pn = it % nN; kbeg = (it / nN) * 4; nk = 4; }
        f32x4 acc[4][4];
#pragma unroll
        for (int n = 0; n < 4; ++n)
#pragma unroll
            for (int m = 0; m < 4; ++m) acc[n][m] = (f32x4){0.f, 0.f, 0.f, 0.f};
        const bf16_t* Ab = A + (size_t)(pm * 128) * lda + kbeg * 64;
        const bf16_t* Bb = Bt + (size_t)(pn * 128) * K + kbeg * 64;
        const int sr = tid >> 3, sgc = ((tid & 7) ^ (sr & 7)) * 8;
        const bf16_t* ap = Ab + (size_t)sr * lda + sgc;
        const bf16_t* bp = Bb + (size_t)sr * K + sgc;
        const size_t a32 = (size_t)32 * lda, b32 = (size_t)32 * K;
        __attribute__((address_space(3))) char* lbase = (__attribute__((address_space(3))) char*)smem + tid * 16;
#define GEMM_STAGE(BUF)                                                                                                         \
        {                                                                                                                        \
            _Pragma("unroll") for (int ii = 0; ii < 4; ++ii) {                                                                   \
                __builtin_amdgcn_global_load_lds((const unsigned*)(ap + ii * a32), (__attribute__((address_space(3))) unsigned*)(lbase + (BUF) * 32768 + ii * 4096), 16, 0, 0);          \
                __builtin_amdgcn_global_load_lds((const unsigned*)(bp + ii * b32), (__attribute__((address_space(3))) unsigned*)(lbase + (BUF) * 32768 + 16384 + ii * 4096), 16, 0, 0);  \
            }                                                                                                                    \
            ap += 64; bp += 64;                                                                                                  \
        }
#define GEMM_COMPUTE(BUF)                                                                                                       \
        {                                                                                                                        \
            const char* SA = smem + (BUF) * 32768; const char* SB = SA + 16384;                                                  \
            _Pragma("unroll") for (int ks = 0; ks < 2; ++ks) {                                                                   \
                bf16x8 af[4], bf[4];                                                                                             \
                const int sw = ((ks * 4 + fq) ^ (fr & 7)) << 4;                                                                  \
                _Pragma("unroll") for (int m = 0; m < 4; ++m) af[m] = *(const bf16x8*)(SA + (wr * 64 + m * 16 + fr) * 128 + sw); \
                _Pragma("unroll") for (int n = 0; n < 4; ++n) bf[n] = *(const bf16x8*)(SB + (wc * 64 + n * 16 + fr) * 128 + sw); \
                _Pragma("unroll") for (int n = 0; n < 4; ++n)                                                                    \
                    _Pragma("unroll") for (int m = 0; m < 4; ++m) acc[n][m] = mfma16(bf[n], af[m], acc[n][m]);                   \
            }                                                                                                                    \
        }
        __syncthreads();
        GEMM_STAGE(0)
        for (int kt = 0; kt < nk; kt += 2) {
            asm volatile("s_waitcnt vmcnt(0)" ::: "memory");
            __syncthreads();
            GEMM_STAGE(1)
            GEMM_COMPUTE(0)
            asm volatile("s_waitcnt vmcnt(0)" ::: "memory");
            __syncthreads();
            if (kt + 2 < nk) GEMM_STAGE(0)
            GEMM_COMPUTE(1)
        }
        if (act)
#pragma unroll
        for (int m = 0; m < 4; ++m) {
            const int row = pm * 128 + wr * 64 + m * 16 + fr;
            if (EPI == EPI_GU) {
#pragma unroll
                for (int i = 0; i < 2; ++i) {
                    const f32x4 g = acc[2 * i][m], u = acc[2 * i + 1][m];
                    u32x2 o; o.x = pack2(siluf(g[0]) * u[0], siluf(g[1]) * u[1]); o.y = pack2(siluf(g[2]) * u[2], siluf(g[3]) * u[3]);
                    *(u32x2*)(e.o16 + (size_t)row * e.ldc + (pn >> 1) * 128 + (wc * 2 + i) * 32 + 8 * fq + 4 * (pn & 1)) = o;
                }
            } else if (EPI == EPI_RES) {
#pragma unroll
                for (int n = 0; n < 4; ++n) {
                    float* dst = e.o32 + (size_t)row * 1024 + pn * 128 + wc * 64 + n * 16 + 4 * fq;
#pragma unroll
                    for (int j = 0; j < 4; ++j) atomicAdd(dst + j, e.scale * acc[n][m][j]);
                }
            } else {
                if (pn < nN - 1) {
                    int hr, unit;
                    if (row < NPR) { hr = (row & 63) - 61; unit = row >> 6; } else { hr = ((row - NPR) & 15) - 13; unit = 256 + ((row - NPR) >> 4); }
#pragma unroll
                    for (int n = 0; n < 4; ++n) {
                        const int col = pn * 128 + wc * 64 + n * 16 + 4 * fq;
                        u32x2 o; o.x = pack2(acc[n][m][0], acc[n][m][1]); o.y = pack2(acc[n][m][2], acc[n][m][3]);
                        *(u32x2*)(e.o16 + (size_t)row * e.ldc + col) = o;
                        if (hr >= 0 && col >= e.cv0 && col < e.cv1) *(u32x2*)(e.halo + ((size_t)unit * 3 + hr) * 3072 + (col - e.cv0)) = o;
                    }
                } else if (wc == 0) {
#pragma unroll
                    for (int n = 0; n < 2; ++n) {
                        float4 o; o.x = acc[n][m][0]; o.y = acc[n][m][1]; o.z = acc[n][m][2]; o.w = acc[n][m][3];
                        *(float4*)(e.gates + (size_t)row * 32 + n * 16 + 4 * fq) = o;
                    }
                }
            }
        }
    }
}


namespace pg8 {
#define PG8_LAS __attribute__((address_space(3)))
constexpr int BM = 256, BK = 64, HALF = 128, HTB = HALF * BK * 2  , STAGE_BYTES = 8 * HTB, NXCD = 8, WGM = 8;
__host__ __device__ __forceinline__ int lds_byte(int r, int c) { const int st = (r >> 4) * 2 + (c >> 5), rr = r & 15, cc = c & 31, ob = rr * 64 + cc * 2; return st * 1024 + (ob ^ (((ob >> 9) & 1) << 5)); }
__host__ __device__ __forceinline__ void stage_rc(int b, int& R, int& C) { const int st = b / 1024, sb = b % 1024, swz = sb ^ (((sb >> 9) & 1) << 5); R = (st >> 1) * 16 + swz / 64; C = (st & 1) * 32 + (swz % 64) / 2; }
__host__ __device__ __forceinline__ int perm32(int rho) { const int n = rho >> 4, i = rho & 15; return 8 * (i >> 2) + 4 * n + (i & 3); }
struct Unit { int pm, pn; };
struct Gemm { const bf16_t* A; const bf16_t* Bt; int M, N, K, lda; };
struct StaticOrder {
    int nM, nN, nwg, G, c;
    __host__ __device__ void init(int M, int N, int G_, int c_) { nM = M / BM; nN = N / BM; nwg = nM * nN; G = G_; c = c_; }
    __host__ __device__ bool next(int i, Unit& u) const {
        const long L = (long)i * G + c; if (L >= nwg) return false;
        int wgid = (int)L; { const int q = nwg / NXCD, r = nwg % NXCD, xcd = wgid % NXCD, off = wgid / NXCD; wgid = (xcd < r ? xcd * (q + 1) : r * (q + 1) + (xcd - r) * q) + off; }
        const int nig = WGM * nN, gid = wgid / nig, fm = gid * WGM, gsz = (nM - fm) < WGM ? (nM - fm) : WGM;
        u.pm = fm + ((wgid % nig) % gsz); u.pn = (wgid % nig) / gsz; return true;
    }
    __device__ __forceinline__ void a_ready(const Unit&) const {}
    __device__ __forceinline__ void done(const Unit&) const {}
};

template <class Epi, class Sched>
__device__ __forceinline__ void gemm_phase(PG8_LAS unsigned char* lds, const Gemm g, const Sched& S, const Epi& E) {
    const int tid = threadIdx.x, wid = __builtin_amdgcn_readfirstlane(tid >> 6), lane = tid & 63, wr = wid >> 2, wc = wid & 3, fr = lane & 15, fq = lane >> 4;
    const int K = g.K, nt = K / BK;
#define PG8_STAMP() do {} while (0)
    PG8_STAMP();
    unsigned voffA[2], voffB[2];
#pragma unroll
    for (int i = 0; i < 2; ++i) { int R, C; stage_rc(tid * 16 + i * 8192, R, C); const int Rb = Epi::PERM ? ((R & ~31) + perm32(R & 31)) : R;
        voffA[i] = (unsigned)(R * g.lda + C) * 2u; voffB[i] = (unsigned)(Rb * K + C) * 2u; }
    const size_t kstep = (size_t)(BK * 2);
    const size_t hstepB = (size_t)HALF * K * 2, hstepA = (size_t)HALF * g.lda * 2;
    const size_t tstepB = 2 * hstepB, tstepA = 2 * hstepA;
    const unsigned ldsw = (unsigned)wid * 1024u;
    const int aoff = lds_byte(wr * 64 + fr, fq * 8), boff = lds_byte(wc * 32 + fr, fq * 8);
#define PG8_SA(b, h) (((b) * 2 + (h)) * HTB)
#define PG8_SB(b, h) ((4 + (b) * 2 + (h)) * HTB)
#define PG8_STAGE(bufoff, gbase, voff) do { _Pragma("unroll") for (int _i = 0; _i < 2; ++_i) \
        __builtin_amdgcn_global_load_lds((const unsigned*)((const char*)(gbase) + (voff)[_i]), (PG8_LAS unsigned*)(lds + (bufoff) + ldsw + _i * 8192), 16, 0, 0); } while (0)
#define PG8_LDA(dst, b, h) do { _Pragma("unroll") for (int m = 0; m < 4; ++m) _Pragma("unroll") for (int k = 0; k < 2; ++k) dst[m][k] = *(const PG8_LAS bf16x8*)(lds + PG8_SA(b, h) + aoff + m * 2048 + k * 1024); } while (0)
#define PG8_LDB(dst, b, h) do { _Pragma("unroll") for (int n = 0; n < 2; ++n) _Pragma("unroll") for (int k = 0; k < 2; ++k) dst[n][k] = *(const PG8_LAS bf16x8*)(lds + PG8_SB(b, h) + boff + n * 2048 + k * 1024); } while (0)
#define PG8_MMA(ai, bj, At, Bt) do { __builtin_amdgcn_s_setprio(1); _Pragma("unroll") for (int m = 0; m < 4; ++m) _Pragma("unroll") for (int n = 0; n < 2; ++n) _Pragma("unroll") for (int k = 0; k < 2; ++k) \
        acc[ai][bj][m][n] = __builtin_amdgcn_mfma_f32_16x16x32_bf16(Bt[n][k], At[m][k], acc[ai][bj][m][n], 0, 0, 0); __builtin_amdgcn_s_setprio(0); } while (0)
#define PG8_WAIT_V(n) asm volatile("s_waitcnt vmcnt(" #n ")" ::: "memory")
#define PG8_WAIT_L(n) asm volatile("s_waitcnt lgkmcnt(" #n ")" ::: "memory")
#define PG8_BAR __builtin_amdgcn_s_barrier()
#define PG8_SCHED __builtin_amdgcn_sched_barrier(0)
    Unit cur, nxt; int ui = 0;
    if (!S.next(0, cur)) return;
    f32x4 acc[2][2][4][2];
#pragma unroll
    for (int a = 0; a < 2; ++a)
#pragma unroll
        for (int b = 0; b < 2; ++b)
#pragma unroll
            for (int m = 0; m < 4; ++m)
#pragma unroll
                for (int n = 0; n < 2; ++n) acc[a][b][m][n] = (f32x4){0.f, 0.f, 0.f, 0.f};
    bf16x8 At[4][2], B0[2][2], B1[2][2];
    const char* cA = (const char*)g.A + (size_t)cur.pm * tstepA; const char* cB = (const char*)g.Bt + (size_t)cur.pn * tstepB;
    S.a_ready(cur);
    PG8_STAGE(PG8_SB(0, 0), cB, voffB); PG8_STAGE(PG8_SA(0, 0), cA, voffA); PG8_STAGE(PG8_SB(0, 1), cB + hstepB, voffB); PG8_STAGE(PG8_SA(0, 1), cA + hstepA, voffA);
    if (wr == 1) PG8_BAR;
    PG8_WAIT_V(4); PG8_BAR;
    PG8_STAGE(PG8_SB(1, 0), cB + kstep, voffB); PG8_STAGE(PG8_SA(1, 0), cA + kstep, voffA); PG8_STAGE(PG8_SB(1, 1), cB + hstepB + kstep, voffB);
    PG8_WAIT_V(6); PG8_BAR;
    PG8_STAMP();
    for (;;) {
        const bool has_next = S.next(ui + 1, nxt);
        const char* nA = has_next ? (const char*)g.A + (size_t)nxt.pm * tstepA : cA; const char* nB = has_next ? (const char*)g.Bt + (size_t)nxt.pn * tstepB : cB;
        for (int t = 0; t < nt; t += 2) {
            const bool last = (t == nt - 2);
            const char* a1 = cA + (size_t)(t + 1) * kstep;
            const char* a2 = last ? nA : cA + (size_t)(t + 2) * kstep; const char* b2 = last ? nB : cB + (size_t)(t + 2) * kstep;
            const char* a3 = a2 + kstep; const char* b3 = b2 + kstep;
            if (last && has_next) S.a_ready(nxt);
            PG8_LDB(B0, 0, 0); PG8_SCHED; PG8_LDA(At, 0, 0); PG8_STAGE(PG8_SA(1, 1), a1 + hstepA, voffA);
            PG8_WAIT_L(8); PG8_BAR; PG8_WAIT_L(0); PG8_MMA(0, 0, At, B0); PG8_BAR; PG8_SCHED;
            PG8_LDB(B1, 0, 1); PG8_STAGE(PG8_SB(0, 0), b2, voffB);
            PG8_BAR; PG8_WAIT_L(0); PG8_MMA(0, 1, At, B1); PG8_BAR;
            PG8_LDA(At, 0, 1); PG8_STAGE(PG8_SA(0, 0), a2, voffA);
            PG8_BAR; PG8_WAIT_L(0); PG8_MMA(1, 0, At, B0); PG8_BAR; PG8_SCHED;
            PG8_STAGE(PG8_SB(0, 1), b2 + hstepB, voffB);
            PG8_WAIT_V(6); PG8_BAR; PG8_MMA(1, 1, At, B1); PG8_BAR;
            PG8_LDB(B0, 1, 0); PG8_SCHED; PG8_LDA(At, 1, 0); PG8_STAGE(PG8_SA(0, 1), a2 + hstepA, voffA);
            PG8_WAIT_L(8); PG8_BAR; PG8_WAIT_L(0); PG8_MMA(0, 0, At, B0); PG8_BAR; PG8_SCHED;
            PG8_LDB(B1, 1, 1); PG8_STAGE(PG8_SB(1, 0), b3, voffB);
            PG8_BAR; PG8_WAIT_L(0); PG8_MMA(0, 1, At, B1); PG8_BAR;
            PG8_LDA(At, 1, 1); PG8_STAGE(PG8_SA(1, 0), a3, voffA);
            PG8_BAR; PG8_WAIT_L(0); PG8_MMA(1, 0, At, B0); PG8_BAR; PG8_SCHED;
            PG8_STAGE(PG8_SB(1, 1), b3 + hstepB, voffB);
            PG8_WAIT_V(6); PG8_BAR; PG8_MMA(1, 1, At, B1); PG8_BAR;
        }
        PG8_STAMP();
        if constexpr (!Epi::AFTER_DRAIN) { E(acc, cur, wr, wc, fr, fq); S.done(cur); }
        PG8_STAMP();
        if (!has_next) break;
#pragma unroll
        for (int a = 0; a < 2; ++a)
#pragma unroll
            for (int b = 0; b < 2; ++b)
#pragma unroll
                for (int m = 0; m < 4; ++m)
#pragma unroll
                    for (int n = 0; n < 2; ++n) acc[a][b][m][n] = (f32x4){0.f, 0.f, 0.f, 0.f};
        cur = nxt; cA = nA; cB = nB; ++ui;
    }
    PG8_WAIT_V(0);
    if (wr == 0) PG8_BAR;
    PG8_BAR;
    if constexpr (Epi::AFTER_DRAIN) { E.fused(acc, cur, wr, wc, fr, fq, lds, wid, lane); S.done(cur); }
    PG8_STAMP();
#undef PG8_STAMP
#undef PG8_SA
#undef PG8_SB
#undef PG8_STAGE
#undef PG8_LDA
#undef PG8_LDB
#undef PG8_MMA
#undef PG8_WAIT_V
#undef PG8_WAIT_L
#undef PG8_BAR
#undef PG8_SCHED
}
}

struct PEpiGU {
    static constexpr bool PERM = false, AFTER_DRAIN = false;
    bf16_t* O;
    DI void operator()(const f32x4 (&acc)[2][2][4][2], const pg8::Unit& u, int wr, int wc, int fr, int fq) const {
        asm volatile("" : "+v"(fr), "+v"(fq));
#pragma unroll
        for (int ai = 0; ai < 2; ++ai)
#pragma unroll
            for (int m = 0; m < 4; ++m) {
                bf16_t* rowp = O + (size_t)(u.pm * 256 + ai * 128 + wr * 64 + m * 16 + fr) * 2816 + u.pn * 128 + wc * 32 + 8 * fq;
                u32x4 o;
                { const f32x4 g = acc[ai][0][m][0], up = acc[ai][0][m][1]; o.x = pack2(siluf(g[0]) * up[0], siluf(g[1]) * up[1]); o.y = pack2(siluf(g[2]) * up[2], siluf(g[3]) * up[3]); }
                { const f32x4 g = acc[ai][1][m][0], up = acc[ai][1][m][1]; o.z = pack2(siluf(g[0]) * up[0], siluf(g[1]) * up[1]); o.w = pack2(siluf(g[2]) * up[2], siluf(g[3]) * up[3]); }
                *(u32x4*)rowp = o;
            }
    }
};
struct PEpiRES {
    static constexpr bool PERM = false, AFTER_DRAIN = false;
    float* X; const float* R; float scale;
    DI void operator()(const f32x4 (&acc)[2][2][4][2], const pg8::Unit& u, int wr, int wc, int fr, int fq) const {
        asm volatile("" : "+v"(fr), "+v"(fq));
#pragma unroll
        for (int ai = 0; ai < 2; ++ai)
#pragma unroll
            for (int m = 0; m < 4; ++m) {
                const size_t off = (size_t)(u.pm * 256 + ai * 128 + wr * 64 + m * 16 + fr) * 1024 + u.pn * 256 + wc * 32 + 4 * fq;
#pragma unroll
                for (int bj = 0; bj < 2; ++bj)
#pragma unroll
                    for (int n = 0; n < 2; ++n) {
                        const float4 r4 = *(const float4*)(R + off + bj * 128 + n * 16);
                        const f32x4 a = acc[ai][bj][m][n];
                        float4 o; o.x = r4.x + scale * a[0]; o.y = r4.y + scale * a[1]; o.z = r4.z + scale * a[2]; o.w = r4.w + scale * a[3];
                        *(float4*)(X + off + bj * 128 + n * 16) = o;
                    }
            }
    }
};
struct PEpiPROJ {
    static constexpr bool PERM = true, AFTER_DRAIN = false;
    bf16_t* O; int ldc; bf16_t* halo; int cv0, cv1;
    DI void operator()(const f32x4 (&acc)[2][2][4][2], const pg8::Unit& u, int wr, int wc, int fr, int fq) const {
        asm volatile("" : "+v"(fr), "+v"(fq));
#pragma unroll
        for (int ai = 0; ai < 2; ++ai)
#pragma unroll
            for (int m = 0; m < 4; ++m) {
                const int row = u.pm * 256 + ai * 128 + wr * 64 + m * 16 + fr, hr = (row & 63) - 61, unit = row >> 6;
#pragma unroll
                for (int bj = 0; bj < 2; ++bj) {
                    const int col = u.pn * 256 + bj * 128 + wc * 32 + 8 * fq;
                    const u32x2 lo = pack4(acc[ai][bj][m][0]), hi = pack4(acc[ai][bj][m][1]);
                    const u32x4 o = (u32x4){lo.x, lo.y, hi.x, hi.y};
                    *(u32x4*)(O + (size_t)row * ldc + col) = o;
                    if (hr >= 0 && col >= cv0 && col < cv1) *(u32x4*)(halo + ((size_t)unit * 3 + hr) * 3072 + (col - cv0)) = o;
                }
            }
    }
};
template <class PE>
DI void gemm_big(const bf16_t* A, int lda, const bf16_t* Bt, int K, int N, const PE& pe, char* smem_all) {
    pg8::Gemm g; g.A = A; g.Bt = Bt; g.M = NPR; g.N = N; g.K = K; g.lda = lda;
    pg8::StaticOrder S; S.init(NPR, N, (int)gridDim.x, (int)blockIdx.x);
    __syncthreads();
    pg8::gemm_phase<PE, pg8::StaticOrder>((PG8_LAS unsigned char*)smem_all, g, S, pe);
    __syncthreads();
}

#define OFF_YS   16777216
#define OFF_PC   16908288
#define OFF_PN   17432576
#define OFF_PM   17434624
#define OFF_PSSD 17434640
#define OFF_PSC  17958928
#define OFF_PG   17977360
#define OFF_PGC  18501648
#define OFF_SC   18538512
#define OFF_SN   19587088
#define OFF_SM   19591184
#define OFF_SSSD 19591216
#define OFF_SSC  20639792
#define OFF_SG   20676656
#define OFF_SGC  21725232

#define LSYNC() do { asm volatile("s_waitcnt lgkmcnt(0)" ::: "memory"); __builtin_amdgcn_s_barrier(); asm volatile("" ::: "memory"); } while (0)

DI float scan_add(float v, int lane) {
#pragma unroll
    for (int o = 1; o < 64; o <<= 1) { const float t = __shfl_up(v, o); if (lane >= o) v += t; }
    return v;
}
DI float scan_max(float v, int lane) {
#pragma unroll
    for (int o = 1; o < 64; o <<= 1) { const float t = __shfl_up(v, o); if (lane >= o) v = fmaxf(v, t); }
    return v;
}

DI void fill_cache_halo(const float* cache, int width, bf16_t* halo) {
    for (int i = VB * 256 + get_tid(); i < 8 * 3 * width; i += NVB * 256) {
        const int s = i / (3 * width), rem = i % (3 * width), r = rem / width, col = rem % width;
        halo[((size_t)(264 + s) * 3 + r) * 3072 + col] = f2bf(cache[i]);
    }
}

DI void phase_conv_ssd(const Params& p, bf16_t* BIG, const bf16_t* halo) {
    const int tid = get_tid(), cv = tid & 31, tg = tid >> 5;
    const float* cw = p.in[19]; const float* cb = p.in[20];
    for (int it = VB; it < 264 * 6; it += NVB) {
        const int unit = it / 6, cblk = it % 6, col = cblk * 256 + cv * 8;
        const bool smp = unit >= 256;
        const int L = smp ? 16 : 64, c = unit & 63, s = unit - 256;
        const size_t row0 = smp ? (size_t)NPR + s * 16 : (size_t)unit * 64;
        const bool act = tg * 8 < L;
        float x[11][8];
        if (act) {
#pragma unroll
            for (int i = 0; i < 11; ++i) {
                const int rl = tg * 8 - 3 + i;
                if (rl >= 0) { const u32x4 v = *(const u32x4*)(BIG + (row0 + rl) * 5632 + 4096 + col); unpack8(v, x[i]); }
                else if (!smp) {
                    if (c == 0) {
#pragma unroll
                        for (int j = 0; j < 8; ++j) x[i][j] = 0.f;
                    } else { const u32x4 v = *(const u32x4*)(halo + ((size_t)(unit - 1) * 3 + (rl + 3)) * 3072 + col); unpack8(v, x[i]); }
                } else {
                    const float* src = p.in[6] + ((size_t)s * 3 + (rl + 3)) * 1536 + col;
                    const float4 a = *(const float4*)src, b = *(const float4*)(src + 4);
                    x[i][0] = a.x; x[i][1] = a.y; x[i][2] = a.z; x[i][3] = a.w; x[i][4] = b.x; x[i][5] = b.y; x[i][6] = b.z; x[i][7] = b.w;
                }
            }
        }
        __syncthreads();
        if (act) {
            float w[4][8], bb[8];
#pragma unroll
            for (int i = 0; i < 4; ++i) {
                const float4 a = *(const float4*)(cw + i * 1536 + col), b = *(const float4*)(cw + i * 1536 + col + 4);
                w[i][0] = a.x; w[i][1] = a.y; w[i][2] = a.z; w[i][3] = a.w; w[i][4] = b.x; w[i][5] = b.y; w[i][6] = b.z; w[i][7] = b.w;
            }
            { const float4 a = *(const float4*)(cb + col), b = *(const float4*)(cb + col + 4);
              bb[0] = a.x; bb[1] = a.y; bb[2] = a.z; bb[3] = a.w; bb[4] = b.x; bb[5] = b.y; bb[6] = b.z; bb[7] = b.w; }
#pragma unroll
            for (int t = 0; t < 8; ++t) {
                float o[8];
#pragma unroll
                for (int j = 0; j < 8; ++j) { const float a = bb[j] + w[0][j] * x[t][j] + w[1][j] * x[t + 1][j] + w[2][j] * x[t + 2][j] + w[3][j] * x[t + 3][j]; o[j] = siluf(a); }
                *(u32x4*)(BIG + (row0 + tg * 8 + t) * 5632 + 4096 + col) = pack8(o);
            }
        }
        if ((smp || c == 63) && tid < 96) {
            const int i = tid >> 5;
            float f[8]; unpack8(*(const u32x4*)(halo + ((size_t)unit * 3 + i) * 3072 + col), f);
            float* dst = smp ? p.out + OFF_SSC + ((size_t)s * 3 + i) * 1536 + col : p.out + OFF_PSC + ((size_t)(unit >> 6) * 3 + i) * 1536 + col;
            *(float4*)dst = make_float4(f[0], f[1], f[2], f[3]); *(float4*)(dst + 4) = make_float4(f[4], f[5], f[6], f[7]);
        }
        __syncthreads();
    }
}

#define L_Q   0
#define L_K   17408
#define L_KT  34816
#define L_VT  53248
#define L_VW  55552
#define L_P   57856
#define L_ST  67072
#define L_F   71424

template <int NT>
DI void mlstm_chain(const Params& p, bf16_t* BIG, const float* gates, int b, int hd, int es, bool smp, char* smem, bool live) {
    const int tid = get_tid(), wid = tid >> 6, lane = tid & 63, fr = lane & 15, fq = lane >> 4;
    bf16_t* Qs = (bf16_t*)(smem + L_Q); bf16_t* Ks = (bf16_t*)(smem + L_K); bf16_t* WRs = (bf16_t*)(smem + L_KT);     bf16_t* VTs = (bf16_t*)(smem + L_VT);
    constexpr int LDV = 16 * NT + 8;
    bf16_t* VWs = VTs + 64 * LDV; bf16_t* Ps = VWs + 64 * LDV; bf16_t* STs = Ps + 64 * 72;
    float* fl = (float*)(STs + 16 * NT * 136);
    float* as_ = fl; float* Ms = fl + 64; float* bs = fl + 128; float* wrs = fl + 192; float* rsum = fl + 256; float* qns = fl + 320; float* ns = fl + 384; float* sc = fl + 512;
    const int L = smp ? 16 : 64, nch = smp ? 1 : 64, sidx = b * 4 + hd;
    const size_t row0 = smp ? (size_t)NPR + b * 16 : (size_t)b * 4096;
    const float bi = p.in[16][hd], bfg = p.in[17][hd];
    float m = 0.f;
    f32x4 accN[2];
    accN[0] = (f32x4){0.f, 0.f, 0.f, 0.f}; accN[1] = accN[0];
    f32x4 accC[2][NT];
#pragma unroll
    for (int mt = 0; mt < 2; ++mt)
#pragma unroll
        for (int nt = 0; nt < NT; ++nt) accC[mt][nt] = (f32x4){0.f, 0.f, 0.f, 0.f};
    if (smp) {
        const float* C0 = p.in[2] + (size_t)sidx * 128 * 256;
#pragma unroll
        for (int mt = 0; mt < 2; ++mt)
#pragma unroll
            for (int nt = 0; nt < NT; ++nt)
#pragma unroll
                for (int j = 0; j < 4; ++j) accC[mt][nt][j] = C0[(size_t)(32 * wid + 16 * mt + 4 * fq + j) * 256 + es * 16 * NT + nt * 16 + fr];
        if (fr == 0) {
#pragma unroll
            for (int mt = 0; mt < 2; ++mt)
#pragma unroll
                for (int j = 0; j < 4; ++j) accN[mt][j] = p.in[3][sidx * 128 + 32 * wid + 16 * mt + 4 * fq + j];
        }
        m = p.in[4][sidx];
    }
    LSYNC();
#pragma unroll
    for (int mt = 0; mt < 2; ++mt)
#pragma unroll
        for (int nt = 0; nt < NT; ++nt) *(u32x2*)(STs + (nt * 16 + fr) * 136 + 32 * wid + 16 * mt + 4 * fq) = pack4(accC[mt][nt]);
#pragma unroll
    for (int mt = 0; mt < 2; ++mt) if (fr == 0) { ns[32 * wid + 16 * mt + 4 * fq] = accN[mt][0]; ns[32 * wid + 16 * mt + 4 * fq + 1] = accN[mt][1]; ns[32 * wid + 16 * mt + 4 * fq + 2] = accN[mt][2]; ns[32 * wid + 16 * mt + 4 * fq + 3] = accN[mt][3]; }
    for (int i = tid; i < 16 * 72 / 2; i += 256) ((unsigned*)WRs)[i] = 0u;

    u32x4 qv[4], kv[4], vv; float gi = 0.f, gf = 0.f;
    auto load = [&](int c) __attribute__((always_inline)) {
        const size_t r0 = row0 + (size_t)c * 64;
{
            const int r = tid >> 2, qt = tid & 3, rc = r < L ? r : L - 1;
            const bf16_t* qp = BIG + (r0 + rc) * 5632 + hd * 128 + qt * 32;
#pragma unroll
            for (int i = 0; i < 4; ++i) {
                qv[i] = *(const u32x4*)(qp + i * 8); kv[i] = *(const u32x4*)(qp + 512 + i * 8);
                if (r >= L) { qv[i] = (u32x4){0u, 0u, 0u, 0u}; kv[i] = (u32x4){0u, 0u, 0u, 0u}; }
            }
        }
        { const int vt = NT == 2 ? tid : (tid & 127), r = vt >> NT, cc = vt & (2 * NT - 1), rc = r < L ? r : L - 1;
          vv = *(const u32x4*)(BIG + (r0 + rc) * 5632 + 1024 + hd * 256 + es * 16 * NT + cc * 8);
          if (r >= L) vv = (u32x4){0u, 0u, 0u, 0u}; }
        { const int lc = lane < L ? lane : L - 1; gi = gates[(r0 + lc) * 32 + hd]; gf = gates[(r0 + lc) * 32 + 4 + hd]; }
    };
    load(0);
    for (int c = 0; c < nch; ++c) {
        LSYNC();
        if (wid == 0) {
            float ig = -1e30f, lf = 0.f;
            if (lane < L) { ig = gi + bi; const float x = gf + bfg; lf = fminf(x, 0.f) - log1pf(__expf(-fabsf(x))); }
            const float bc = scan_add(lf, lane);
            const float a = ig - bc;
            const float pm = scan_max(a, lane);
            const float M = fmaxf(m, pm);
            const float Mlast = __shfl(M, L - 1), bL = __shfl(bc, L - 1);
            as_[lane] = a; Ms[lane] = M; bs[lane] = bc; { const float wrv = lane < L ? __expf(a - Mlast) : 0.f; wrs[lane] = wrv; WRs[lane] = f2bf(wrv); }
            if (lane == 0) { sc[0] = Mlast; sc[1] = bL; }
        }
        LSYNC();
{
            const int r = tid >> 2, qt = tid & 3;
            bf16_t* qd = Qs + r * 136 + qt * 32; bf16_t* kd = Ks + r * 136 + qt * 32;
#pragma unroll
            for (int i = 0; i < 4; ++i) { *(u32x4*)(qd + i * 8) = qv[i]; *(u32x4*)(kd + i * 8) = kv[i]; }
        }
        if (NT == 2 || tid < 128) {
            const int r = tid >> NT, cc = tid & (2 * NT - 1); const float w = wrs[r];
            float vf[8]; unpack8(vv, vf);
#pragma unroll
            for (int j = 0; j < 8; ++j) vf[j] *= w;
            *(u32x4*)(VTs + r * LDV + cc * 8) = vv; *(u32x4*)(VWs + r * LDV + cc * 8) = pack8(vf);
        }
        if (c + 1 < nch) load(c + 1);
        LSYNC();
        {
            f32x4 s4[4];
#pragma unroll
            for (int nt = 0; nt < 4; ++nt) s4[nt] = (f32x4){0.f, 0.f, 0.f, 0.f};
#pragma unroll 1
            for (int kk = 0; kk < 4; ++kk) {
                const bf16x8 qf = ldfrag(Qs, 136, 16 * wid + fr, kk * 32 + fq * 8);
#pragma unroll
                for (int nt = 0; nt < 4; ++nt) s4[nt] = mfma16(ldfrag(Ks, 136, 16 * nt + fr, kk * 32 + fq * 8), qf, s4[nt]);
            }
            const int s = 16 * wid + fr; const float Msv = Ms[s]; float rs = 0.f;
#pragma unroll
            for (int nt = 0; nt < 4; ++nt) {
                f32x4 pv;
#pragma unroll
                for (int j = 0; j < 4; ++j) { const int r = 16 * nt + 4 * fq + j; const float d = (r <= s) ? __expf(as_[r] - Msv) : 0.f; pv[j] = s4[nt][j] * d; rs += pv[j]; }
                *(u32x2*)(Ps + s * 72 + 16 * nt + 4 * fq) = pack4(pv);
            }
            rs += __shfl_xor(rs, 16); rs += __shfl_xor(rs, 32);
            if (fq == 0) rsum[s] = rs;
            const int s2 = tid >> 2, part = tid & 3; float qa = 0.f;
#pragma unroll
            for (int j = 0; j < 4; ++j) { float qf8[8]; unpack8(*(const u32x4*)(Qs + s2 * 136 + part * 32 + j * 8), qf8);
#pragma unroll
                for (int i = 0; i < 8; ++i) qa += qf8[i] * ns[part * 32 + j * 8 + i]; }
            qa += __shfl_xor(qa, 1); qa += __shfl_xor(qa, 2);
            if (part == 0) qns[s2] = qa;
        }
        LSYNC();
        const float Mlast = sc[0], bL = sc[1];
        {
            bf16x8 pf[2], qf[4];
#pragma unroll
            for (int kk = 0; kk < 2; ++kk) pf[kk] = ldfrag(Ps, 72, 16 * wid + fr, kk * 32 + fq * 8);
#pragma unroll
            for (int kk = 0; kk < 4; ++kk) qf[kk] = ldfrag(Qs, 136, 16 * wid + fr, kk * 32 + fq * 8);
            const int s = 16 * wid + fr; const float Msv = Ms[s], wi = __expf(m - Msv);
            const float den = rsum[s] + wi * qns[s], ms = bs[s] + Msv, inv = 1.f / fmaxf(fabsf(den), __expf(-ms));
#pragma unroll
            for (int nt = 0; nt < NT; ++nt) {
                f32x4 h1 = (f32x4){0.f, 0.f, 0.f, 0.f}, h2 = h1;
#pragma unroll
                for (int kk = 0; kk < 2; ++kk) h1 = mfma16(ldfrag_tr(VTs, LDV, kk * 32, nt * 16, fr, fq), pf[kk], h1);
#pragma unroll
                for (int kk = 0; kk < 4; ++kk) h2 = mfma16(ldfrag(STs, 136, nt * 16 + fr, kk * 32 + fq * 8), qf[kk], h2);
                f32x4 hv;
#pragma unroll
                for (int j = 0; j < 4; ++j) hv[j] = (h1[j] + wi * h2[j]) * inv;
                if (s < L && live) *(u32x2*)(BIG + (row0 + (size_t)c * 64 + s) * 5632 + 1024 + hd * 256 + es * 16 * NT + nt * 16 + 4 * fq) = pack4(hv);
            }
        }
        {
            const float decay = __expf(m - Mlast);
            bf16x8 vw0[NT], vw1[NT];
#pragma unroll
            for (int nt = 0; nt < NT; ++nt) { vw0[nt] = ldfrag_tr(VWs, LDV, 0, nt * 16, fr, fq); vw1[nt] = ldfrag_tr(VWs, LDV, 32, nt * 16, fr, fq); }
#pragma unroll
            for (int mt = 0; mt < 2; ++mt) {
                const bf16x8 k0 = ldfrag_tr(Ks, 136, 0, 32 * wid + 16 * mt, fr, fq), k1 = ldfrag_tr(Ks, 136, 32, 32 * wid + 16 * mt, fr, fq);
#pragma unroll
                for (int nt = 0; nt < NT; ++nt) {
                    accC[mt][nt] *= decay;
                    accC[mt][nt] = mfma16(k0, vw0[nt], accC[mt][nt]);
                    accC[mt][nt] = mfma16(k1, vw1[nt], accC[mt][nt]);
                }
                accN[mt] *= decay;
                accN[mt] = mfma16(k0, ldfrag(WRs, 72, fr, fq * 8), accN[mt]);
                accN[mt] = mfma16(k1, ldfrag(WRs, 72, fr, 32 + fq * 8), accN[mt]);
            }
        }
        m = bL + Mlast;
        LSYNC();
#pragma unroll
        for (int mt = 0; mt < 2; ++mt)
#pragma unroll
            for (int nt = 0; nt < NT; ++nt) *(u32x2*)(STs + (nt * 16 + fr) * 136 + 32 * wid + 16 * mt + 4 * fq) = pack4(accC[mt][nt]);
    #pragma unroll
        for (int mt = 0; mt < 2; ++mt) if (fr == 0) { ns[32 * wid + 16 * mt + 4 * fq] = accN[mt][0]; ns[32 * wid + 16 * mt + 4 * fq + 1] = accN[mt][1]; ns[32 * wid + 16 * mt + 4 * fq + 2] = accN[mt][2]; ns[32 * wid + 16 * mt + 4 * fq + 3] = accN[mt][3]; }
    }
    if (!live) return;
    float* Co = p.out + (smp ? OFF_SC : OFF_PC) + (size_t)sidx * 128 * 256;
#pragma unroll
    for (int mt = 0; mt < 2; ++mt)
#pragma unroll
        for (int nt = 0; nt < NT; ++nt)
#pragma unroll
            for (int j = 0; j < 4; ++j) Co[(size_t)(32 * wid + 16 * mt + 4 * fq + j) * 256 + es * 16 * NT + nt * 16 + fr] = accC[mt][nt][j];
    if (es == 0) {
        if (fr == 0) {
#pragma unroll
            for (int mt = 0; mt < 2; ++mt)
#pragma unroll
                for (int j = 0; j < 4; ++j) p.out[(smp ? OFF_SN : OFF_PN) + sidx * 128 + 32 * wid + 16 * mt + 4 * fq + j] = accN[mt][j];
        }
        if (tid == 0) p.out[(smp ? OFF_SM : OFF_PM) + sidx] = m;
    }
}

template <int NT>
DI void ssd_chain(const Params& p, bf16_t* BIG, const float* gates, int b, int hd, int ps, bool smp, char* smem, bool live) {
    const int tid = get_tid(), wid = tid >> 6, lane = tid & 63, fr = lane & 15, fq = lane >> 4;
    bf16_t* Cs = (bf16_t*)(smem + L_Q); bf16_t* Bs = (bf16_t*)(smem + L_K);  bf16_t* XTs = (bf16_t*)(smem + L_VT);
    constexpr int LDX = 16 * NT + 8;
    bf16_t* XWs = XTs + 64 * LDX; bf16_t* Ps = XWs + 64 * LDX; bf16_t* STs = Ps + 64 * 72;
    float* fl = (float*)(STs + 16 * NT * 136);
    float* bs = fl; float* dts = fl + 64; float* wrs = fl + 128; float* sc = fl + 192;
    const int L = smp ? 16 : 64, nch = smp ? 1 : 64, sidx = b * 16 + hd, g = hd >> 3;
    const size_t row0 = smp ? (size_t)NPR + b * 16 : (size_t)b * 4096;
    const float dtb = p.in[21][hd], negA = -__expf(p.in[22][hd]), Dk = p.in[23][hd];
    f32x4 accS[2][NT];
#pragma unroll
    for (int i = 0; i < 2; ++i)
#pragma unroll
        for (int nt = 0; nt < NT; ++nt) accS[i][nt] = (f32x4){0.f, 0.f, 0.f, 0.f};
    if (smp) {
        const float* S0 = p.in[5] + (size_t)sidx * 64 * 128;
#pragma unroll
        for (int i = 0; i < 2; ++i)
#pragma unroll
            for (int nt = 0; nt < NT; ++nt)
#pragma unroll
                for (int j = 0; j < 4; ++j) accS[i][nt][j] = S0[(size_t)(ps * 16 * NT + nt * 16 + fr) * 128 + 16 * (2 * wid + i) + 4 * fq + j];
    }
    LSYNC();
#pragma unroll
    for (int i = 0; i < 2; ++i)
#pragma unroll
        for (int nt = 0; nt < NT; ++nt) *(u32x2*)(STs + (nt * 16 + fr) * 136 + 16 * (2 * wid + i) + 4 * fq) = pack4(accS[i][nt]);

    u32x4 qv[4], kv[4], vv; float gd = 0.f;
    auto load = [&](int c) __attribute__((always_inline)) {
        const size_t r0 = row0 + (size_t)c * 64;
{
            const int r = tid >> 2, qt = tid & 3, rc = r < L ? r : L - 1;
            const bf16_t* bp = BIG + (r0 + rc) * 5632 + 5120 + g * 128 + qt * 32;
#pragma unroll
            for (int i = 0; i < 4; ++i) {
                qv[i] = *(const u32x4*)(bp + 256 + i * 8); kv[i] = *(const u32x4*)(bp + i * 8);
                if (r >= L) { qv[i] = (u32x4){0u, 0u, 0u, 0u}; kv[i] = (u32x4){0u, 0u, 0u, 0u}; }
            }
        }
        { const int vt = NT == 2 ? tid : (tid & 127), r = vt >> NT, cc = vt & (2 * NT - 1), rc = r < L ? r : L - 1;
          vv = *(const u32x4*)(BIG + (r0 + rc) * 5632 + 4096 + hd * 64 + ps * 16 * NT + cc * 8);
          if (r >= L) vv = (u32x4){0u, 0u, 0u, 0u}; }
        { const int lc = lane < L ? lane : L - 1; gd = gates[(r0 + lc) * 32 + 8 + hd]; }
    };
    load(0);
    for (int c = 0; c < nch; ++c) {
        LSYNC();
        if (wid == 0) {
            float dtv = 0.f;
            if (lane < L) dtv = softplusf(gd + dtb);
            const float a = negA * dtv;
            const float bc = scan_add(a, lane);
            const float bL = __shfl(bc, L - 1);
            bs[lane] = bc; dts[lane] = dtv; wrs[lane] = __expf(bL - bc) * dtv;
            if (lane == 0) sc[1] = bL;
        }
        LSYNC();
{
            const int r = tid >> 2, qt = tid & 3;
            bf16_t* qd = Cs + r * 136 + qt * 32; bf16_t* kd = Bs + r * 136 + qt * 32;
#pragma unroll
            for (int i = 0; i < 4; ++i) { *(u32x4*)(qd + i * 8) = qv[i]; *(u32x4*)(kd + i * 8) = kv[i]; }
        }
        if (NT == 2 || tid < 128) {
            const int r = tid >> NT, cc = tid & (2 * NT - 1); const float w = wrs[r];
            float vf[8]; unpack8(vv, vf);
#pragma unroll
            for (int j = 0; j < 8; ++j) vf[j] *= w;
            *(u32x4*)(XTs + r * LDX + cc * 8) = vv; *(u32x4*)(XWs + r * LDX + cc * 8) = pack8(vf);
        }
        if (c + 1 < nch) load(c + 1);
        LSYNC();
        {
            f32x4 s4[4];
#pragma unroll
            for (int nt = 0; nt < 4; ++nt) s4[nt] = (f32x4){0.f, 0.f, 0.f, 0.f};
#pragma unroll 1
            for (int kk = 0; kk < 4; ++kk) {
                const bf16x8 qf = ldfrag(Cs, 136, 16 * wid + fr, kk * 32 + fq * 8);
#pragma unroll
                for (int nt = 0; nt < 4; ++nt) s4[nt] = mfma16(ldfrag(Bs, 136, 16 * nt + fr, kk * 32 + fq * 8), qf, s4[nt]);
            }
            const int s = 16 * wid + fr; const float bsv = bs[s];
#pragma unroll
            for (int nt = 0; nt < 4; ++nt) {
                f32x4 pv;
#pragma unroll
                for (int j = 0; j < 4; ++j) { const int r = 16 * nt + 4 * fq + j; const float d = (r <= s) ? __expf(bsv - bs[r]) * dts[r] : 0.f; pv[j] = s4[nt][j] * d; }
                *(u32x2*)(Ps + s * 72 + 16 * nt + 4 * fq) = pack4(pv);
            }
        }
        LSYNC();
        const float bL = sc[1];
        {
            bf16x8 pf[2], cf[4];
#pragma unroll
            for (int kk = 0; kk < 2; ++kk) pf[kk] = ldfrag(Ps, 72, 16 * wid + fr, kk * 32 + fq * 8);
#pragma unroll
            for (int kk = 0; kk < 4; ++kk) cf[kk] = ldfrag(Cs, 136, 16 * wid + fr, kk * 32 + fq * 8);
            const int s = 16 * wid + fr; const float eb = __expf(bs[s]);
#pragma unroll
            for (int nt = 0; nt < NT; ++nt) {
                f32x4 h1 = (f32x4){0.f, 0.f, 0.f, 0.f}, h2 = h1;
#pragma unroll
                for (int kk = 0; kk < 2; ++kk) h1 = mfma16(ldfrag_tr(XTs, LDX, kk * 32, nt * 16, fr, fq), pf[kk], h1);
#pragma unroll
                for (int kk = 0; kk < 4; ++kk) h2 = mfma16(ldfrag(STs, 136, nt * 16 + fr, kk * 32 + fq * 8), cf[kk], h2);
                if (s < L && live) {
                    bf16_t* zp = BIG + (row0 + (size_t)c * 64 + s) * 5632 + 2048 + hd * 64 + ps * 16 * NT + nt * 16 + 4 * fq;
                    const u32x2 zr = *(const u32x2*)zp;
                    const float zf[4] = {lo2f(zr.x), hi2f(zr.x), lo2f(zr.y), hi2f(zr.y)};
                    f32x4 yv;
#pragma unroll
                    for (int j = 0; j < 4; ++j) { const float xv = bf2f(XTs[s * LDX + nt * 16 + 4 * fq + j]); yv[j] = (h1[j] + eb * h2[j] + Dk * xv) * siluf(zf[j]); }
                    *(u32x2*)zp = pack4(yv);
                }
            }
        }
        {
            const float dec = __expf(bL);
#pragma unroll
            for (int i = 0; i < 2; ++i) {
                const bf16x8 b0 = ldfrag_tr(Bs, 136, 0, 16 * (2 * wid + i), fr, fq), b1 = ldfrag_tr(Bs, 136, 32, 16 * (2 * wid + i), fr, fq);
#pragma unroll
                for (int nt = 0; nt < NT; ++nt) {
                    accS[i][nt] *= dec;
                    accS[i][nt] = mfma16(b0, ldfrag_tr(XWs, LDX, 0, nt * 16, fr, fq), accS[i][nt]);
                    accS[i][nt] = mfma16(b1, ldfrag_tr(XWs, LDX, 32, nt * 16, fr, fq), accS[i][nt]);
                }
            }
        }
        LSYNC();
#pragma unroll
        for (int i = 0; i < 2; ++i)
#pragma unroll
            for (int nt = 0; nt < NT; ++nt) *(u32x2*)(STs + (nt * 16 + fr) * 136 + 16 * (2 * wid + i) + 4 * fq) = pack4(accS[i][nt]);
    }
    if (!live) return;
    float* So = p.out + (smp ? OFF_SSSD : OFF_PSSD) + (size_t)sidx * 64 * 128;
#pragma unroll
    for (int i = 0; i < 2; ++i)
#pragma unroll
        for (int nt = 0; nt < NT; ++nt) {
            float4 o; o.x = accS[i][nt][0]; o.y = accS[i][nt][1]; o.z = accS[i][nt][2]; o.w = accS[i][nt][3];
            *(float4*)(So + (size_t)(ps * 16 * NT + nt * 16 + fr) * 128 + 16 * (2 * wid + i) + 4 * fq) = o;
        }
}

DI void phase_scan_l0(const Params& p, bf16_t* BIG, const float* gates, char* smem, bool live) {
    if (gridDim.x != 256) {
        for (int it = VB; it < 512; it += NVB) {
            const int k = it & 255;
            if (it < 256) mlstm_chain<1>(p, BIG, gates, k >> 6, (k >> 4) & 3, k & 15, false, smem, live);
            else ssd_chain<1>(p, BIG, gates, k >> 6, (k >> 2) & 15, k & 3, false, smem, live);
        }
    } else {
        const int x = (int)blockIdx.x & 7, y = (int)blockIdx.x >> 3, sub = get_sub();
        if (sub != 0) { for (int i = 0; i < 321; ++i) { asm volatile("" ::: "memory"); __builtin_amdgcn_s_barrier(); } }
        else if (y < 16) { const int chain = x + 8 * (y >> 3); mlstm_chain<2>(p, BIG, gates, chain >> 2, chain & 3, y & 7, false, smem, live); }
        else { const int yy = y - 16; ssd_chain<2>(p, BIG, gates, x >> 1, (x & 1) * 8 + (yy >> 1), yy & 1, false, smem, live); }
    }
    for (int it = 512 + VB; it < 1536; it += NVB) {
        const int k = (it - 512) & 511;
        if (it < 1024) mlstm_chain<1>(p, BIG, gates, k >> 6, (k >> 4) & 3, k & 15, true, smem, live);
        else ssd_chain<1>(p, BIG, gates, k >> 6, (k >> 2) & 15, k & 3, true, smem, live);
    }
}

DI void phase_post_l0(const Params& p, bf16_t* BIG) {
    const int tid_ = get_tid(), lane = tid_ & 63, gw = VB * 4 + (tid_ >> 6), nw = NVB * 4;
    for (int row = gw; row < NTOK; row += nw) {
        bf16_t* rp = BIG + (size_t)row * 5632;
        u32x2 rv[4], ov[4]; u32x4 yv[2];
#pragma unroll
        for (int hd = 0; hd < 4; ++hd) { rv[hd] = *(const u32x2*)(rp + 1024 + hd * 256 + lane * 4); ov[hd] = *(const u32x2*)(rp + 3072 + hd * 256 + lane * 4); }
#pragma unroll
        for (int g = 0; g < 2; ++g) yv[g] = *(const u32x4*)(rp + 2048 + g * 512 + lane * 8);
#pragma unroll
        for (int hd = 0; hd < 4; ++hd) {
            const float x[4] = {lo2f(rv[hd].x), hi2f(rv[hd].x), lo2f(rv[hd].y), hi2f(rv[hd].y)}, o[4] = {lo2f(ov[hd].x), hi2f(ov[hd].x), lo2f(ov[hd].y), hi2f(ov[hd].y)};
            const float ss = wave_sum(x[0] * x[0] + x[1] * x[1] + x[2] * x[2] + x[3] * x[3]);
            const float r = rsqrtf(ss * (1.f / 256.f) + 1e-6f);
            const float4 gg = *(const float4*)(p.in[18] + hd * 256 + lane * 4);
            f32x4 y; y[0] = sigmf(o[0]) * x[0] * r * gg.x; y[1] = sigmf(o[1]) * x[1] * r * gg.y; y[2] = sigmf(o[2]) * x[2] * r * gg.z; y[3] = sigmf(o[3]) * x[3] * r * gg.w;
            *(u32x2*)(rp + 1024 + hd * 256 + lane * 4) = pack4(y);
        }
#pragma unroll
        for (int g = 0; g < 2; ++g) {
            float x[8]; unpack8(yv[g], x);
            float ss = 0.f;
#pragma unroll
            for (int j = 0; j < 8; ++j) ss += x[j] * x[j];
            ss = wave_sum(ss);
            const float r = rsqrtf(ss * (1.f / 512.f) + 1e-6f);
            const float4 g0 = *(const float4*)(p.in[24] + g * 512 + lane * 8), g1 = *(const float4*)(p.in[24] + g * 512 + lane * 8 + 4);
            float y[8] = {x[0] * r * g0.x, x[1] * r * g0.y, x[2] * r * g0.z, x[3] * r * g0.w, x[4] * r * g1.x, x[5] * r * g1.y, x[6] * r * g1.z, x[7] * r * g1.w};
            *(u32x4*)(rp + 2048 + g * 512 + lane * 8) = pack8(y);
        }
    }
}

#define G_QN  0
#define G_KN  18432
#define G_AT  36864
#define G_VN  53504
#define G_TV  0
#define G_TW  9216
#define G_F   71936
DI void gdn_g1_item(const Params& p, bf16_t* BIG, bf16_t* Wb, bf16_t* PB, const float* gates, const bf16_t* halo, float* egl, int unit, int hd, char* smem, bool live) {
    const int tid = get_tid(), wid = tid >> 6, lane = tid & 63, fr = lane & 15, fq = lane >> 4;
    bf16_t* Qn = (bf16_t*)(smem + G_QN); bf16_t* Kn = (bf16_t*)(smem + G_KN);
    bf16_t* Vn = (bf16_t*)(smem + G_VN);
    float* AT = (float*)(smem + G_AT); bf16_t* Tv = (bf16_t*)(smem + G_TV); bf16_t* Tw = (bf16_t*)(smem + G_TW);
    float* beta_s = (float*)(smem + G_F); float* gam_s = beta_s + 64;
    const bool smp = unit >= 256;
    const int L = smp ? 16 : 64, c = unit & 63, s_ = unit - 256;
    const size_t row0 = smp ? (size_t)NPR + s_ * 16 : (size_t)unit * 64;
    const int tok = tid >> 2, qt = tid & 3;
    const float* cw = p.in[27];
    const bf16_t* hp = halo + (size_t)(smp ? 264 + s_ : (unit > 0 ? unit - 1 : 0)) * 3 * 3072;
    const bool zh = !smp && c == 0;
    LSYNC();
    if (wid == 0) {
        float beta = 0.f, g = 0.f;
        const int lc = lane < L ? lane : L - 1;
        const float br = gates[(row0 + lc) * 32 + hd], ar = gates[(row0 + lc) * 32 + 8 + hd];
        if (lane < L) { beta = sigmf(br); g = -__expf(p.in[29][hd]) * softplusf(ar + p.in[28][hd]); }
        const float gam = scan_add(g, lane);
        beta_s[lane] = beta; gam_s[lane] = gam;
        if (lane == L - 1 && live) egl[unit * 8 + hd] = __expf(gam);
    }
    u32x4 xn[16];
    auto g1_issue = [&](int mi) __attribute__((always_inline)) {
#pragma unroll
        for (int j = 0; j < 4; ++j) {
            const int col = mi * 1024 + hd * 128 + j * 32 + qt * 8;
#pragma unroll
            for (int i = 0; i < 4; ++i) {
                const int tc = tok < L ? tok : L - 1, rlc = tc - 3 + i;
                const bf16_t* src = rlc >= 0 ? BIG + (row0 + rlc) * 4096 + col : hp + (rlc + 3) * 3072 + col;
                xn[j * 4 + i] = *(const u32x4*)src;
                if (rlc < 0 && zh) xn[j * 4 + i] = (u32x4){0u, 0u, 0u, 0u};
            }
        }
    };
    g1_issue(0);
#pragma unroll 1
    for (int mi = 0; mi < 3; ++mi) {
        float o[32];
        u32x4 xc[16];
#pragma unroll
        for (int q = 0; q < 16; ++q) xc[q] = xn[q];
        if (mi < 2) g1_issue(mi + 1);
#pragma unroll
        for (int j = 0; j < 4; ++j) {
            const int col = mi * 1024 + hd * 128 + j * 32 + qt * 8;
            float a8[8];
#pragma unroll
            for (int q = 0; q < 8; ++q) a8[q] = 0.f;
#pragma unroll
            for (int i = 0; i < 4; ++i) {
                float xf[8]; unpack8(xc[j * 4 + i], xf);
                const float4 w0 = *(const float4*)(cw + i * 3072 + col), w1 = *(const float4*)(cw + i * 3072 + col + 4);
                a8[0] += w0.x * xf[0]; a8[1] += w0.y * xf[1]; a8[2] += w0.z * xf[2]; a8[3] += w0.w * xf[3];
                a8[4] += w1.x * xf[4]; a8[5] += w1.y * xf[5]; a8[6] += w1.z * xf[6]; a8[7] += w1.w * xf[7];
            }
#pragma unroll
            for (int q = 0; q < 8; ++q) o[j * 8 + q] = siluf(a8[q]);
        }
        if (mi < 2) {
            float ss = 0.f;
#pragma unroll
            for (int q = 0; q < 32; ++q) ss += o[q] * o[q];
            ss += __shfl_xor(ss, 1); ss += __shfl_xor(ss, 2);
            const float sc = rsqrtf(ss + 1e-6f) * (mi == 0 ? 0.08838834764831845f : 1.f);
#pragma unroll
            for (int q = 0; q < 32; ++q) o[q] *= sc;
        }
        if (tok >= L) {
#pragma unroll
            for (int q = 0; q < 32; ++q) o[q] = 0.f;
        }
        bf16_t* dst = (mi == 0 ? Qn : (mi == 1 ? Kn : Vn)) + tok * 136 + qt * 8;
#pragma unroll
        for (int j = 0; j < 4; ++j) *(u32x4*)(dst + j * 32) = pack8(o + j * 8);
    }
    LSYNC();
    {
        f32x4 a4[4], p4[4];
#pragma unroll
        for (int nt = 0; nt < 4; ++nt) { a4[nt] = (f32x4){0.f, 0.f, 0.f, 0.f}; p4[nt] = a4[nt]; }
#pragma unroll 1
        for (int kk = 0; kk < 4; ++kk) {
            const bf16x8 qf = ldfrag(Qn, 136, 16 * wid + fr, kk * 32 + fq * 8), ksf = ldfrag(Kn, 136, 16 * wid + fr, kk * 32 + fq * 8);
#pragma unroll
            for (int nt = 0; nt < 4; ++nt) { const bf16x8 kf = ldfrag(Kn, 136, 16 * nt + fr, kk * 32 + fq * 8); a4[nt] = mfma16(kf, ksf, a4[nt]); p4[nt] = mfma16(kf, qf, p4[nt]); }
        }
        const int s = 16 * wid + fr; const float gs = gam_s[s], bsv = beta_s[s];
#pragma unroll
        for (int nt = 0; nt < 4; ++nt) {
            f32x4 pv;
#pragma unroll
            for (int j = 0; j < 4; ++j) {
                const int r = 16 * nt + 4 * fq + j;
                const float d = (r <= s) ? __expf(gs - gam_s[r]) : 0.f;
                pv[j] = p4[nt][j] * d;
                AT[s * 65 + r] = (r < s) ? a4[nt][j] * d * bsv : 0.f;
            }
            if (s < L && live) *(u32x2*)(PB + (row0 + s) * 512 + hd * 64 + 16 * nt + 4 * fq) = pack4(pv);
        }
    }
    LSYNC();
    if (tok < L && live) {
        const float eg = __expf(gam_s[tok]);
#pragma unroll
        for (int j = 0; j < 4; ++j) {
            float qf8[8]; unpack8(*(const u32x4*)(Qn + tok * 136 + qt * 32 + j * 8), qf8);
#pragma unroll
            for (int q = 0; q < 8; ++q) qf8[q] *= eg;
            *(u32x4*)(BIG + (row0 + tok) * 4096 + hd * 128 + qt * 32 + j * 8) = pack8(qf8);
        }
    }
    LSYNC();
    {
        if (lane < 16) {
            const int o = 16 * wid; float t[16];
#pragma unroll
            for (int s = 0; s < 16; ++s) {
                float acc = (s == lane) ? 1.f : 0.f;
#pragma unroll
                for (int r = 0; r < s; ++r) acc -= AT[(o + s) * 65 + o + r] * t[r];
                t[s] = acc;
            }
#pragma unroll
            for (int s = 0; s < 16; ++s) AT[(o + s) * 65 + o + lane] = t[s];
        }
        LSYNC();
        {
            f32x4 bacc[2];
#pragma unroll
            for (int bb = 0; bb < 2; ++bb) {
                const int blk = wid + 4 * bb;
                bacc[bb] = (f32x4){0.f, 0.f, 0.f, 0.f};
                if (blk < 6) {
                    const int i = blk == 0 ? 1 : (blk < 3 ? 2 : 3), jb = blk == 0 ? 0 : (blk < 3 ? blk - 1 : blk - 3);
#pragma unroll
                    for (int kq = 0; kq < 4; ++kq)
                        bacc[bb] = __builtin_amdgcn_mfma_f32_16x16x4f32(AT[(16 * i + fr) * 65 + 16 * i + 4 * kq + fq], AT[(16 * i + 4 * kq + fq) * 65 + 16 * jb + fr], bacc[bb], 0, 0, 0);
                }
            }
            LSYNC();
#pragma unroll
            for (int bb = 0; bb < 2; ++bb) {
                const int blk = wid + 4 * bb;
                if (blk < 6) {
                    const int i = blk == 0 ? 1 : (blk < 3 ? 2 : 3), jb = blk == 0 ? 0 : (blk < 3 ? blk - 1 : blk - 3);
#pragma unroll
                    for (int jj = 0; jj < 4; ++jj) AT[(16 * i + 4 * fq + jj) * 65 + 16 * jb + fr] = bacc[bb][jj];
                }
            }
            LSYNC();
        }
#pragma unroll
        for (int i = 1; i < 4; ++i) {
            f32x4 tacc = (f32x4){0.f, 0.f, 0.f, 0.f};
            if (wid < i) {
                for (int m0 = 16 * wid; m0 < 16 * i; m0 += 4)
                    tacc = __builtin_amdgcn_mfma_f32_16x16x4f32(AT[(16 * i + fr) * 65 + m0 + fq], AT[(m0 + fq) * 65 + 16 * wid + fr], tacc, 0, 0, 0);
            }
            LSYNC();
            if (wid < i) {
#pragma unroll
                for (int jj = 0; jj < 4; ++jj) AT[(16 * i + 4 * fq + jj) * 65 + 16 * wid + fr] = -tacc[jj];
            }
            LSYNC();
        }
        const int s = tid >> 2, j0 = (tid & 3) * 16;
#pragma unroll
        for (int jj = 0; jj < 16; ++jj) {
            const int j = j0 + jj; const float t = AT[s * 65 + j], bj = beta_s[j];
            Tv[s * 72 + j] = f2bf(t * bj); Tw[s * 72 + j] = f2bf(t * bj * __expf(gam_s[j]));
        }
    }
    LSYNC();
    {
        const int s = 16 * wid + fr;
        const bf16x8 tw0 = ldfrag(Tw, 72, s, fq * 8), tw1 = ldfrag(Tw, 72, s, 32 + fq * 8), tv0 = ldfrag(Tv, 72, s, fq * 8), tv1 = ldfrag(Tv, 72, s, 32 + fq * 8);
#pragma unroll 2
        for (int nt = 0; nt < 8; ++nt) {
            f32x4 w4 = (f32x4){0.f, 0.f, 0.f, 0.f}, u4 = w4;
            w4 = mfma16(ldfrag_tr(Kn, 136, 0, 16 * nt, fr, fq), tw0, w4); w4 = mfma16(ldfrag_tr(Kn, 136, 32, 16 * nt, fr, fq), tw1, w4);
            u4 = mfma16(ldfrag_tr(Vn, 136, 0, 16 * nt, fr, fq), tv0, u4); u4 = mfma16(ldfrag_tr(Vn, 136, 32, 16 * nt, fr, fq), tv1, u4);
            if (s < L && live) {
                *(u32x2*)(Wb + (row0 + s) * 1024 + hd * 128 + 16 * nt + 4 * fq) = pack4(w4);
                *(u32x2*)(BIG + (row0 + s) * 4096 + 2048 + hd * 128 + 16 * nt + 4 * fq) = pack4(u4);
            }
        }
        const float gL = gam_s[L - 1];
#pragma unroll
        for (int ci = 0; ci < 2; ++ci)
#pragma unroll
            for (int kk = 0; kk < 2; ++kk) {
                const int cc = 2 * wid + ci, rb = 32 * kk + 8 * fq, d = 16 * cc + fr;
                const bf16x8 kf8 = ldfrag_tr(Kn, 136, 32 * kk, 16 * cc, fr, fq);
                if (rb < L && live) {
                    float kf[8]; unpack8(__builtin_bit_cast(u32x4, kf8), kf);
#pragma unroll
                    for (int q = 0; q < 8; ++q) kf[q] *= __expf(gL - gam_s[rb + q]);
                    const int e = d * L + rb;
                    *(u32x4*)(BIG + (row0 + (e >> 7)) * 4096 + 1024 + hd * 128 + (e & 127)) = pack8(kf);
                }
            }
        if ((smp || c == 63) && tid < 144 && live) {
            const int i = tid / 48, rem = tid % 48, col = (rem >> 4) * 1024 + hd * 128 + (rem & 15) * 8;
            float f[8]; unpack8(*(const u32x4*)(halo + ((size_t)unit * 3 + i) * 3072 + col), f);
            float* dst = smp ? p.out + OFF_SGC + ((size_t)s_ * 3 + i) * 3072 + col : p.out + OFF_PGC + ((size_t)(unit >> 6) * 3 + i) * 3072 + col;
            *(float4*)dst = make_float4(f[0], f[1], f[2], f[3]); *(float4*)(dst + 4) = make_float4(f[4], f[5], f[6], f[7]);
        }
    }
}

struct GdnFrags { bf16x8 w[4], q[4], p[2], kt[2][2]; u32x2 u0[2]; float eg; };
DI void gdn_chain(const Params& p, bf16_t* BIG, const bf16_t* Wb, const bf16_t* PB, const float* egl, int b, int hd, int es, bool smp, char* smem, bool live) {
    const int tid = get_tid(), wid = tid >> 6, lane = tid & 63, fr = lane & 15, fq = lane >> 4;
    bf16_t* UT0 = (bf16_t*)smem;
    bf16_t* ST0 = (bf16_t*)(smem + 9216);
    const int L = smp ? 16 : 64, nch = smp ? 1 : 64, sidx = b * 8 + hd;
    const size_t row0 = smp ? (size_t)NPR + b * 16 : (size_t)b * 4096;
    const bf16x8 z8 = (bf16x8){0, 0, 0, 0, 0, 0, 0, 0};
    f32x4 accS[2][2];
#pragma unroll
    for (int mt = 0; mt < 2; ++mt)
#pragma unroll
        for (int nt = 0; nt < 2; ++nt) accS[mt][nt] = (f32x4){0.f, 0.f, 0.f, 0.f};
    if (smp) {
        const float* S0 = p.in[7] + (size_t)sidx * 128 * 128;
#pragma unroll
        for (int mt = 0; mt < 2; ++mt)
#pragma unroll
            for (int nt = 0; nt < 2; ++nt)
#pragma unroll
                for (int j = 0; j < 4; ++j) accS[mt][nt][j] = S0[(size_t)(32 * wid + 16 * mt + 4 * fq + j) * 128 + es * 32 + nt * 16 + fr];
    }
    LSYNC();
#pragma unroll
    for (int mt = 0; mt < 2; ++mt)
#pragma unroll
        for (int nt = 0; nt < 2; ++nt) *(u32x2*)(ST0 + (nt * 16 + fr) * 136 + 32 * wid + 16 * mt + 4 * fq) = pack4(accS[mt][nt]);
    const int s = 16 * wid + fr, sc_ = s < L ? s : L - 1;
    const bool valid = s < L;
    auto load = [&](int c, GdnFrags& F) __attribute__((always_inline)) {
        const size_t r0 = row0 + (size_t)c * 64;
        const bf16_t* wp = Wb + (r0 + sc_) * 1024 + hd * 128 + fq * 8;
        const bf16_t* qp = BIG + (r0 + sc_) * 4096 + hd * 128 + fq * 8;
        const bf16_t* pp = PB + (r0 + sc_) * 512 + hd * 64 + fq * 8;
#pragma unroll
        for (int kk = 0; kk < 4; ++kk) { F.w[kk] = *(const bf16x8*)(wp + kk * 32); F.q[kk] = *(const bf16x8*)(qp + kk * 32); if (!valid) { F.w[kk] = z8; F.q[kk] = z8; } }
#pragma unroll
        for (int kk = 0; kk < 2; ++kk) { F.p[kk] = *(const bf16x8*)(pp + kk * 32); if (!valid) F.p[kk] = z8; }
#pragma unroll
        for (int mt = 0; mt < 2; ++mt)
#pragma unroll
            for (int kk = 0; kk < 2; ++kk) {
                const int d = 32 * wid + 16 * mt + fr, r = kk * 32 + fq * 8, rc = r < L ? r : 0, e = d * L + rc;
                F.kt[mt][kk] = *(const bf16x8*)(BIG + (r0 + (e >> 7)) * 4096 + 1024 + hd * 128 + (e & 127));
                if (r >= L) F.kt[mt][kk] = z8;
            }
#pragma unroll
        for (int nt = 0; nt < 2; ++nt) {
            F.u0[nt] = *(const u32x2*)(BIG + (r0 + sc_) * 4096 + 2048 + hd * 128 + es * 32 + nt * 16 + 4 * fq);
            if (!valid) F.u0[nt] = (u32x2){0u, 0u};
        }
        F.eg = egl[(smp ? 256 + b : b * 64 + c) * 8 + hd];
    };
    auto step = [&](int c, const GdnFrags& cur) __attribute__((always_inline)) {
        const bf16_t* STc = ST0 + (c & 1) * (32 * 136); bf16_t* STn = ST0 + ((c + 1) & 1) * (32 * 136);
        bf16_t* UTc = UT0 + (c & 1) * (32 * 72);
        bf16x8 sf[2][4];
#pragma unroll
        for (int nt = 0; nt < 2; ++nt)
#pragma unroll
            for (int kk = 0; kk < 4; ++kk) sf[nt][kk] = ldfrag(STc, 136, nt * 16 + fr, kk * 32 + fq * 8);
#pragma unroll
        for (int nt = 0; nt < 2; ++nt) {
            f32x4 w4 = (f32x4){0.f, 0.f, 0.f, 0.f};
#pragma unroll
            for (int kk = 0; kk < 4; ++kk) w4 = mfma16(sf[nt][kk], cur.w[kk], w4);
            const float uf[4] = {lo2f(cur.u0[nt].x) - w4[0], hi2f(cur.u0[nt].x) - w4[1], lo2f(cur.u0[nt].y) - w4[2], hi2f(cur.u0[nt].y) - w4[3]};
#pragma unroll
            for (int j = 0; j < 4; ++j) UTc[(nt * 16 + 4 * fq + j) * 72 + s] = f2bf(uf[j]);
        }
        LSYNC();
        {
            bf16x8 uf8[2][2];
#pragma unroll
            for (int nt = 0; nt < 2; ++nt) {
                f32x4 o4 = (f32x4){0.f, 0.f, 0.f, 0.f};
#pragma unroll
                for (int kk = 0; kk < 4; ++kk) o4 = mfma16(sf[nt][kk], cur.q[kk], o4);
#pragma unroll
                for (int kk = 0; kk < 2; ++kk) { uf8[nt][kk] = ldfrag(UTc, 72, nt * 16 + fr, kk * 32 + fq * 8); o4 = mfma16(uf8[nt][kk], cur.p[kk], o4); }
                if (valid && live) *(u32x2*)(BIG + (row0 + (size_t)c * 64 + s) * 4096 + 2048 + hd * 128 + es * 32 + nt * 16 + 4 * fq) = pack4(o4);
            }
#pragma unroll
            for (int mt = 0; mt < 2; ++mt)
#pragma unroll
                for (int nt = 0; nt < 2; ++nt) {
                    accS[mt][nt] *= cur.eg;
#pragma unroll
                    for (int kk = 0; kk < 2; ++kk) accS[mt][nt] = mfma16(cur.kt[mt][kk], uf8[nt][kk], accS[mt][nt]);
                    *(u32x2*)(STn + (nt * 16 + fr) * 136 + 32 * wid + 16 * mt + 4 * fq) = pack4(accS[mt][nt]);
                }
        }
        LSYNC();
    };
    GdnFrags fa, fb; load(0, fa); fb = fa;
    if (nch > 1) load(1, fb);
    LSYNC();
    for (int c = 0; c < nch; c += 2) {
        step(c, fa);
        if (c + 2 < nch) load(c + 2, fa);
        if (c + 1 < nch) { step(c + 1, fb); if (c + 3 < nch) load(c + 3, fb); }
    }
    if (!live) return;
    float* So = p.out + (smp ? OFF_SG : OFF_PG) + (size_t)sidx * 128 * 128;
#pragma unroll
    for (int mt = 0; mt < 2; ++mt)
#pragma unroll
        for (int nt = 0; nt < 2; ++nt)
#pragma unroll
            for (int j = 0; j < 4; ++j) So[(size_t)(32 * wid + 16 * mt + 4 * fq + j) * 128 + es * 32 + nt * 16 + fr] = accS[mt][nt][j];
}

DI void phase_post_l1(const Params& p, bf16_t* BIG) {
    const int tid_ = get_tid(), lane = tid_ & 63, gw = VB * 4 + (tid_ >> 6), nw = NVB * 4;
    const int hd = lane >> 3, e0 = (lane & 7) * 16;
    for (int row = gw; row < NTOK; row += nw) {
        bf16_t* op = BIG + (size_t)row * 4096 + 2048 + hd * 128 + e0;
        const bf16_t* zp = BIG + (size_t)row * 4096 + 3072 + hd * 128 + e0;
        float x[16], z[16];
        unpack8(*(const u32x4*)op, x); unpack8(*(const u32x4*)(op + 8), x + 8);
        unpack8(*(const u32x4*)zp, z); unpack8(*(const u32x4*)(zp + 8), z + 8);
        float ss = 0.f;
#pragma unroll
        for (int j = 0; j < 16; ++j) ss += x[j] * x[j];
        ss += __shfl_xor(ss, 1); ss += __shfl_xor(ss, 2); ss += __shfl_xor(ss, 4);
        const float r = rsqrtf(ss * (1.f / 128.f) + 1e-6f);
        float y[16];
#pragma unroll
        for (int j = 0; j < 16; ++j) y[j] = x[j] * r * p.in[30][e0 + j] * siluf(z[j]);
        *(u32x4*)op = pack8(y); *(u32x4*)(op + 8) = pack8(y + 8);
    }
}

__global__ void __launch_bounds__(512, 2) fwd_megakernel(Params p) {
    __shared__ __attribute__((aligned(16))) char smem_all[LDS_BYTES];
    char* smem = smem_all + get_sub() * LDS_SUB;
    cg::grid_group grid = cg::this_grid();
    char* ws = p.ws;
    if (ws == nullptr) grid.sync();
    if (threadIdx.x < 4) ((volatile LAS unsigned*)(smem_all + LDS_BYTES - 16))[threadIdx.x] = 0u;
    __syncthreads();
    const XcdBarrier xb = xcd_barrier_post((unsigned*)(ws + WS_BAR), (volatile LAS unsigned*)(smem_all + LDS_BYTES - 16));
    bf16_t* WGU = (bf16_t*)(ws + WS_WGU); bf16_t* WD = (bf16_t*)(ws + WS_WD); bf16_t* WIN = (bf16_t*)(ws + WS_WIN); bf16_t* WOUT = (bf16_t*)(ws + WS_WOUT);
    bf16_t* H = (bf16_t*)(ws + WS_H); bf16_t* BIG = (bf16_t*)(ws + WS_BIG); float* GATES = (float*)(ws + WS_GATES); bf16_t* HALO = (bf16_t*)(ws + WS_HALO); float* EGL = (float*)(ws + WS_EGL);
    bf16_t* PB = BIG + (size_t)NTOK * 4096;
    float* X = p.out; float* XS = p.out + (size_t)NPR * 1024;
    const float* ng = p.in[9];
    const size_t FW = (size_t)1024 * 2816;
    Epi e{};
    phase_norm(p.in[0], p.in[1], ng, H);
    for (int i = VB * 256 + get_tid(); i < 128 * 1024 / 4; i += NVB * 256) ((float4*)XS)[i] = ((const float4*)p.in[1])[i];
    cvt_job(p.in[11], 1024, 2816, WGU, 1, 0, smem);
    cvt_job(p.in[12], 1024, 2816, WGU, 2, 100, smem);
    cvt_job(p.in[13], 2816, 1024, WD, 0, 200, smem);
    cvt_job(p.in[14], 1024, 5656, WIN, 3, 300, smem);
    cvt_job(p.in[15], 2048, 1024, WOUT, 0, 400, smem);
    xcd_barrier(xb);
    e.o16 = BIG; e.ldc = 2816;
    { PEpiGU pe; pe.O = BIG; gemm_big(H, 1024, WGU, 1024, 5632, pe, smem_all); }
    gemm_tail<EPI_GU>(H, 1024, WGU, 1024, 44, e, smem);
    xcd_barrier(xb);
    e.o32 = X; e.rp = p.in[0]; e.rs = p.in[1]; e.scale = 0.5f;
    { PEpiRES pe; pe.X = X; pe.R = e.rp; pe.scale = e.scale; gemm_big(BIG, 2816, WD, 2816, 1024, pe, smem_all); }
    gemm_tail<EPI_RES>(BIG, 2816, WD, 2816, 8, e, smem);
    xcd_barrier(xb);
    phase_norm(X, XS, ng + 1024, H);
    cvt_job(p.in[11] + FW, 1024, 2816, WGU, 1, 0, smem);
    cvt_job(p.in[12] + FW, 1024, 2816, WGU, 2, 100, smem);
    cvt_job(p.in[13] + FW, 2816, 1024, WD, 0, 200, smem);
    xcd_barrier(xb);
    e.o16 = BIG; e.ldc = 5632; e.gates = GATES; e.halo = HALO; e.cv0 = 4096; e.cv1 = 5632;
    { PEpiPROJ pe; pe.O = BIG; pe.ldc = 5632; pe.halo = HALO; pe.cv0 = 4096; pe.cv1 = 5632; gemm_big(H, 1024, WIN, 1024, 5632, pe, smem_all); }
    gemm_tail<EPI_PROJ>(H, 1024, WIN, 1024, 45, e, smem);
    xcd_barrier(xb);
#if PHM & 1
    phase_conv_ssd(p, BIG, HALO);
#endif
    xcd_barrier(xb);
#if PHM & 2
#ifdef PROBE_L0
    phase_scan_l0(p, BIG, GATES, smem, p.ws == nullptr);
    xcd_barrier(xb);
#endif
    phase_scan_l0(p, BIG, GATES, smem, true);
#endif
    xcd_barrier(xb);
    phase_post_l0(p, BIG);
    xcd_barrier(xb);
    e.o32 = X; e.rp = X; e.rs = XS; e.scale = 1.0f;
    { PEpiRES pe; pe.X = X; pe.R = e.rp; pe.scale = e.scale; gemm_big(BIG + 1024, 5632, WOUT, 2048, 1024, pe, smem_all); }
    gemm_tail<EPI_RES>(BIG + 1024, 5632, WOUT, 2048, 8, e, smem);
    xcd_barrier(xb);
    phase_norm(X, XS, ng + 2048, H);
    xcd_barrier(xb);
    e.o16 = BIG; e.ldc = 2816;
    { PEpiGU pe; pe.O = BIG; gemm_big(H, 1024, WGU, 1024, 5632, pe, smem_all); }
    gemm_tail<EPI_GU>(H, 1024, WGU, 1024, 44, e, smem);
    xcd_barrier(xb);
    e.scale = 0.5f;
    { PEpiRES pe; pe.X = X; pe.R = e.rp; pe.scale = e.scale; gemm_big(BIG, 2816, WD, 2816, 1024, pe, smem_all); }
    gemm_tail<EPI_RES>(BIG, 2816, WD, 2816, 8, e, smem);
    xcd_barrier(xb);
    phase_norm(X, XS, ng + 3072, H);
    cvt_job(p.in[11] + 2 * FW, 1024, 2816, WGU, 1, 0, smem);
    cvt_job(p.in[12] + 2 * FW, 1024, 2816, WGU, 2, 100, smem);
    cvt_job(p.in[13] + 2 * FW, 2816, 1024, WD, 0, 200, smem);
    cvt_job(p.in[25], 1024, 4112, WIN, 0, 300, smem);
    cvt_job(p.in[26], 1024, 1024, WOUT, 0, 400, smem);
    xcd_barrier(xb);
    { PEpiGU pe; pe.O = BIG; gemm_big(H, 1024, WGU, 1024, 5632, pe, smem_all); }
    gemm_tail<EPI_GU>(H, 1024, WGU, 1024, 44, e, smem);
    xcd_barrier(xb);
    { PEpiRES pe; pe.X = X; pe.R = e.rp; pe.scale = e.scale; gemm_big(BIG, 2816, WD, 2816, 1024, pe, smem_all); }
    gemm_tail<EPI_RES>(BIG, 2816, WD, 2816, 8, e, smem);
    xcd_barrier(xb);
    phase_norm(X, XS, ng + 4096, H);
    fill_cache_halo(p.in[8], 3072, HALO);
    cvt_job(p.in[11] + 3 * FW, 1024, 2816, WGU, 1, 0, smem);
    cvt_job(p.in[12] + 3 * FW, 1024, 2816, WGU, 2, 100, smem);
    cvt_job(p.in[13] + 3 * FW, 2816, 1024, WD, 0, 200, smem);
    xcd_barrier(xb);
    e.o16 = BIG; e.ldc = 4096; e.cv0 = 0; e.cv1 = 3072;
    { PEpiPROJ pe; pe.O = BIG; pe.ldc = 4096; pe.halo = HALO; pe.cv0 = 0; pe.cv1 = 3072; gemm_big(H, 1024, WIN, 1024, 4096, pe, smem_all); }
    gemm_tail<EPI_PROJ>(H, 1024, WIN, 1024, 33, e, smem);
    xcd_barrier(xb);
#if PHM & 4
#ifdef PROBE_G1
    for (int it = VB; it < 264 * 8; it += NVB) gdn_g1_item(p, BIG, H, PB, GATES, HALO, EGL, it >> 3, it & 7, smem, p.ws == nullptr);
    xcd_barrier(xb);
#endif
    for (int it = VB; it < (gridDim.x == 256 ? 256 : 264) * 8; it += NVB) gdn_g1_item(p, BIG, H, PB, GATES, HALO, EGL, it >> 3, it & 7, smem, true);
#endif
    xcd_barrier(xb);
#if PHM & 8
#ifdef PROBE_GDN
    { const bool glive = (p.ws == nullptr);
    if (gridDim.x != 256) {
        for (int it = VB; it < 384; it += NVB) {
            const bool smp = it >= 128; const int j = smp ? it - 128 : it;
            gdn_chain(p, BIG, H, PB, EGL, j >> 5, (j >> 2) & 7, j & 3, smp, smem, glive);
        }
    } else {
        const int x = (int)blockIdx.x & 7, y = (int)blockIdx.x >> 3, sub = get_sub();
        if (y < 16) {
            if (sub == 0) gdn_chain(p, BIG, H, PB, EGL, y >> 2, x, y & 3, false, smem, glive);
            else for (int i = 0; i < 130; ++i) { asm volatile("" ::: "memory"); __builtin_amdgcn_s_barrier(); }
        }
        else if (y < 20) {
            const int v = (y - 16) * 16 + x * 2 + sub, sidx = v >> 3, shd = v & 7;
            gdn_g1_item(p, BIG, H, PB, GATES, HALO, EGL, 256 + sidx, shd, smem, glive);
            asm volatile("s_waitcnt vmcnt(0)" ::: "memory");
            __builtin_amdgcn_fence(__ATOMIC_RELEASE, "agent");
            __builtin_amdgcn_fence(__ATOMIC_ACQUIRE, "agent");
            asm volatile("s_waitcnt vmcnt(0)" ::: "memory");
            __builtin_amdgcn_s_barrier();
            for (int e4 = 0; e4 < 4; ++e4) gdn_chain(p, BIG, H, PB, EGL, sidx, shd, e4, true, smem, glive);
        }
    }
    }
    xcd_barrier(xb);
#endif
    { const bool glive = true;
    if (gridDim.x != 256) {
        for (int it = VB; it < 384; it += NVB) {
            const bool smp = it >= 128; const int j = smp ? it - 128 : it;
            gdn_chain(p, BIG, H, PB, EGL, j >> 5, (j >> 2) & 7, j & 3, smp, smem, glive);
        }
    } else {
        const int x = (int)blockIdx.x & 7, y = (int)blockIdx.x >> 3, sub = get_sub();
        if (y < 16) {
            if (sub == 0) gdn_chain(p, BIG, H, PB, EGL, y >> 2, x, y & 3, false, smem, glive);
            else for (int i = 0; i < 130; ++i) { asm volatile("" ::: "memory"); __builtin_amdgcn_s_barrier(); }
        }
        else if (y < 20) {
            const int v = (y - 16) * 16 + x * 2 + sub, sidx = v >> 3, shd = v & 7;
            gdn_g1_item(p, BIG, H, PB, GATES, HALO, EGL, 256 + sidx, shd, smem, glive);
            asm volatile("s_waitcnt vmcnt(0)" ::: "memory");
            __builtin_amdgcn_fence(__ATOMIC_RELEASE, "agent");
            __builtin_amdgcn_fence(__ATOMIC_ACQUIRE, "agent");
            asm volatile("s_waitcnt vmcnt(0)" ::: "memory");
            __builtin_amdgcn_s_barrier();
            for (int e4 = 0; e4 < 4; ++e4) gdn_chain(p, BIG, H, PB, EGL, sidx, shd, e4, true, smem, glive);
        }
    }
    }
#endif
    xcd_barrier(xb);
    phase_post_l1(p, BIG);
    xcd_barrier(xb);
    e.scale = 1.0f;
    { PEpiRES pe; pe.X = X; pe.R = e.rp; pe.scale = e.scale; gemm_big(BIG + 2048, 4096, WOUT, 1024, 1024, pe, smem_all); }
    gemm_tail<EPI_RES>(BIG + 2048, 4096, WOUT, 1024, 8, e, smem);
    xcd_barrier(xb);
    phase_norm(X, XS, ng + 5120, H);
    xcd_barrier(xb);
    e.o16 = BIG; e.ldc = 2816;
    { PEpiGU pe; pe.O = BIG; gemm_big(H, 1024, WGU, 1024, 5632, pe, smem_all); }
    gemm_tail<EPI_GU>(H, 1024, WGU, 1024, 44, e, smem);
    xcd_barrier(xb);
    e.scale = 0.5f;
    { PEpiRES pe; pe.X = X; pe.R = e.rp; pe.scale = e.scale; gemm_big(BIG, 2816, WD, 2816, 1024, pe, smem_all); }
    gemm_tail<EPI_RES>(BIG, 2816, WD, 2816, 8, e, smem);
    xcd_barrier(xb);
    phase_final_norm(X, p.in[10]);
}

extern "C" void kernel_launch(void* const* d_in, const int* in_sizes, int n_in, void* d_out, int out_size, void* d_ws, size_t ws_size, hipStream_t stream) {
    static int grid_blocks = 0;
    if (!grid_blocks) {
        int dev = 0, cus = 0, per_cu = 0;
        hipGetDevice(&dev);
        hipDeviceGetAttribute(&cus, hipDeviceAttributeMultiprocessorCount, dev);
        hipOccupancyMaxActiveBlocksPerMultiprocessor(&per_cu, fwd_megakernel, 512, 0);
        if (per_cu > 1) per_cu = 1;
        if (per_cu < 1) per_cu = 1;
        grid_blocks = cus * per_cu;
    }
    Params p{};
    for (int i = 0; i < 31; ++i) p.in[i] = (const float*)d_in[i];
    p.out = (float*)d_out;
    p.ws = (char*)d_ws;
    (void)hipMemsetAsync((char*)d_ws + WS_BAR, 0, 16384, stream);
    void* args[] = {&p};
    hipError_t err = hipLaunchCooperativeKernel((void*)fwd_megakernel, dim3(grid_blocks), dim3(512), args, 0, stream);
    if (err != hipSuccess) fprintf(stderr, "cooperative launch failed: %s (grid %d)\n", hipGetErrorString(err), grid_blocks);
}
```

```cpp
#include <hip/hip_runtime.h>
#include <hip/hip_cooperative_groups.h>
#include <cstdio>
namespace cg = cooperative_groups;

typedef unsigned short bf16_t;
typedef short bf16x8 __attribute__((ext_vector_type(8)));
typedef float f32x4 __attribute__((ext_vector_type(4)));
typedef unsigned u32x2 __attribute__((ext_vector_type(2)));
typedef unsigned u32x4 __attribute__((ext_vector_type(4)));

#define DI __device__ __forceinline__
#define NTOK 16512
#define NPR 16384
#define LDS_SUB 75776
#define LDS_BYTES (2 * LDS_SUB + 16)
#ifndef PHM
#define PHM 15
#endif

#define WS_WGU   0ull
#define WS_WD    (WS_WGU + 5632ull * 1024 * 2)
#define WS_WIN   (WS_WD + 1024ull * 2816 * 2)
#define WS_WOUT  (WS_WIN + 5760ull * 1024 * 2)
#define WS_H     (WS_WOUT + 1024ull * 2048 * 2)
#define WS_BIG   (WS_H + 16512ull * 1024 * 2)
#define WS_GATES (WS_BIG + 16512ull * 5632 * 2)
#define WS_HALO  (WS_GATES + 16512ull * 32 * 4)
#define WS_EGL   (WS_HALO + 272ull * 3 * 3072 * 2)
#define WS_BAR   (WS_EGL + 272ull * 8 * 4)
#define WS_END   (WS_BAR + 16384ull)

struct Params {
    const float* in[31];
    float* out;
    char* ws;
};

DI int get_tid() { int t = threadIdx.x & 255; asm volatile("" : "+v"(t)); return t; }
DI int get_sub() { return __builtin_amdgcn_readfirstlane((int)(threadIdx.x >> 8)); }
#define VB ((int)blockIdx.x * 2 + get_sub())
#define NVB ((int)gridDim.x * 2)
typedef __bf16 hwbf16x2 __attribute__((ext_vector_type(2)));
typedef float hwf32x2 __attribute__((ext_vector_type(2)));
DI unsigned pack2(float lo, float hi) { hwf32x2 v = {lo, hi}; hwbf16x2 b = __builtin_convertvector(v, hwbf16x2); return __builtin_bit_cast(unsigned, b); }
DI bf16_t f2bf(float f) { return (bf16_t)(pack2(f, f) & 0xffffu); }
DI float bf2f(bf16_t h) { return __uint_as_float(((unsigned)h) << 16); }
DI float lo2f(unsigned u) { return __uint_as_float(u << 16); }
DI float hi2f(unsigned u) { return __uint_as_float(u & 0xffff0000u); }
DI float siluf(float x) { return x * __builtin_amdgcn_rcpf(1.f + __expf(-x)); }
DI float sigmf(float x) { return __builtin_amdgcn_rcpf(1.f + __expf(-x)); }
DI float softplusf(float x) { return fmaxf(x, 0.f) + log1pf(__expf(-fabsf(x))); }
DI f32x4 mfma16(bf16x8 a, bf16x8 b, f32x4 c) { return __builtin_amdgcn_mfma_f32_16x16x32_bf16(a, b, c, 0, 0, 0); }
DI bf16x8 ldfrag(const bf16_t* base, int ld, int row, int k) { return *(const bf16x8*)(base + row * ld + k); }
typedef short s16x4 __attribute__((ext_vector_type(4)));
DI bf16x8 ldfrag_tr(const bf16_t* T, int ld, int k0, int c0, int fr, int fq) {
    const bf16_t* p0 = T + (k0 + 8 * fq + (fr >> 2)) * ld + c0 + 4 * (fr & 3);
    const s16x4 a = __builtin_amdgcn_ds_read_tr16_b64_v4i16((__attribute__((address_space(3))) s16x4*)p0);
    const s16x4 b = __builtin_amdgcn_ds_read_tr16_b64_v4i16((__attribute__((address_space(3))) s16x4*)(p0 + 4 * ld));
    return (bf16x8){a[0], a[1], a[2], a[3], b[0], b[1], b[2], b[3]};
}
DI void unpack8(u32x4 v, float* f) {
    f[0] = lo2f(v.x); f[1] = hi2f(v.x); f[2] = lo2f(v.y); f[3] = hi2f(v.y);
    f[4] = lo2f(v.z); f[5] = hi2f(v.z); f[6] = lo2f(v.w); f[7] = hi2f(v.w);
}
DI u32x4 pack8(const float* f) { u32x4 o; o.x = pack2(f[0], f[1]); o.y = pack2(f[2], f[3]); o.z = pack2(f[4], f[5]); o.w = pack2(f[6], f[7]); return o; }
DI u32x2 pack4(f32x4 v) { u32x2 o; o.x = pack2(v[0], v[1]); o.y = pack2(v[2], v[3]); return o; }
DI float wave_sum(float v) {
#pragma unroll
    for (int o = 32; o >= 1; o >>= 1) v += __shfl_xor(v, o);
    return v;
}


#define XB_TMO      128
#define XB_XCNT(j)  (256  + 64 * (j))
#define XB_XSUB(j)  (1280 + 64 * (j))
#define XB_XGEN(j)  (2304 + 64 * (j))
#define XB_TOP      3328
#define XB_TOPGEN   3392
#define XCD_BAR_WORDS 3456
#define XB_SPIN_CAP (1u << 18)
#define LAS __attribute__((address_space(3)))
DI unsigned xb_ld(unsigned* p)              { return __hip_atomic_load(p, __ATOMIC_RELAXED, __HIP_MEMORY_SCOPE_AGENT); }
DI unsigned xb_add(unsigned* p, unsigned v) { return __hip_atomic_fetch_add(p, v, __ATOMIC_RELAXED, __HIP_MEMORY_SCOPE_AGENT); }
DI unsigned xb_xcc_id() { return (unsigned)__builtin_amdgcn_s_getreg((3 << 11) | 20) & 0xFu; }
#define XB_SPIN(cond, bar) do { unsigned _sp = 0; while (cond) { __builtin_amdgcn_s_sleep(1); \
    if ((++_sp & 255u) == 0u) { if (xb_ld(&(bar)[XB_TMO])) break; if (_sp > XB_SPIN_CAP) { atomicAdd(&(bar)[XB_TMO], 1u); break; } } } } while (0)
struct XcdBarrier { unsigned* bar; unsigned x; volatile LAS unsigned* st; };
DI XcdBarrier xcd_barrier_post(unsigned* bar, volatile LAS unsigned* st) {
    XcdBarrier b; b.bar = bar; b.x = xb_xcc_id(); b.st = st;
    if (threadIdx.x == 0) (void)xb_add(&bar[XB_XCNT(b.x)], 1u);
    return b;
}
DI void xcd_barrier_complete(unsigned* bar, unsigned x, unsigned& nloc, unsigned& nx) {
    const unsigned G = gridDim.x * gridDim.y * gridDim.z;
    unsigned sum, cnt, mine, sp = 0u;
    for (;;) {
        sum = 0u; cnt = 0u; mine = 0u;
#pragma unroll
        for (unsigned j = 0; j < 16; ++j) { const unsigned c = xb_ld(&bar[XB_XCNT(j)]); sum += c; cnt += (c > 0u) ? 1u : 0u; mine = (j == x) ? c : mine; }
        if (sum == G) break;
        __builtin_amdgcn_s_sleep(1);
        if ((++sp & 255u) == 0u) { if (xb_ld(&bar[XB_TMO])) break; if (sp > XB_SPIN_CAP) { atomicAdd(&bar[XB_TMO], 1u); break; } }
    }
    nloc = mine > 0u ? mine : 1u; nx = cnt > 0u ? cnt : 1u;
}
DI void xcd_barrier(const XcdBarrier& b) {
    asm volatile("s_waitcnt vmcnt(0)" ::: "memory");
    __syncthreads();
    if (threadIdx.x == 0) {
        unsigned* bar = b.bar;
        __builtin_amdgcn_s_waitcnt(0);
        unsigned nloc = b.st[0], nx = b.st[1];
        if (nloc == 0u) { xcd_barrier_complete(bar, b.x, nloc, nx); b.st[0] = nloc; b.st[1] = nx; }
        const unsigned old = xb_add(&bar[XB_XSUB(b.x)], 1u);
        const unsigned gen = old / nloc;
        if (old + 1u == (gen + 1u) * nloc) {
            __builtin_amdgcn_fence(__ATOMIC_RELEASE, "agent");
            asm volatile("s_waitcnt vmcnt(0)" ::: "memory");
            const unsigned og = xb_add(&bar[XB_TOP], 1u);
            const unsigned tg = og / nx;
            if (og + 1u == (tg + 1u) * nx) xb_add(&bar[XB_TOPGEN], 1u);
            else XB_SPIN(xb_ld(&bar[XB_TOPGEN]) == tg, bar);
            __builtin_amdgcn_fence(__ATOMIC_ACQUIRE, "agent");
            xb_add(&bar[XB_XGEN(b.x)], 1u);
            asm volatile("s_waitcnt vmcnt(0)" ::: "memory");
        } else {
            XB_SPIN(xb_ld(&bar[XB_XGEN(b.x)]) == gen, bar);
            __builtin_amdgcn_fence(__ATOMIC_ACQUIRE, "agent");
            asm volatile("s_waitcnt vmcnt(0)" ::: "memory");
        }
    }
    __syncthreads();
}

DI void phase_norm(const float* xp, const float* xs, const float* g, bf16_t* h) {
    const int tid_ = get_tid(), lane = tid_ & 63, gw = VB * 4 + (tid_ >> 6), nw = NVB * 4;
    float4 gg[4];
#pragma unroll
    for (int i = 0; i < 4; ++i) gg[i] = *(const float4*)(g + i * 256 + lane * 4);
    for (int row = gw; row < NTOK; row += 2 * nw) {
        const int rowb = row + nw < NTOK ? row + nw : row;
        const float* sa = row < NPR ? xp + (size_t)row * 1024 : xs + (size_t)(row - NPR) * 1024;
        const float* sb = rowb < NPR ? xp + (size_t)rowb * 1024 : xs + (size_t)(rowb - NPR) * 1024;
        float4 va[4], vb[4]; float ssa = 0.f, ssb = 0.f;
#pragma unroll
        for (int i = 0; i < 4; ++i) { va[i] = *(const float4*)(sa + i * 256 + lane * 4); vb[i] = *(const float4*)(sb + i * 256 + lane * 4); }
#pragma unroll
        for (int i = 0; i < 4; ++i) {
            ssa += va[i].x * va[i].x + va[i].y * va[i].y + va[i].z * va[i].z + va[i].w * va[i].w;
            ssb += vb[i].x * vb[i].x + vb[i].y * vb[i].y + vb[i].z * vb[i].z + vb[i].w * vb[i].w;
        }
        ssa = wave_sum(ssa); ssb = wave_sum(ssb);
        const float ra = rsqrtf(ssa * (1.f / 1024.f) + 1e-6f), rb = rsqrtf(ssb * (1.f / 1024.f) + 1e-6f);
#pragma unroll
        for (int i = 0; i < 4; ++i) {
            u32x2 o; o.x = pack2(va[i].x * ra * gg[i].x, va[i].y * ra * gg[i].y); o.y = pack2(va[i].z * ra * gg[i].z, va[i].w * ra * gg[i].w);
            *(u32x2*)(h + (size_t)row * 1024 + i * 256 + lane * 4) = o;
            u32x2 q; q.x = pack2(vb[i].x * rb * gg[i].x, vb[i].y * rb * gg[i].y); q.y = pack2(vb[i].z * rb * gg[i].z, vb[i].w * rb * gg[i].w);
            *(u32x2*)(h + (size_t)rowb * 1024 + i * 256 + lane * 4) = q;
        }
    }
}
DI void phase_final_norm(float* x, const float* g) {
    const int tid_ = get_tid(), lane = tid_ & 63, gw = VB * 4 + (tid_ >> 6), nw = NVB * 4;
    float4 gg[4];
#pragma unroll
    for (int i = 0; i < 4; ++i) gg[i] = *(const float4*)(g + i * 256 + lane * 4);
    for (int row = gw; row < NTOK; row += 2 * nw) {
        const bool two = row + nw < NTOK;
        float* sa = x + (size_t)row * 1024; float* sb = x + (size_t)(two ? row + nw : row) * 1024;
        float4 va[4], vb[4]; float ssa = 0.f, ssb = 0.f;
#pragma unroll
        for (int i = 0; i < 4; ++i) { va[i] = *(const float4*)(sa + i * 256 + lane * 4); vb[i] = *(const float4*)(sb + i * 256 + lane * 4); }
#pragma unroll
        for (int i = 0; i < 4; ++i) {
            ssa += va[i].x * va[i].x + va[i].y * va[i].y + va[i].z * va[i].z + va[i].w * va[i].w;
            ssb += vb[i].x * vb[i].x + vb[i].y * vb[i].y + vb[i].z * vb[i].z + vb[i].w * vb[i].w;
        }
        ssa = wave_sum(ssa); ssb = wave_sum(ssb);
        const float ra = rsqrtf(ssa * (1.f / 1024.f) + 1e-6f), rb = rsqrtf(ssb * (1.f / 1024.f) + 1e-6f);
#pragma unroll
        for (int i = 0; i < 4; ++i) {
            float4 o; o.x = va[i].x * ra * gg[i].x; o.y = va[i].y * ra * gg[i].y; o.z = va[i].z * ra * gg[i].z; o.w = va[i].w * ra * gg[i].w;
            __builtin_nontemporal_store((f32x4){o.x, o.y, o.z, o.w}, (f32x4*)(sa + i * 256 + lane * 4));
            if (two) { float4 q; q.x = vb[i].x * rb * gg[i].x; q.y = vb[i].y * rb * gg[i].y; q.z = vb[i].z * rb * gg[i].z; q.w = vb[i].w * rb * gg[i].w; __builtin_nontemporal_store((f32x4){q.x, q.y, q.z, q.w}, (f32x4*)(sb + i * 256 + lane * 4)); }
        }
    }
}

DI int map_row(int mode, int n) {
    if (mode == 0) return n;
    if (mode == 1 || mode == 2) {
        const int oc = n & 127;
        return ((n >> 7) << 8) + (((oc >> 2) & 1) << 7) + ((oc >> 5) << 5) + ((mode - 1) << 4) + (((oc >> 3) & 3) << 2) + (oc & 3);
    }
    if (n < 2048) return n;
    if (n < 3072) return n + 1024;
    if (n < 3080) return n - 3072 + 5632;
    if (n < 4104) return n - 3080 + 2048;
    if (n < 5640) return n - 4104 + 4096;
    return n;
}
DI void cvt_job(const float* src, int K, int N, bf16_t* dst, int mode, int rot, char* smem) {
    float* tile = (float*)smem;
    const int tid = get_tid(), nkt = K >> 6, nnt = (N + 63) >> 6, ntiles = nkt * nnt;
    const int kl0 = tid >> 4, nl4 = (tid & 15) * 4;
    float4 v[4];
    auto issue = [&](int t) __attribute__((always_inline)) {
        const int kt = t % nkt, nt = t / nkt, n = nt * 64 + nl4, nc = n < N ? n : 0;
#pragma unroll
        for (int i = 0; i < 4; ++i) {
            v[i] = *(const float4*)(src + (size_t)(kt * 64 + kl0 + 16 * i) * N + nc);
            if (n >= N) v[i] = make_float4(0.f, 0.f, 0.f, 0.f);
        }
    };
    int t = (int)((VB + rot) % NVB);
    if (t < ntiles) issue(t);
    while (t < ntiles) {
        const int kt = t % nkt, nt = t / nkt;
        __syncthreads();
#pragma unroll
        for (int i = 0; i < 4; ++i) {
            const int kl = kl0 + 16 * i;
            tile[kl * 65 + nl4] = v[i].x; tile[kl * 65 + nl4 + 1] = v[i].y; tile[kl * 65 + nl4 + 2] = v[i].z; tile[kl * 65 + nl4 + 3] = v[i].w;
        }
        const int tn = t + NVB;
        if (tn < ntiles) issue(tn);
        __syncthreads();
        const int nl = tid >> 2, kq = (tid & 3) * 16, n = nt * 64 + nl;
        if (n < N) {
            const float sc = (mode == 3 && n >= 512 && n < 1024) ? 0.08838834764831845f : 1.f;
            float tv[16];
#pragma unroll
            for (int q = 0; q < 16; ++q) tv[q] = tile[(kq + q) * 65 + nl] * sc;
            const u32x4 o0 = pack8(tv), o1 = pack8(tv + 8);
            bf16_t* d = dst + (size_t)map_row(mode, n) * K + kt * 64 + kq;
            *(u32x4*)d = o0; *(u32x4*)(d + 8) = o1;
        }
        t = tn;
    }
    __syncthreads();
}

struct Epi {
    bf16_t* o16; int ldc;
    float* o32;
    const float* rp; const float* rs; float scale;
    float* gates; bf16_t* halo; int cv0, cv1;
};
enum { EPI_GU = 0, EPI_RES = 1, EPI_PROJ = 2 };

template <int EPI>
DI void gemm_tail(const bf16_t* A, int lda, const bf16_t* Bt, int K, int nN, const Epi& e, char* smem) {
    const int tid = get_tid(), wid = tid >> 6, lane = tid & 63, wr = wid >> 1, wc = wid & 1, fr = lane & 15, fq = lane >> 4;
    const int nkt = K >> 6;
    const int nitems = EPI == EPI_GU ? nN : (EPI == EPI_PROJ ? nN + 128 : nN * (nkt >> 2));
    for (int it0 = 0; it0 < nitems; it0 += NVB) {
        int it = it0 + ((VB + (NVB >> 1)) % NVB); const bool act = it < nitems; if (!act) it = 0;
        int pm, pn, kbeg = 0, nk = nkt;
        if (EPI == EPI_GU) { pm = 128; pn = it; }
        else if (EPI == EPI_PROJ) { if (it < nN) { pm = 128; pn = it; } else { pm = it - nN; pn = nN - 1; } }
        else { pm = 128; pn = it % nN; kbeg = (it / nN) * 4; nk = 4; }
        f32x4 acc[4][4];
#pragma unroll
        for (int n = 0; n < 4; ++n)
#pragma unroll
            for (int m = 0; m < 4; ++m) acc[n][m] = (f32x4){0.f, 0.f, 0.f, 0.f};
        const bf16_t* Ab = A + (size_t)(pm * 128) * lda + kbeg * 64;
        const bf16_t* Bb = Bt + (size_t)(pn * 128) * K + kbeg * 64;
        const int sr = tid >> 3, sgc = ((tid & 7) ^ (sr & 7)) * 8;
        const bf16_t* ap = Ab + (size_t)sr * lda + sgc;
        const bf16_t* bp = Bb + (size_t)sr * K + sgc;
        const size_t a32 = (size_t)32 * lda, b32 = (size_t)32 * K;
        __attribute__((address_space(3))) char* lbase = (__attribute__((address_space(3))) char*)smem + tid * 16;
#define GEMM_STAGE(BUF)                                                                                                         \
        {                                                                                                                        \
            _Pragma("unroll") for (int ii = 0; ii < 4; ++ii) {                                                                   \
                __builtin_amdgcn_global_load_lds((const unsigned*)(ap + ii * a32), (__attribute__((address_space(3))) unsigned*)(lbase + (BUF) * 32768 + ii * 4096), 16, 0, 0);          \
                __builtin_amdgcn_global_load_lds((const unsigned*)(bp + ii * b32), (__attribute__((address_space(3))) unsigned*)(lbase + (BUF) * 32768 + 16384 + ii * 4096), 16, 0, 0);  \
            }                                                                                                                    \
            ap += 64; bp += 64;                                                                                                  \
        }
#define GEMM_COMPUTE(BUF)                                                                                                       \
        {                                                                                                                        \
            const char* SA = smem + (BUF) * 32768; const char* SB = SA + 16384;                                                  \
            _Pragma("unroll") for (int ks = 0; ks < 2; ++ks) {                                                                   \
                bf16x8 af[4], bf[4];                                                                                             \
                const int sw = ((ks * 4 + fq) ^ (fr & 7)) << 4;                                                                  \
                _Pragma("unroll") for (int m = 0; m < 4; ++m) af[m] = *(const bf16x8*)(SA + (wr * 64 + m * 16 + fr) * 128 + sw); \
                _Pragma("unroll") for (int n = 0; n < 4; ++n) bf[n] = *(const bf16x8*)(SB + (wc * 64 + n * 16 + fr) * 128 + sw); \
                _Pragma("unroll") for (int n = 0; n < 4; ++n)                                                                    \
                    _Pragma("unroll") for (int m = 0; m < 4; ++m) acc[n][m] = mfma16(bf[n], af[m], acc[n][m]);                   \
            }                                                                                                                    \
        }
        __syncthreads();
        GEMM_STAGE(0)
        for (int kt = 0; kt < nk; kt += 2) {
            asm volatile("s_waitcnt vmcnt(0)" ::: "memory");
            __syncthreads();
            GEMM_STAGE(1)
            GEMM_COMPUTE(0)
            asm volatile("s_waitcnt vmcnt(0)" ::: "memory");
            __syncthreads();
            if (kt + 2 < nk) GEMM_STAGE(0)
            GEMM_COMPUTE(1)
        }
        if (act)
#pragma unroll
        for (int m = 0; m < 4; ++m) {
            const int row = pm * 128 + wr * 64 + m * 16 + fr;
            if (EPI == EPI_GU) {
#pragma unroll
                for (int i = 0; i < 2; ++i) {
                    const f32x4 g = acc[2 * i][m], u = acc[2 * i + 1][m];
                    u32x2 o; o.x = pack2(siluf(g[0]) * u[0], siluf(g[1]) * u[1]); o.y = pack2(siluf(g[2]) * u[2], siluf(g[3]) * u[3]);
                    *(u32x2*)(e.o16 + (size_t)row * e.ldc + (pn >> 1) * 128 + (wc * 2 + i) * 32 + 8 * fq + 4 * (pn & 1)) = o;
                }
            } else if (EPI == EPI_RES) {
#pragma unroll
                for (int n = 0; n < 4; ++n) {
                    float* dst = e.o32 + (size_t)row * 1024 + pn * 128 + wc * 64 + n * 16 + 4 * fq;
#pragma unroll
                    for (int j = 0; j < 4; ++j) atomicAdd(dst + j, e.scale * acc[n][m][j]);
                }
            } else {
                if (pn < nN - 1) {
                    int hr, unit;
                    if (row < NPR) { hr = (row & 63) - 61; unit = row >> 6; } else { hr = ((row - NPR) & 15) - 13; unit = 256 + ((row - NPR) >> 4); }
#pragma unroll
                    for (int n = 0; n < 4; ++n) {
                        const int col = pn * 128 + wc * 64 + n * 16 + 4 * fq;
                        u32x2 o; o.x = pack2(acc[n][m][0], acc[n][m][1]); o.y = pack2(acc[n][m][2], acc[n][m][3]);
                        *(u32x2*)(e.o16 + (size_t)row * e.ldc + col) = o;
                        if (hr >= 0 && col >= e.cv0 && col < e.cv1) *(u32x2*)(e.halo + ((size_t)unit * 3 + hr) * 3072 + (col - e.cv0)) = o;
                    }
                } else if (wc == 0) {
#pragma unroll
                    for (int n = 0; n < 2; ++n) {
                        float4 o; o.x = acc[n][m][0]; o.y = acc[n][m][1]; o.z = acc[n][m][2]; o.w = acc[n][m][3];
                        *(float4*)(e.gates + (size_t)row * 32 + n * 16 + 4 * fq) = o;
                    }
                }
            }
        }
    }
}


namespace pg8 {
#define PG8_LAS __attribute__((address_space(3)))
constexpr int BM = 256, BK = 64, HALF = 128, HTB = HALF * BK * 2  , STAGE_BYTES = 8 * HTB, NXCD = 8, WGM = 8;
__host__ __device__ __forceinline__ int lds_byte(int r, int c) { const int st = (r >> 4) * 2 + (c >> 5), rr = r & 15, cc = c & 31, ob = rr * 64 + cc * 2; return st * 1024 + (ob ^ (((ob >> 9) & 1) << 5)); }
__host__ __device__ __forceinline__ void stage_rc(int b, int& R, int& C) { const int st = b / 1024, sb = b % 1024, swz = sb ^ (((sb >> 9) & 1) << 5); R = (st >> 1) * 16 + swz / 64; C = (st & 1) * 32 + (swz % 64) / 2; }
__host__ __device__ __forceinline__ int perm32(int rho) { const int n = rho >> 4, i = rho & 15; return 8 * (i >> 2) + 4 * n + (i & 3); }
struct Unit { int pm, pn; };
struct Gemm { const bf16_t* A; const bf16_t* Bt; int M, N, K, lda; };
struct StaticOrder {
    int nM, nN, nwg, G, c;
    __host__ __device__ void init(int M, int N, int G_, int c_) { nM = M / BM; nN = N / BM; nwg = nM * nN; G = G_; c = c_; }
    __host__ __device__ bool next(int i, Unit& u) const {
        const long L = (long)i * G + c; if (L >= nwg) return false;
        int wgid = (int)L; { const int q = nwg / NXCD, r = nwg % NXCD, xcd = wgid % NXCD, off = wgid / NXCD; wgid = (xcd < r ? xcd * (q + 1) : r * (q + 1) + (xcd - r) * q) + off; }
        const int nig = WGM * nN, gid = wgid / nig, fm = gid * WGM, gsz = (nM - fm) < WGM ? (nM - fm) : WGM;
        u.pm = fm + ((wgid % nig) % gsz); u.pn = (wgid % nig) / gsz; return true;
    }
    __device__ __forceinline__ void a_ready(const Unit&) const {}
    __device__ __forceinline__ void done(const Unit&) const {}
};

template <class Epi, class Sched>
__device__ __forceinline__ void gemm_phase(PG8_LAS unsigned char* lds, const Gemm g, const Sched& S, const Epi& E) {
    const int tid = threadIdx.x, wid = __builtin_amdgcn_readfirstlane(tid >> 6), lane = tid & 63, wr = wid >> 2, wc = wid & 3, fr = lane & 15, fq = lane >> 4;
    const int K = g.K, nt = K / BK;
#define PG8_STAMP() do {} while (0)
    PG8_STAMP();
    unsigned voffA[2], voffB[2];
#pragma unroll
    for (int i = 0; i < 2; ++i) { int R, C; stage_rc(tid * 16 + i * 8192, R, C); const int Rb = Epi::PERM ? ((R & ~31) + perm32(R & 31)) : R;
        voffA[i] = (unsigned)(R * g.lda + C) * 2u; voffB[i] = (unsigned)(Rb * K + C) * 2u; }
    const size_t kstep = (size_t)(BK * 2);
    const size_t hstepB = (size_t)HALF * K * 2, hstepA = (size_t)HALF * g.lda * 2;
    const size_t tstepB = 2 * hstepB, tstepA = 2 * hstepA;
    const unsigned ldsw = (unsigned)wid * 1024u;
    const int aoff = lds_byte(wr * 64 + fr, fq * 8), boff = lds_byte(wc * 32 + fr, fq * 8);
#define PG8_SA(b, h) (((b) * 2 + (h)) * HTB)
#define PG8_SB(b, h) ((4 + (b) * 2 + (h)) * HTB)
#define PG8_STAGE(bufoff, gbase, voff) do { _Pragma("unroll") for (int _i = 0; _i < 2; ++_i) \
        __builtin_amdgcn_global_load_lds((const unsigned*)((const char*)(gbase) + (voff)[_i]), (PG8_LAS unsigned*)(lds + (bufoff) + ldsw + _i * 8192), 16, 0, 0); } while (0)
#define PG8_LDA(dst, b, h) do { _Pragma("unroll") for (int m = 0; m < 4; ++m) _Pragma("unroll") for (int k = 0; k < 2; ++k) dst[m][k] = *(const PG8_LAS bf16x8*)(lds + PG8_SA(b, h) + aoff + m * 2048 + k * 1024); } while (0)
#define PG8_LDB(dst, b, h) do { _Pragma("unroll") for (int n = 0; n < 2; ++n) _Pragma("unroll") for (int k = 0; k < 2; ++k) dst[n][k] = *(const PG8_LAS bf16x8*)(lds + PG8_SB(b, h) + boff + n * 2048 + k * 1024); } while (0)
#define PG8_MMA(ai, bj, At, Bt) do { __builtin_amdgcn_s_setprio(1); _Pragma("unroll") for (int m = 0; m < 4; ++m) _Pragma("unroll") for (int n = 0; n < 2; ++n) _Pragma("unroll") for (int k = 0; k < 2; ++k) \
        acc[ai][bj][m][n] = __builtin_amdgcn_mfma_f32_16x16x32_bf16(Bt[n][k], At[m][k], acc[ai][bj][m][n], 0, 0, 0); __builtin_amdgcn_s_setprio(0); } while (0)
#define PG8_WAIT_V(n) asm volatile("s_waitcnt vmcnt(" #n ")" ::: "memory")
#define PG8_WAIT_L(n) asm volatile("s_waitcnt lgkmcnt(" #n ")" ::: "memory")
#define PG8_BAR __builtin_amdgcn_s_barrier()
#define PG8_SCHED __builtin_amdgcn_sched_barrier(0)
    Unit cur, nxt; int ui = 0;
    if (!S.next(0, cur)) return;
    f32x4 acc[2][2][4][2];
#pragma unroll
    for (int a = 0; a < 2; ++a)
#pragma unroll
        for (int b = 0; b < 2; ++b)
#pragma unroll
            for (int m = 0; m < 4; ++m)
#pragma unroll
                for (int n = 0; n < 2; ++n) acc[a][b][m][n] = (f32x4){0.f, 0.f, 0.f, 0.f};
    bf16x8 At[4][2], B0[2][2], B1[2][2];
    const char* cA = (const char*)g.A + (size_t)cur.pm * tstepA; const char* cB = (const char*)g.Bt + (size_t)cur.pn * tstepB;
    S.a_ready(cur);
    PG8_STAGE(PG8_SB(0, 0), cB, voffB); PG8_STAGE(PG8_SA(0, 0), cA, voffA); PG8_STAGE(PG8_SB(0, 1), cB + hstepB, voffB); PG8_STAGE(PG8_SA(0, 1), cA + hstepA, voffA);
    if (wr == 1) PG8_BAR;
    PG8_WAIT_V(4); PG8_BAR;
    PG8_STAGE(PG8_SB(1, 0), cB + kstep, voffB); PG8_STAGE(PG8_SA(1, 0), cA + kstep, voffA); PG8_STAGE(PG8_SB(1, 1), cB + hstepB + kstep, voffB);
    PG8_WAIT_V(6); PG8_BAR;
    PG8_STAMP();
    for (;;) {
        const bool has_next = S.next(ui + 1, nxt);
        const char* nA = has_next ? (const char*)g.A + (size_t)nxt.pm * tstepA : cA; const char* nB = has_next ? (const char*)g.Bt + (size_t)nxt.pn * tstepB : cB;
        for (int t = 0; t < nt; t += 2) {
            const bool last = (t == nt - 2);
            const char* a1 = cA + (size_t)(t + 1) * kstep;
            const char* a2 = last ? nA : cA + (size_t)(t + 2) * kstep; const char* b2 = last ? nB : cB + (size_t)(t + 2) * kstep;
            const char* a3 = a2 + kstep; const char* b3 = b2 + kstep;
            if (last && has_next) S.a_ready(nxt);
            PG8_LDB(B0, 0, 0); PG8_SCHED; PG8_LDA(At, 0, 0); PG8_STAGE(PG8_SA(1, 1), a1 + hstepA, voffA);
            PG8_WAIT_L(8); PG8_BAR; PG8_WAIT_L(0); PG8_MMA(0, 0, At, B0); PG8_BAR; PG8_SCHED;
            PG8_LDB(B1, 0, 1); PG8_STAGE(PG8_SB(0, 0), b2, voffB);
            PG8_BAR; PG8_WAIT_L(0); PG8_MMA(0, 1, At, B1); PG8_BAR;
            PG8_LDA(At, 0, 1); PG8_STAGE(PG8_SA(0, 0), a2, voffA);
            PG8_BAR; PG8_WAIT_L(0); PG8_MMA(1, 0, At, B0); PG8_BAR; PG8_SCHED;
            PG8_STAGE(PG8_SB(0, 1), b2 + hstepB, voffB);
            PG8_WAIT_V(6); PG8_BAR; PG8_MMA(1, 1, At, B1); PG8_BAR;
            PG8_LDB(B0, 1, 0); PG8_SCHED; PG8_LDA(At, 1, 0); PG8_STAGE(PG8_SA(0, 1), a2 + hstepA, voffA);
            PG8_WAIT_L(8); PG8_BAR; PG8_WAIT_L(0); PG8_MMA(0, 0, At, B0); PG8_BAR; PG8_SCHED;
            PG8_LDB(B1, 1, 1); PG8_STAGE(PG8_SB(1, 0), b3, voffB);
            PG8_BAR; PG8_WAIT_L(0); PG8_MMA(0, 1, At, B1); PG8_BAR;
            PG8_LDA(At, 1, 1); PG8_STAGE(PG8_SA(1, 0), a3, voffA);
            PG8_BAR; PG8_WAIT_L(0); PG8_MMA(1, 0, At, B0); PG8_BAR; PG8_SCHED;
            PG8_STAGE(PG8_SB(1, 1), b3 + hstepB, voffB);
            PG8_WAIT_V(6); PG8_BAR; PG8_MMA(1, 1, At, B1); PG8_BAR;
        }
        PG8_STAMP();
        if constexpr (!Epi::AFTER_DRAIN) { E(acc, cur, wr, wc, fr, fq); S.done(cur); }
        PG8_STAMP();
        if (!has_next) break;
#pragma unroll
        for (int a = 0; a < 2; ++a)
#pragma unroll
            for (int b = 0; b < 2; ++b)
#pragma unroll
                for (int m = 0; m < 4; ++m)
#pragma unroll
                    for (int n = 0; n < 2; ++n) acc[a][b][m][n] = (f32x4){0.f, 0.f, 0.f, 0.f};
        cur = nxt; cA = nA; cB = nB; ++ui;
    }
    PG8_WAIT_V(0);
    if (wr == 0) PG8_BAR;
    PG8_BAR;
    if constexpr (Epi::AFTER_DRAIN) { E.fused(acc, cur, wr, wc, fr, fq, lds, wid, lane); S.done(cur); }
    PG8_STAMP();
#undef PG8_STAMP
#undef PG8_SA
#undef PG8_SB
#undef PG8_STAGE
#undef PG8_LDA
#undef PG8_LDB
#undef PG8_MMA
#undef PG8_WAIT_V
#undef PG8_WAIT_L
#undef PG8_BAR
#undef PG8_SCHED
}
}

struct PEpiGU {
    static constexpr bool PERM = false, AFTER_DRAIN = false;
    bf16_t* O;
    DI void operator()(const f32x4 (&acc)[2][2][4][2], const pg8::Unit& u, int wr, int wc, int fr, int fq) const {
        asm volatile("" : "+v"(fr), "+v"(fq));
#pragma unroll
        for (int ai = 0; ai < 2; ++ai)
#pragma unroll
            for (int m = 0; m < 4; ++m) {
                bf16_t* rowp = O + (size_t)(u.pm * 256 + ai * 128 + wr * 64 + m * 16 + fr) * 2816 + u.pn * 128 + wc * 32 + 8 * fq;
                u32x4 o;
                { const f32x4 g = acc[ai][0][m][0], up = acc[ai][0][m][1]; o.x = pack2(siluf(g[0]) * up[0], siluf(g[1]) * up[1]); o.y = pack2(siluf(g[2]) * up[2], siluf(g[3]) * up[3]); }
                { const f32x4 g = acc[ai][1][m][0], up = acc[ai][1][m][1]; o.z = pack2(siluf(g[0]) * up[0], siluf(g[1]) * up[1]); o.w = pack2(siluf(g[2]) * up[2], siluf(g[3]) * up[3]); }
                *(u32x4*)rowp = o;
            }
    }
};
struct PEpiRES {
    static constexpr bool PERM = false, AFTER_DRAIN = false;
    float* X; const float* R; float scale;
    DI void operator()(const f32x4 (&acc)[2][2][4][2], const pg8::Unit& u, int wr, int wc, int fr, int fq) const {
        asm volatile("" : "+v"(fr), "+v"(fq));
#pragma unroll
        for (int ai = 0; ai < 2; ++ai)
#pragma unroll
            for (int m = 0; m < 4; ++m) {
                const size_t off = (size_t)(u.pm * 256 + ai * 128 + wr * 64 + m * 16 + fr) * 1024 + u.pn * 256 + wc * 32 + 4 * fq;
#pragma unroll
                for (int bj = 0; bj < 2; ++bj)
#pragma unroll
                    for (int n = 0; n < 2; ++n) {
                        const float4 r4 = *(const float4*)(R + off + bj * 128 + n * 16);
                        const f32x4 a = acc[ai][bj][m][n];
                        float4 o; o.x = r4.x + scale * a[0]; o.y = r4.y + scale * a[1]; o.z = r4.z + scale * a[2]; o.w = r4.w + scale * a[3];
                        *(float4*)(X + off + bj * 128 + n * 16) = o;
                    }
            }
    }
};
struct PEpiPROJ {
    static constexpr bool PERM = true, AFTER_DRAIN = false;
    bf16_t* O; int ldc; bf16_t* halo; int cv0, cv1;
    DI void operator()(const f32x4 (&acc)[2][2][4][2], const pg8::Unit& u, int wr, int wc, int fr, int fq) const {
        asm volatile("" : "+v"(fr), "+v"(fq));
#pragma unroll
        for (int ai = 0; ai < 2; ++ai)
#pragma unroll
            for (int m = 0; m < 4; ++m) {
                const int row = u.pm * 256 + ai * 128 + wr * 64 + m * 16 + fr, hr = (row & 63) - 61, unit = row >> 6;
#pragma unroll
                for (int bj = 0; bj < 2; ++bj) {
                    const int col = u.pn * 256 + bj * 128 + wc * 32 + 8 * fq;
                    const u32x2 lo = pack4(acc[ai][bj][m][0]), hi = pack4(acc[ai][bj][m][1]);
                    const u32x4 o = (u32x4){lo.x, lo.y, hi.x, hi.y};
                    *(u32x4*)(O + (size_t)row * ldc + col) = o;
                    if (hr >= 0 && col >= cv0 && col < cv1) *(u32x4*)(halo + ((size_t)unit * 3 + hr) * 3072 + (col - cv0)) = o;
                }
            }
    }
};
template <class PE>
DI void gemm_big(const bf16_t* A, int lda, const bf16_t* Bt, int K, int N, const PE& pe, char* smem_all) {
    pg8::Gemm g; g.A = A; g.Bt = Bt; g.M = NPR; g.N = N; g.K = K; g.lda = lda;
    pg8::StaticOrder S; S.init(NPR, N, (int)gridDim.x, (int)blockIdx.x);
    __syncthreads();
    pg8::gemm_phase<PE, pg8::StaticOrder>((PG8_LAS unsigned char*)smem_all, g, S, pe);
    __syncthreads();
}

#define OFF_YS   16777216
#define OFF_PC   16908288
#define OFF_PN   17432576
#define OFF_PM   17434624
#define OFF_PSSD 17434640
#define OFF_PSC  17958928
#define OFF_PG   17977360
#define OFF_PGC  18501648
#define OFF_SC   18538512
#define OFF_SN   19587088
#define OFF_SM   19591184
#define OFF_SSSD 19591216
#define OFF_SSC  20639792
#define OFF_SG   20676656
#define OFF_SGC  21725232

#define LSYNC() do { asm volatile("s_waitcnt lgkmcnt(0)" ::: "memory"); __builtin_amdgcn_s_barrier(); asm volatile("" ::: "memory"); } while (0)

DI float scan_add(float v, int lane) {
#pragma unroll
    for (int o = 1; o < 64; o <<= 1) { const float t = __shfl_up(v, o); if (lane >= o) v += t; }
    return v;
}
DI float scan_max(float v, int lane) {
#pragma unroll
    for (int o = 1; o < 64; o <<= 1) { const float t = __shfl_up(v, o); if (lane >= o) v = fmaxf(v, t); }
    return v;
}

DI void fill_cache_halo(const float* cache, int width, bf16_t* halo) {
    for (int i = VB * 256 + get_tid(); i < 8 * 3 * width; i += NVB * 256) {
        const int s = i / (3 * width), rem = i % (3 * width), r = rem / width, col = rem % width;
        halo[((size_t)(264 + s) * 3 + r) * 3072 + col] = f2bf(cache[i]);
    }
}

DI void phase_conv_ssd(const Params& p, bf16_t* BIG, const bf16_t* halo) {
    const int tid = get_tid(), cv = tid & 31, tg = tid >> 5;
    const float* cw = p.in[19]; const float* cb = p.in[20];
    for (int it = VB; it < 264 * 6; it += NVB) {
        const int unit = it / 6, cblk = it % 6, col = cblk * 256 + cv * 8;
        const bool smp = unit >= 256;
        const int L = smp ? 16 : 64, c = unit & 63, s = unit - 256;
        const size_t row0 = smp ? (size_t)NPR + s * 16 : (size_t)unit * 64;
        const bool act = tg * 8 < L;
        float x[11][8];
        if (act) {
#pragma unroll
            for (int i = 0; i < 11; ++i) {
                const int rl = tg * 8 - 3 + i;
                if (rl >= 0) { const u32x4 v = *(const u32x4*)(BIG + (row0 + rl) * 5632 + 4096 + col); unpack8(v, x[i]); }
                else if (!smp) {
                    if (c == 0) {
#pragma unroll
                        for (int j = 0; j < 8; ++j) x[i][j] = 0.f;
                    } else { const u32x4 v = *(const u32x4*)(halo + ((size_t)(unit - 1) * 3 + (rl + 3)) * 3072 + col); unpack8(v, x[i]); }
                } else {
                    const float* src = p.in[6] + ((size_t)s * 3 + (rl + 3)) * 1536 + col;
                    const float4 a = *(const float4*)src, b = *(const float4*)(src + 4);
                    x[i][0] = a.x; x[i][1] = a.y; x[i][2] = a.z; x[i][3] = a.w; x[i][4] = b.x; x[i][5] = b.y; x[i][6] = b.z; x[i][7] = b.w;
                }
            }
        }
        __syncthreads();
        if (act) {
            float w[4][8], bb[8];
#pragma unroll
            for (int i = 0; i < 4; ++i) {
                const float4 a = *(const float4*)(cw + i * 1536 + col), b = *(const float4*)(cw + i * 1536 + col + 4);
                w[i][0] = a.x; w[i][1] = a.y; w[i][2] = a.z; w[i][3] = a.w; w[i][4] = b.x; w[i][5] = b.y; w[i][6] = b.z; w[i][7] = b.w;
            }
            { const float4 a = *(const float4*)(cb + col), b = *(const float4*)(cb + col + 4);
              bb[0] = a.x; bb[1] = a.y; bb[2] = a.z; bb[3] = a.w; bb[4] = b.x; bb[5] = b.y; bb[6] = b.z; bb[7] = b.w; }
#pragma unroll
            for (int t = 0; t < 8; ++t) {
                float o[8];
#pragma unroll
                for (int j = 0; j < 8; ++j) { const float a = bb[j] + w[0][j] * x[t][j] + w[1][j] * x[t + 1][j] + w[2][j] * x[t + 2][j] + w[3][j] * x[t + 3][j]; o[j] = siluf(a); }
                *(u32x4*)(BIG + (row0 + tg * 8 + t) * 5632 + 4096 + col) = pack8(o);
            }
        }
        if ((smp || c == 63) && tid < 96) {
            const int i = tid >> 5;
            float f[8]; unpack8(*(const u32x4*)(halo + ((size_t)unit * 3 + i) * 3072 + col), f);
            float* dst = smp ? p.out + OFF_SSC + ((size_t)s * 3 + i) * 1536 + col : p.out + OFF_PSC + ((size_t)(unit >> 6) * 3 + i) * 1536 + col;
            *(float4*)dst = make_float4(f[0], f[1], f[2], f[3]); *(float4*)(dst + 4) = make_float4(f[4], f[5], f[6], f[7]);
        }
        __syncthreads();
    }
}

#define L_Q   0
#define L_K   17408
#define L_KT  34816
#define L_VT  53248
#define L_VW  55552
#define L_P   57856
#define L_ST  67072
#define L_F   71424

template <int NT>
DI void mlstm_chain(const Params& p, bf16_t* BIG, const float* gates, int b, int hd, int es, bool smp, char* smem, bool live) {
    const int tid = get_tid(), wid = tid >> 6, lane = tid & 63, fr = lane & 15, fq = lane >> 4;
    bf16_t* Qs = (bf16_t*)(smem + L_Q); bf16_t* Ks = (bf16_t*)(smem + L_K); bf16_t* WRs = (bf16_t*)(smem + L_KT);     bf16_t* VTs = (bf16_t*)(smem + L_VT);
    constexpr int LDV = 16 * NT + 8;
    bf16_t* VWs = VTs + 64 * LDV; bf16_t* Ps = VWs + 64 * LDV; bf16_t* STs = Ps + 64 * 72;
    float* fl = (float*)(STs + 16 * NT * 136);
    float* as_ = fl; float* Ms = fl + 64; float* bs = fl + 128; float* wrs = fl + 192; float* rsum = fl + 256; float* qns = fl + 320; float* ns = fl + 384; float* sc = fl + 512;
    const int L = smp ? 16 : 64, nch = smp ? 1 : 64, sidx = b * 4 + hd;
    const size_t row0 = smp ? (size_t)NPR + b * 16 : (size_t)b * 4096;
    const float bi = p.in[16][hd], bfg = p.in[17][hd];
    float m = 0.f;
    f32x4 accN[2];
    accN[0] = (f32x4){0.f, 0.f, 0.f, 0.f}; accN[1] = accN[0];
    f32x4 accC[2][NT];
#pragma unroll
    for (int mt = 0; mt < 2; ++mt)
#pragma unroll
        for (int nt = 0; nt < NT; ++nt) accC[mt][nt] = (f32x4){0.f, 0.f, 0.f, 0.f};
    if (smp) {
        const float* C0 = p.in[2] + (size_t)sidx * 128 * 256;
#pragma unroll
        for (int mt = 0; mt < 2; ++mt)
#pragma unroll
            for (int nt = 0; nt < NT; ++nt)
#pragma unroll
                for (int j = 0; j < 4; ++j) accC[mt][nt][j] = C0[(size_t)(32 * wid + 16 * mt + 4 * fq + j) * 256 + es * 16 * NT + nt * 16 + fr];
        if (fr == 0) {
#pragma unroll
            for (int mt = 0; mt < 2; ++mt)
#pragma unroll
                for (int j = 0; j < 4; ++j) accN[mt][j] = p.in[3][sidx * 128 + 32 * wid + 16 * mt + 4 * fq + j];
        }
        m = p.in[4][sidx];
    }
    LSYNC();
#pragma unroll
    for (int mt = 0; mt < 2; ++mt)
#pragma unroll
        for (int nt = 0; nt < NT; ++nt) *(u32x2*)(STs + (nt * 16 + fr) * 136 + 32 * wid + 16 * mt + 4 * fq) = pack4(accC[mt][nt]);
#pragma unroll
    for (int mt = 0; mt < 2; ++mt) if (fr == 0) { ns[32 * wid + 16 * mt + 4 * fq] = accN[mt][0]; ns[32 * wid + 16 * mt + 4 * fq + 1] = accN[mt][1]; ns[32 * wid + 16 * mt + 4 * fq + 2] = accN[mt][2]; ns[32 * wid + 16 * mt + 4 * fq + 3] = accN[mt][3]; }
    for (int i = tid; i < 16 * 72 / 2; i += 256) ((unsigned*)WRs)[i] = 0u;

    u32x4 qv[4], kv[4], vv; float gi = 0.f, gf = 0.f;
    auto load = [&](int c) __attribute__((always_inline)) {
        const size_t r0 = row0 + (size_t)c * 64;
{
            const int r = tid >> 2, qt = tid & 3, rc = r < L ? r : L - 1;
            const bf16_t* qp = BIG + (r0 + rc) * 5632 + hd * 128 + qt * 32;
#pragma unroll
            for (int i = 0; i < 4; ++i) {
                qv[i] = *(const u32x4*)(qp + i * 8); kv[i] = *(const u32x4*)(qp + 512 + i * 8);
                if (r >= L) { qv[i] = (u32x4){0u, 0u, 0u, 0u}; kv[i] = (u32x4){0u, 0u, 0u, 0u}; }
            }
        }
        { const int vt = NT == 2 ? tid : (tid & 127), r = vt >> NT, cc = vt & (2 * NT - 1), rc = r < L ? r : L - 1;
          vv = *(const u32x4*)(BIG + (r0 + rc) * 5632 + 1024 + hd * 256 + es * 16 * NT + cc * 8);
          if (r >= L) vv = (u32x4){0u, 0u, 0u, 0u}; }
        { const int lc = lane < L ? lane : L - 1; gi = gates[(r0 + lc) * 32 + hd]; gf = gates[(r0 + lc) * 32 + 4 + hd]; }
    };
    load(0);
    for (int c = 0; c < nch; ++c) {
        LSYNC();
        if (wid == 0) {
            float ig = -1e30f, lf = 0.f;
            if (lane < L) { ig = gi + bi; const float x = gf + bfg; lf = fminf(x, 0.f) - log1pf(__expf(-fabsf(x))); }
            const float bc = scan_add(lf, lane);
            const float a = ig - bc;
            const float pm = scan_max(a, lane);
            const float M = fmaxf(m, pm);
            const float Mlast = __shfl(M, L - 1), bL = __shfl(bc, L - 1);
            as_[lane] = a; Ms[lane] = M; bs[lane] = bc; { const float wrv = lane < L ? __expf(a - Mlast) : 0.f; wrs[lane] = wrv; WRs[lane] = f2bf(wrv); }
            if (lane == 0) { sc[0] = Mlast; sc[1] = bL; }
        }
        LSYNC();
{
            const int r = tid >> 2, qt = tid & 3;
            bf16_t* qd = Qs + r * 136 + qt * 32; bf16_t* kd = Ks + r * 136 + qt * 32;
#pragma unroll
            for (int i = 0; i < 4; ++i) { *(u32x4*)(qd + i * 8) = qv[i]; *(u32x4*)(kd + i * 8) = kv[i]; }
        }
        if (NT == 2 || tid < 128) {
            const int r = tid >> NT, cc = tid & (2 * NT - 1); const float w = wrs[r];
            float vf[8]; unpack8(vv, vf);
#pragma unroll
            for (int j = 0; j < 8; ++j) vf[j] *= w;
            *(u32x4*)(VTs + r * LDV + cc * 8) = vv; *(u32x4*)(VWs + r * LDV + cc * 8) = pack8(vf);
        }
        if (c + 1 < nch) load(c + 1);
        LSYNC();
        {
            f32x4 s4[4];
#pragma unroll
            for (int nt = 0; nt < 4; ++nt) s4[nt] = (f32x4){0.f, 0.f, 0.f, 0.f};
#pragma unroll 1
            for (int kk = 0; kk < 4; ++kk) {
                const bf16x8 qf = ldfrag(Qs, 136, 16 * wid + fr, kk * 32 + fq * 8);
#pragma unroll
                for (int nt = 0; nt < 4; ++nt) s4[nt] = mfma16(ldfrag(Ks, 136, 16 * nt + fr, kk * 32 + fq * 8), qf, s4[nt]);
            }
            const int s = 16 * wid + fr; const float Msv = Ms[s]; float rs = 0.f;
#pragma unroll
            for (int nt = 0; nt < 4; ++nt) {
                f32x4 pv;
#pragma unroll
                for (int j = 0; j < 4; ++j) { const int r = 16 * nt + 4 * fq + j; const float d = (r <= s) ? __expf(as_[r] - Msv) : 0.f; pv[j] = s4[nt][j] * d; rs += pv[j]; }
                *(u32x2*)(Ps + s * 72 + 16 * nt + 4 * fq) = pack4(pv);
            }
            rs += __shfl_xor(rs, 16); rs += __shfl_xor(rs, 32);
            if (fq == 0) rsum[s] = rs;
            const int s2 = tid >> 2, part = tid & 3; float qa = 0.f;
#pragma unroll
            for (int j = 0; j < 4; ++j) { float qf8[8]; unpack8(*(const u32x4*)(Qs + s2 * 136 + part * 32 + j * 8), qf8);
#pragma unroll
                for (int i = 0; i < 8; ++i) qa += qf8[i] * ns[part * 32 + j * 8 + i]; }
            qa += __shfl_xor(qa, 1); qa += __shfl_xor(qa, 2);
            if (part == 0) qns[s2] = qa;
        }
        LSYNC();
        const float Mlast = sc[0], bL = sc[1];
        {
            bf16x8 pf[2], qf[4];
#pragma unroll
            for (int kk = 0; kk < 2; ++kk) pf[kk] = ldfrag(Ps, 72, 16 * wid + fr, kk * 32 + fq * 8);
#pragma unroll
            for (int kk = 0; kk < 4; ++kk) qf[kk] = ldfrag(Qs, 136, 16 * wid + fr, kk * 32 + fq * 8);
            const int s = 16 * wid + fr; const float Msv = Ms[s], wi = __expf(m - Msv);
            const float den = rsum[s] + wi * qns[s], ms = bs[s] + Msv, inv = 1.f / fmaxf(fabsf(den), __expf(-ms));
#pragma unroll
            for (int nt = 0; nt < NT; ++nt) {
                f32x4 h1 = (f32x4){0.f, 0.f, 0.f, 0.f}, h2 = h1;
#pragma unroll
                for (int kk = 0; kk < 2; ++kk) h1 = mfma16(ldfrag_tr(VTs, LDV, kk * 32, nt * 16, fr, fq), pf[kk], h1);
#pragma unroll
                for (int kk = 0; kk < 4; ++kk) h2 = mfma16(ldfrag(STs, 136, nt * 16 + fr, kk * 32 + fq * 8), qf[kk], h2);
                f32x4 hv;
#pragma unroll
                for (int j = 0; j < 4; ++j) hv[j] = (h1[j] + wi * h2[j]) * inv;
                if (s < L && live) *(u32x2*)(BIG + (row0 + (size_t)c * 64 + s) * 5632 + 1024 + hd * 256 + es * 16 * NT + nt * 16 + 4 * fq) = pack4(hv);
            }
        }
        {
            const float decay = __expf(m - Mlast);
            bf16x8 vw0[NT], vw1[NT];
#pragma unroll
            for (int nt = 0; nt < NT; ++nt) { vw0[nt] = ldfrag_tr(VWs, LDV, 0, nt * 16, fr, fq); vw1[nt] = ldfrag_tr(VWs, LDV, 32, nt * 16, fr, fq); }
#pragma unroll
            for (int mt = 0; mt < 2; ++mt) {
                const bf16x8 k0 = ldfrag_tr(Ks, 136, 0, 32 * wid + 16 * mt, fr, fq), k1 = ldfrag_tr(Ks, 136, 32, 32 * wid + 16 * mt, fr, fq);
#pragma unroll
                for (int nt = 0; nt < NT; ++nt) {
                    accC[mt][nt] *= decay;
                    accC[mt][nt] = mfma16(k0, vw0[nt], accC[mt][nt]);
                    accC[mt][nt] = mfma16(k1, vw1[nt], accC[mt][nt]);
                }
                accN[mt] *= decay;
                accN[mt] = mfma16(k0, ldfrag(WRs, 72, fr, fq * 8), accN[mt]);
                accN[mt] = mfma16(k1, ldfrag(WRs, 72, fr, 32 + fq * 8), accN[mt]);
            }
        }
        m = bL + Mlast;
        LSYNC();
#pragma unroll
        for (int mt = 0; mt < 2; ++mt)
#pragma unroll
            for (int nt = 0; nt < NT; ++nt) *(u32x2*)(STs + (nt * 16 + fr) * 136 + 32 * wid + 16 * mt + 4 * fq) = pack4(accC[mt][nt]);
    #pragma unroll
        for (int mt = 0; mt < 2; ++mt) if (fr == 0) { ns[32 * wid + 16 * mt + 4 * fq] = accN[mt][0]; ns[32 * wid + 16 * mt + 4 * fq + 1] = accN[mt][1]; ns[32 * wid + 16 * mt + 4 * fq + 2] = accN[mt][2]; ns[32 * wid + 16 * mt + 4 * fq + 3] = accN[mt][3]; }
    }
    if (!live) return;
    float* Co = p.out + (smp ? OFF_SC : OFF_PC) + (size_t)sidx * 128 * 256;
#pragma unroll
    for (int mt = 0; mt < 2; ++mt)
#pragma unroll
        for (int nt = 0; nt < NT; ++nt)
#pragma unroll
            for (int j = 0; j < 4; ++j) Co[(size_t)(32 * wid + 16 * mt + 4 * fq + j) * 256 + es * 16 * NT + nt * 16 + fr] = accC[mt][nt][j];
    if (es == 0) {
        if (fr == 0) {
#pragma unroll
            for (int mt = 0; mt < 2; ++mt)
#pragma unroll
                for (int j = 0; j < 4; ++j) p.out[(smp ? OFF_SN : OFF_PN) + sidx * 128 + 32 * wid + 16 * mt + 4 * fq + j] = accN[mt][j];
        }
        if (tid == 0) p.out[(smp ? OFF_SM : OFF_PM) + sidx] = m;
    }
}

template <int NT>
DI void ssd_chain(const Params& p, bf16_t* BIG, const float* gates, int b, int hd, int ps, bool smp, char* smem, bool live) {
    const int tid = get_tid(), wid = tid >> 6, lane = tid & 63, fr = lane & 15, fq = lane >> 4;
    bf16_t* Cs = (bf16_t*)(smem + L_Q); bf16_t* Bs = (bf16_t*)(smem + L_K);  bf16_t* XTs = (bf16_t*)(smem + L_VT);
    constexpr int LDX = 16 * NT + 8;
    bf16_t* XWs = XTs + 64 * LDX; bf16_t* Ps = XWs + 64 * LDX; bf16_t* STs = Ps + 64 * 72;
    float* fl = (float*)(STs + 16 * NT * 136);
    float* bs = fl; float* dts = fl + 64; float* wrs = fl + 128; float* sc = fl + 192;
    const int L = smp ? 16 : 64, nch = smp ? 1 : 64, sidx = b * 16 + hd, g = hd >> 3;
    const size_t row0 = smp ? (size_t)NPR + b * 16 : (size_t)b * 4096;
    const float dtb = p.in[21][hd], negA = -__expf(p.in[22][hd]), Dk = p.in[23][hd];
    f32x4 accS[2][NT];
#pragma unroll
    for (int i = 0; i < 2; ++i)
#pragma unroll
        for (int nt = 0; nt < NT; ++nt) accS[i][nt] = (f32x4){0.f, 0.f, 0.f, 0.f};
    if (smp) {
        const float* S0 = p.in[5] + (size_t)sidx * 64 * 128;
#pragma unroll
        for (int i = 0; i < 2; ++i)
#pragma unroll
            for (int nt = 0; nt < NT; ++nt)
#pragma unroll
                for (int j = 0; j < 4; ++j) accS[i][nt][j] = S0[(size_t)(ps * 16 * NT + nt * 16 + fr) * 128 + 16 * (2 * wid + i) + 4 * fq + j];
    }
    LSYNC();
#pragma unroll
    for (int i = 0; i < 2; ++i)
#pragma unroll
        for (int nt = 0; nt < NT; ++nt) *(u32x2*)(STs + (nt * 16 + fr) * 136 + 16 * (2 * wid + i) + 4 * fq) = pack4(accS[i][nt]);

    u32x4 qv[4], kv[4], vv; float gd = 0.f;
    auto load = [&](int c) __attribute__((always_inline)) {
        const size_t r0 = row0 + (size_t)c * 64;
{
            const int r = tid >> 2, qt = tid & 3, rc = r < L ? r : L - 1;
            const bf16_t* bp = BIG + (r0 + rc) * 5632 + 5120 + g * 128 + qt * 32;
#pragma unroll
            for (int i = 0; i < 4; ++i) {
                qv[i] = *(const u32x4*)(bp + 256 + i * 8); kv[i] = *(const u32x4*)(bp + i * 8);
                if (r >= L) { qv[i] = (u32x4){0u, 0u, 0u, 0u}; kv[i] = (u32x4){0u, 0u, 0u, 0u}; }
            }
        }
        { const int vt = NT == 2 ? tid : (tid & 127), r = vt >> NT, cc = vt & (2 * NT - 1), rc = r < L ? r : L - 1;
          vv = *(const u32x4*)(BIG + (r0 + rc) * 5632 + 4096 + hd * 64 + ps * 16 * NT + cc * 8);
          if (r >= L) vv = (u32x4){0u, 0u, 0u, 0u}; }
        { const int lc = lane < L ? lane : L - 1; gd = gates[(r0 + lc) * 32 + 8 + hd]; }
    };
    load(0);
    for (int c = 0; c < nch; ++c) {
        LSYNC();
        if (wid == 0) {
            float dtv = 0.f;
            if (lane < L) dtv = softplusf(gd + dtb);
            const float a = negA * dtv;
            const float bc = scan_add(a, lane);
            const float bL = __shfl(bc, L - 1);
            bs[lane] = bc; dts[lane] = dtv; wrs[lane] = __expf(bL - bc) * dtv;
            if (lane == 0) sc[1] = bL;
        }
        LSYNC();
{
            const int r = tid >> 2, qt = tid & 3;
            bf16_t* qd = Cs + r * 136 + qt * 32; bf16_t* kd = Bs + r * 136 + qt * 32;
#pragma unroll
            for (int i = 0; i < 4; ++i) { *(u32x4*)(qd + i * 8) = qv[i]; *(u32x4*)(kd + i * 8) = kv[i]; }
        }
        if (NT == 2 || tid < 128) {
            const int r = tid >> NT, cc = tid & (2 * NT - 1); const float w = wrs[r];
            float vf[8]; unpack8(vv, vf);
#pragma unroll
            for (int j = 0; j < 8; ++j) vf[j] *= w;
            *(u32x4*)(XTs + r * LDX + cc * 8) = vv; *(u32x4*)(XWs + r * LDX + cc * 8) = pack8(vf);
        }
        if (c + 1 < nch) load(c + 1);
        LSYNC();
        {
            f32x4 s4[4];
#pragma unroll
            for (int nt = 0; nt < 4; ++nt) s4[nt] = (f32x4){0.f, 0.f, 0.f, 0.f};
#pragma unroll 1
            for (int kk = 0; kk < 4; ++kk) {
                const bf16x8 qf = ldfrag(Cs, 136, 16 * wid + fr, kk * 32 + fq * 8);
#pragma unroll
                for (int nt = 0; nt < 4; ++nt) s4[nt] = mfma16(ldfrag(Bs, 136, 16 * nt + fr, kk * 32 + fq * 8), qf, s4[nt]);
            }
            const int s = 16 * wid + fr; const float bsv = bs[s];
#pragma unroll
            for (int nt = 0; nt < 4; ++nt) {
                f32x4 pv;
#pragma unroll
                for (int j = 0; j < 4; ++j) { const int r = 16 * nt + 4 * fq + j; const float d = (r <= s) ? __expf(bsv - bs[r]) * dts[r] : 0.f; pv[j] = s4[nt][j] * d; }
                *(u32x2*)(Ps + s * 72 + 16 * nt + 4 * fq) = pack4(pv);
            }
        }
        LSYNC();
        const float bL = sc[1];
        {
            bf16x8 pf[2], cf[4];
#pragma unroll
            for (int kk = 0; kk < 2; ++kk) pf[kk] = ldfrag(Ps, 72, 16 * wid + fr, kk * 32 + fq * 8);
#pragma unroll
            for (int kk = 0; kk < 4; ++kk) cf[kk] = ldfrag(Cs, 136, 16 * wid + fr, kk * 32 + fq * 8);
            const int s = 16 * wid + fr; const float eb = __expf(bs[s]);
#pragma unroll
            for (int nt = 0; nt < NT; ++nt) {
                f32x4 h1 = (f32x4){0.f, 0.f, 0.f, 0.f}, h2 = h1;
#pragma unroll
                for (int kk = 0; kk < 2; ++kk) h1 = mfma16(ldfrag_tr(XTs, LDX, kk * 32, nt * 16, fr, fq), pf[kk], h1);
#pragma unroll
                for (int kk = 0; kk < 4; ++kk) h2 = mfma16(ldfrag(STs, 136, nt * 16 + fr, kk * 32 + fq * 8), cf[kk], h2);
                if (s < L && live) {
                    bf16_t* zp = BIG + (row0 + (size_t)c * 64 + s) * 5632 + 2048 + hd * 64 + ps * 16 * NT + nt * 16 + 4 * fq;
                    const u32x2 zr = *(const u32x2*)zp;
                    const float zf[4] = {lo2f(zr.x), hi2f(zr.x), lo2f(zr.y), hi2f(zr.y)};
                    f32x4 yv;
#pragma unroll
                    for (int j = 0; j < 4; ++j) { const float xv = bf2f(XTs[s * LDX + nt * 16 + 4 * fq + j]); yv[j] = (h1[j] + eb * h2[j] + Dk * xv) * siluf(zf[j]); }
                    *(u32x2*)zp = pack4(yv);
                }
            }
        }
        {
            const float dec = __expf(bL);
#pragma unroll
            for (int i = 0; i < 2; ++i) {
                const bf16x8 b0 = ldfrag_tr(Bs, 136, 0, 16 * (2 * wid + i), fr, fq), b1 = ldfrag_tr(Bs, 136, 32, 16 * (2 * wid + i), fr, fq);
#pragma unroll
                for (int nt = 0; nt < NT; ++nt) {
                    accS[i][nt] *= dec;
                    accS[i][nt] = mfma16(b0, ldfrag_tr(XWs, LDX, 0, nt * 16, fr, fq), accS[i][nt]);
                    accS[i][nt] = mfma16(b1, ldfrag_tr(XWs, LDX, 32, nt * 16, fr, fq), accS[i][nt]);
                }
            }
        }
        LSYNC();
#pragma unroll
        for (int i = 0; i < 2; ++i)
#pragma unroll
            for (int nt = 0; nt < NT; ++nt) *(u32x2*)(STs + (nt * 16 + fr) * 136 + 16 * (2 * wid + i) + 4 * fq) = pack4(accS[i][nt]);
    }
    if (!live) return;
    float* So = p.out + (smp ? OFF_SSSD : OFF_PSSD) + (size_t)sidx * 64 * 128;
#pragma unroll
    for (int i = 0; i < 2; ++i)
#pragma unroll
        for (int nt = 0; nt < NT; ++nt) {
            float4 o; o.x = accS[i][nt][0]; o.y = accS[i][nt][1]; o.z = accS[i][nt][2]; o.w = accS[i][nt][3];
            *(float4*)(So + (size_t)(ps * 16 * NT + nt * 16 + fr) * 128 + 16 * (2 * wid + i) + 4 * fq) = o;
        }
}

DI void phase_scan_l0(const Params& p, bf16_t* BIG, const float* gates, char* smem, bool live) {
    if (gridDim.x != 256) {
        for (int it = VB; it < 512; it += NVB) {
            const int k = it & 255;
            if (it < 256) mlstm_chain<1>(p, BIG, gates, k >> 6, (k >> 4) & 3, k & 15, false, smem, live);
            else ssd_chain<1>(p, BIG, gates, k >> 6, (k >> 2) & 15, k & 3, false, smem, live);
        }
    } else {
        const int x = (int)blockIdx.x & 7, y = (int)blockIdx.x >> 3, sub = get_sub();
        if (sub != 0) { for (int i = 0; i < 321; ++i) { asm volatile("" ::: "memory"); __builtin_amdgcn_s_barrier(); } }
        else if (y < 16) { const int chain = x + 8 * (y >> 3); mlstm_chain<2>(p, BIG, gates, chain >> 2, chain & 3, y & 7, false, smem, live); }
        else { const int yy = y - 16; ssd_chain<2>(p, BIG, gates, x >> 1, (x & 1) * 8 + (yy >> 1), yy & 1, false, smem, live); }
    }
    for (int it = 512 + VB; it < 1536; it += NVB) {
        const int k = (it - 512) & 511;
        if (it < 1024) mlstm_chain<1>(p, BIG, gates, k >> 6, (k >> 4) & 3, k & 15, true, smem, live);
        else ssd_chain<1>(p, BIG, gates, k >> 6, (k >> 2) & 15, k & 3, true, smem, live);
    }
}

DI void phase_post_l0(const Params& p, bf16_t* BIG) {
    const int tid_ = get_tid(), lane = tid_ & 63, gw = VB * 4 + (tid_ >> 6), nw = NVB * 4;
    for (int row = gw; row < NTOK; row += nw) {
        bf16_t* rp = BIG + (size_t)row * 5632;
        u32x2 rv[4], ov[4]; u32x4 yv[2];
#pragma unroll
        for (int hd = 0; hd < 4; ++hd) { rv[hd] = *(const u32x2*)(rp + 1024 + hd * 256 + lane * 4); ov[hd] = *(const u32x2*)(rp + 3072 + hd * 256 + lane * 4); }
#pragma unroll
        for (int g = 0; g < 2; ++g) yv[g] = *(const u32x4*)(rp + 2048 + g * 512 + lane * 8);
#pragma unroll
        for (int hd = 0; hd < 4; ++hd) {
            const float x[4] = {lo2f(rv[hd].x), hi2f(rv[hd].x), lo2f(rv[hd].y), hi2f(rv[hd].y)}, o[4] = {lo2f(ov[hd].x), hi2f(ov[hd].x), lo2f(ov[hd].y), hi2f(ov[hd].y)};
            const float ss = wave_sum(x[0] * x[0] + x[1] * x[1] + x[2] * x[2] + x[3] * x[3]);
            const float r = rsqrtf(ss * (1.f / 256.f) + 1e-6f);
            const float4 gg = *(const float4*)(p.in[18] + hd * 256 + lane * 4);
            f32x4 y; y[0] = sigmf(o[0]) * x[0] * r * gg.x; y[1] = sigmf(o[1]) * x[1] * r * gg.y; y[2] = sigmf(o[2]) * x[2] * r * gg.z; y[3] = sigmf(o[3]) * x[3] * r * gg.w;
            *(u32x2*)(rp + 1024 + hd * 256 + lane * 4) = pack4(y);
        }
#pragma unroll
        for (int g = 0; g < 2; ++g) {
            float x[8]; unpack8(yv[g], x);
            float ss = 0.f;
#pragma unroll
            for (int j = 0; j < 8; ++j) ss += x[j] * x[j];
            ss = wave_sum(ss);
            const float r = rsqrtf(ss * (1.f / 512.f) + 1e-6f);
            const float4 g0 = *(const float4*)(p.in[24] + g * 512 + lane * 8), g1 = *(const float4*)(p.in[24] + g * 512 + lane * 8 + 4);
            float y[8] = {x[0] * r * g0.x, x[1] * r * g0.y, x[2] * r * g0.z, x[3] * r * g0.w, x[4] * r * g1.x, x[5] * r * g1.y, x[6] * r * g1.z, x[7] * r * g1.w};
            *(u32x4*)(rp + 2048 + g * 512 + lane * 8) = pack8(y);
        }
    }
}

#define G_QN  0
#define G_KN  18432
#define G_AT  36864
#define G_VN  53504
#define G_TV  0
#define G_TW  9216
#define G_F   71936
DI void gdn_g1_item(const Params& p, bf16_t* BIG, bf16_t* Wb, bf16_t* PB, const float* gates, const bf16_t* halo, float* egl, int unit, int hd, char* smem, bool live) {
    const int tid = get_tid(), wid = tid >> 6, lane = tid & 63, fr = lane & 15, fq = lane >> 4;
    bf16_t* Qn = (bf16_t*)(smem + G_QN); bf16_t* Kn = (bf16_t*)(smem + G_KN);
    bf16_t* Vn = (bf16_t*)(smem + G_VN);
    float* AT = (float*)(smem + G_AT); bf16_t* Tv = (bf16_t*)(smem + G_TV); bf16_t* Tw = (bf16_t*)(smem + G_TW);
    float* beta_s = (float*)(smem + G_F); float* gam_s = beta_s + 64;
    const bool smp = unit >= 256;
    const int L = smp ? 16 : 64, c = unit & 63, s_ = unit - 256;
    const size_t row0 = smp ? (size_t)NPR + s_ * 16 : (size_t)unit * 64;
    const int tok = tid >> 2, qt = tid & 3;
    const float* cw = p.in[27];
    const bf16_t* hp = halo + (size_t)(smp ? 264 + s_ : (unit > 0 ? unit - 1 : 0)) * 3 * 3072;
    const bool zh = !smp && c == 0;
    LSYNC();
    if (wid == 0) {
        float beta = 0.f, g = 0.f;
        const int lc = lane < L ? lane : L - 1;
        const float br = gates[(row0 + lc) * 32 + hd], ar = gates[(row0 + lc) * 32 + 8 + hd];
        if (lane < L) { beta = sigmf(br); g = -__expf(p.in[29][hd]) * softplusf(ar + p.in[28][hd]); }
        const float gam = scan_add(g, lane);
        beta_s[lane] = beta; gam_s[lane] = gam;
        if (lane == L - 1 && live) egl[unit * 8 + hd] = __expf(gam);
    }
    u32x4 xn[16];
    auto g1_issue = [&](int mi) __attribute__((always_inline)) {
#pragma unroll
        for (int j = 0; j < 4; ++j) {
            const int col = mi * 1024 + hd * 128 + j * 32 + qt * 8;
#pragma unroll
            for (int i = 0; i < 4; ++i) {
                const int tc = tok < L ? tok : L - 1, rlc = tc - 3 + i;
                const bf16_t* src = rlc >= 0 ? BIG + (row0 + rlc) * 4096 + col : hp + (rlc + 3) * 3072 + col;
                xn[j * 4 + i] = *(const u32x4*)src;
                if (rlc < 0 && zh) xn[j * 4 + i] = (u32x4){0u, 0u, 0u, 0u};
            }
        }
    };
    g1_issue(0);
#pragma unroll 1
    for (int mi = 0; mi < 3; ++mi) {
        float o[32];
        u32x4 xc[16];
#pragma unroll
        for (int q = 0; q < 16; ++q) xc[q] = xn[q];
        if (mi < 2) g1_issue(mi + 1);
#pragma unroll
        for (int j = 0; j < 4; ++j) {
            const int col = mi * 1024 + hd * 128 + j * 32 + qt * 8;
            float a8[8];
#pragma unroll
            for (int q = 0; q < 8; ++q) a8[q] = 0.f;
#pragma unroll
            for (int i = 0; i < 4; ++i) {
                float xf[8]; unpack8(xc[j * 4 + i], xf);
                const float4 w0 = *(const float4*)(cw + i * 3072 + col), w1 = *(const float4*)(cw + i * 3072 + col + 4);
                a8[0] += w0.x * xf[0]; a8[1] += w0.y * xf[1]; a8[2] += w0.z * xf[2]; a8[3] += w0.w * xf[3];
                a8[4] += w1.x * xf[4]; a8[5] += w1.y * xf[5]; a8[6] += w1.z * xf[6]; a8[7] += w1.w * xf[7];
            }
#pragma unroll
            for (int q = 0; q < 8; ++q) o[j * 8 + q] = siluf(a8[q]);
        }
        if (mi < 2) {
            float ss = 0.f;
#pragma unroll
            for (int q = 0; q < 32; ++q) ss += o[q] * o[q];
            ss += __shfl_xor(ss, 1); ss += __shfl_xor(ss, 2);
            const float sc = rsqrtf(ss + 1e-6f) * (mi == 0 ? 0.08838834764831845f : 1.f);
#pragma unroll
            for (int q = 0; q < 32; ++q) o[q] *= sc;
        }
        if (tok >= L) {
#pragma unroll
            for (int q = 0; q < 32; ++q) o[q] = 0.f;
        }
        bf16_t* dst = (mi == 0 ? Qn : (mi == 1 ? Kn : Vn)) + tok * 136 + qt * 8;
#pragma unroll
        for (int j = 0; j < 4; ++j) *(u32x4*)(dst + j * 32) = pack8(o + j * 8);
    }
    LSYNC();
    {
        f32x4 a4[4], p4[4];
#pragma unroll
        for (int nt = 0; nt < 4; ++nt) { a4[nt] = (f32x4){0.f, 0.f, 0.f, 0.f}; p4[nt] = a4[nt]; }
#pragma unroll 1
        for (int kk = 0; kk < 4; ++kk) {
            const bf16x8 qf = ldfrag(Qn, 136, 16 * wid + fr, kk * 32 + fq * 8), ksf = ldfrag(Kn, 136, 16 * wid + fr, kk * 32 + fq * 8);
#pragma unroll
            for (int nt = 0; nt < 4; ++nt) { const bf16x8 kf = ldfrag(Kn, 136, 16 * nt + fr, kk * 32 + fq * 8); a4[nt] = mfma16(kf, ksf, a4[nt]); p4[nt] = mfma16(kf, qf, p4[nt]); }
        }
        const int s = 16 * wid + fr; const float gs = gam_s[s], bsv = beta_s[s];
#pragma unroll
        for (int nt = 0; nt < 4; ++nt) {
            f32x4 pv;
#pragma unroll
            for (int j = 0; j < 4; ++j) {
                const int r = 16 * nt + 4 * fq + j;
                const float d = (r <= s) ? __expf(gs - gam_s[r]) : 0.f;
                pv[j] = p4[nt][j] * d;
                AT[s * 65 + r] = (r < s) ? a4[nt][j] * d * bsv : 0.f;
            }
            if (s < L && live) *(u32x2*)(PB + (row0 + s) * 512 + hd * 64 + 16 * nt + 4 * fq) = pack4(pv);
        }
    }
    LSYNC();
    if (tok < L && live) {
        const float eg = __expf(gam_s[tok]);
#pragma unroll
        for (int j = 0; j < 4; ++j) {
            float qf8[8]; unpack8(*(const u32x4*)(Qn + tok * 136 + qt * 32 + j * 8), qf8);
#pragma unroll
            for (int q = 0; q < 8; ++q) qf8[q] *= eg;
            *(u32x4*)(BIG + (row0 + tok) * 4096 + hd * 128 + qt * 32 + j * 8) = pack8(qf8);
        }
    }
    LSYNC();
    {
        if (lane < 16) {
            const int o = 16 * wid; float t[16];
#pragma unroll
            for (int s = 0; s < 16; ++s) {
                float acc = (s == lane) ? 1.f : 0.f;
#pragma unroll
                for (int r = 0; r < s; ++r) acc -= AT[(o + s) * 65 + o + r] * t[r];
                t[s] = acc;
            }
#pragma unroll
            for (int s = 0; s < 16; ++s) AT[(o + s) * 65 + o + lane] = t[s];
        }
        LSYNC();
        {
            f32x4 bacc[2];
#pragma unroll
            for (int bb = 0; bb < 2; ++bb) {
                const int blk = wid + 4 * bb;
                bacc[bb] = (f32x4){0.f, 0.f, 0.f, 0.f};
                if (blk < 6) {
                    const int i = blk == 0 ? 1 : (blk < 3 ? 2 : 3), jb = blk == 0 ? 0 : (blk < 3 ? blk - 1 : blk - 3);
#pragma unroll
                    for (int kq = 0; kq < 4; ++kq)
                        bacc[bb] = __builtin_amdgcn_mfma_f32_16x16x4f32(AT[(16 * i + fr) * 65 + 16 * i + 4 * kq + fq], AT[(16 * i + 4 * kq + fq) * 65 + 16 * jb + fr], bacc[bb], 0, 0, 0);
                }
            }
            LSYNC();
#pragma unroll
            for (int bb = 0; bb < 2; ++bb) {
                const int blk = wid + 4 * bb;
                if (blk < 6) {
                    const int i = blk == 0 ? 1 : (blk < 3 ? 2 : 3), jb = blk == 0 ? 0 : (blk < 3 ? blk - 1 : blk - 3);
#pragma unroll
                    for (int jj = 0; jj < 4; ++jj) AT[(16 * i + 4 * fq + jj) * 65 + 16 * jb + fr] = bacc[bb][jj];
                }
            }
            LSYNC();
        }
#pragma unroll
        for (int i = 1; i < 4; ++i) {
            f32x4 tacc = (f32x4){0.f, 0.f, 0.f, 0.f};
            if (wid < i) {
                for (int m0 = 16 * wid; m0 < 16 * i; m0 += 4)
                    tacc = __builtin_amdgcn_mfma_f32_16x16x4f32(AT[(16 * i + fr) * 65 + m0 + fq], AT[(m0 + fq) * 65 + 16 * wid + fr], tacc, 0, 0, 0);
            }
            LSYNC();
            if (wid < i) {
#pragma unroll
                for (int jj = 0; jj < 4; ++jj) AT[(16 * i + 4 * fq + jj) * 65 + 16 * wid + fr] = -tacc[jj];
            }
            LSYNC();
        }
        const int s = tid >> 2, j0 = (tid & 3) * 16;
#pragma unroll
        for (int jj = 0; jj < 16; ++jj) {
            const int j = j0 + jj; const float t = AT[s * 65 + j], bj = beta_s[j];
            Tv[s * 72 + j] = f2bf(t * bj); Tw[s * 72 + j] = f2bf(t * bj * __expf(gam_s[j]));
        }
    }
    LSYNC();
    {
        const int s = 16 * wid + fr;
        const bf16x8 tw0 = ldfrag(Tw, 72, s, fq * 8), tw1 = ldfrag(Tw, 72, s, 32 + fq * 8), tv0 = ldfrag(Tv, 72, s, fq * 8), tv1 = ldfrag(Tv, 72, s, 32 + fq * 8);
#pragma unroll 2
        for (int nt = 0; nt < 8; ++nt) {
            f32x4 w4 = (f32x4){0.f, 0.f, 0.f, 0.f}, u4 = w4;
            w4 = mfma16(ldfrag_tr(Kn, 136, 0, 16 * nt, fr, fq), tw0, w4); w4 = mfma16(ldfrag_tr(Kn, 136, 32, 16 * nt, fr, fq), tw1, w4);
            u4 = mfma16(ldfrag_tr(Vn, 136, 0, 16 * nt, fr, fq), tv0, u4); u4 = mfma16(ldfrag_tr(Vn, 136, 32, 16 * nt, fr, fq), tv1, u4);
            if (s < L && live) {
                *(u32x2*)(Wb + (row0 + s) * 1024 + hd * 128 + 16 * nt + 4 * fq) = pack4(w4);
                *(u32x2*)(BIG + (row0 + s) * 4096 + 2048 + hd * 128 + 16 * nt + 4 * fq) = pack4(u4);
            }
        }
        const float gL = gam_s[L - 1];
#pragma unroll
        for (int ci = 0; ci < 2; ++ci)
#pragma unroll
            for (int kk = 0; kk < 2; ++kk) {
                const int cc = 2 * wid + ci, rb = 32 * kk + 8 * fq, d = 16 * cc + fr;
                const bf16x8 kf8 = ldfrag_tr(Kn, 136, 32 * kk, 16 * cc, fr, fq);
                if (rb < L && live) {
                    float kf[8]; unpack8(__builtin_bit_cast(u32x4, kf8), kf);
#pragma unroll
                    for (int q = 0; q < 8; ++q) kf[q] *= __expf(gL - gam_s[rb + q]);
                    const int e = d * L + rb;
                    *(u32x4*)(BIG + (row0 + (e >> 7)) * 4096 + 1024 + hd * 128 + (e & 127)) = pack8(kf);
                }
            }
        if ((smp || c == 63) && tid < 144 && live) {
            const int i = tid / 48, rem = tid % 48, col = (rem >> 4) * 1024 + hd * 128 + (rem & 15) * 8;
            float f[8]; unpack8(*(const u32x4*)(halo + ((size_t)unit * 3 + i) * 3072 + col), f);
            float* dst = smp ? p.out + OFF_SGC + ((size_t)s_ * 3 + i) * 3072 + col : p.out + OFF_PGC + ((size_t)(unit >> 6) * 3 + i) * 3072 + col;
            *(float4*)dst = make_float4(f[0], f[1], f[2], f[3]); *(float4*)(dst + 4) = make_float4(f[4], f[5], f[6], f[7]);
        }
    }
}

struct GdnFrags { bf16x8 w[4], q[4], p[2], kt[2][2]; u32x2 u0[2]; float eg; };
DI void gdn_chain(const Params& p, bf16_t* BIG, const bf16_t* Wb, const bf16_t* PB, const float* egl, int b, int hd, int es, bool smp, char* smem, bool live) {
    const int tid = get_tid(), wid = tid >> 6, lane = tid & 63, fr = lane & 15, fq = lane >> 4;
    bf16_t* UT0 = (bf16_t*)smem;
    bf16_t* ST0 = (bf16_t*)(smem + 9216);
    const int L = smp ? 16 : 64, nch = smp ? 1 : 64, sidx = b * 8 + hd;
    const size_t row0 = smp ? (size_t)NPR + b * 16 : (size_t)b * 4096;
    const bf16x8 z8 = (bf16x8){0, 0, 0, 0, 0, 0, 0, 0};
    f32x4 accS[2][2];
#pragma unroll
    for (int mt = 0; mt < 2; ++mt)
#pragma unroll
        for (int nt = 0; nt < 2; ++nt) accS[mt][nt] = (f32x4){0.f, 0.f, 0.f, 0.f};
    if (smp) {
        const float* S0 = p.in[7] + (size_t)sidx * 128 * 128;
#pragma unroll
        for (int mt = 0; mt < 2; ++mt)
#pragma unroll
            for (int nt = 0; nt < 2; ++nt)
#pragma unroll
                for (int j = 0; j < 4; ++j) accS[mt][nt][j] = S0[(size_t)(32 * wid + 16 * mt + 4 * fq + j) * 128 + es * 32 + nt * 16 + fr];
    }
    LSYNC();
#pragma unroll
    for (int mt = 0; mt < 2; ++mt)
#pragma unroll
        for (int nt = 0; nt < 2; ++nt) *(u32x2*)(ST0 + (nt * 16 + fr) * 136 + 32 * wid + 16 * mt + 4 * fq) = pack4(accS[mt][nt]);
    const int s = 16 * wid + fr, sc_ = s < L ? s : L - 1;
    const bool valid = s < L;
    auto load = [&](int c, GdnFrags& F) __attribute__((always_inline)) {
        const size_t r0 = row0 + (size_t)c * 64;
        const bf16_t* wp = Wb + (r0 + sc_) * 1024 + hd * 128 + fq * 8;
        const bf16_t* qp = BIG + (r0 + sc_) * 4096 + hd * 128 + fq * 8;
        const bf16_t* pp = PB + (r0 + sc_) * 512 + hd * 64 + fq * 8;
#pragma unroll
        for (int kk = 0; kk < 4; ++kk) { F.w[kk] = *(const bf16x8*)(wp + kk * 32); F.q[kk] = *(const bf16x8*)(qp + kk * 32); if (!valid) { F.w[kk] = z8; F.q[kk] = z8; } }
#pragma unroll
        for (int kk = 0; kk < 2; ++kk) { F.p[kk] = *(const bf16x8*)(pp + kk * 32); if (!valid) F.p[kk] = z8; }
#pragma unroll
        for (int mt = 0; mt < 2; ++mt)
#pragma unroll
            for (int kk = 0; kk < 2; ++kk) {
                const int d = 32 * wid + 16 * mt + fr, r = kk * 32 + fq * 8, rc = r < L ? r : 0, e = d * L + rc;
                F.kt[mt][kk] = *(const bf16x8*)(BIG + (r0 + (e >> 7)) * 4096 + 1024 + hd * 128 + (e & 127));
                if (r >= L) F.kt[mt][kk] = z8;
            }
#pragma unroll
        for (int nt = 0; nt < 2; ++nt) {
            F.u0[nt] = *(const u32x2*)(BIG + (r0 + sc_) * 4096 + 2048 + hd * 128 + es * 32 + nt * 16 + 4 * fq);
            if (!valid) F.u0[nt] = (u32x2){0u, 0u};
        }
        F.eg = egl[(smp ? 256 + b : b * 64 + c) * 8 + hd];
    };
    auto step = [&](int c, const GdnFrags& cur) __attribute__((always_inline)) {
        const bf16_t* STc = ST0 + (c & 1) * (32 * 136); bf16_t* STn = ST0 + ((c + 1) & 1) * (32 * 136);
        bf16_t* UTc = UT0 + (c & 1) * (32 * 72);
        bf16x8 sf[2][4];
#pragma unroll
        for (int nt = 0; nt < 2; ++nt)
#pragma unroll
            for (int kk = 0; kk < 4; ++kk) sf[nt][kk] = ldfrag(STc, 136, nt * 16 + fr, kk * 32 + fq * 8);
#pragma unroll
        for (int nt = 0; nt < 2; ++nt) {
            f32x4 w4 = (f32x4){0.f, 0.f, 0.f, 0.f};
#pragma unroll
            for (int kk = 0; kk < 4; ++kk) w4 = mfma16(sf[nt][kk], cur.w[kk], w4);
            const float uf[4] = {lo2f(cur.u0[nt].x) - w4[0], hi2f(cur.u0[nt].x) - w4[1], lo2f(cur.u0[nt].y) - w4[2], hi2f(cur.u0[nt].y) - w4[3]};
#pragma unroll
            for (int j = 0; j < 4; ++j) UTc[(nt * 16 + 4 * fq + j) * 72 + s] = f2bf(uf[j]);
        }
        LSYNC();
        {
            bf16x8 uf8[2][2];
#pragma unroll
            for (int nt = 0; nt < 2; ++nt) {
                f32x4 o4 = (f32x4){0.f, 0.f, 0.f, 0.f};
#pragma unroll
                for (int kk = 0; kk < 4; ++kk) o4 = mfma16(sf[nt][kk], cur.q[kk], o4);
#pragma unroll
                for (int kk = 0; kk < 2; ++kk) { uf8[nt][kk] = ldfrag(UTc, 72, nt * 16 + fr, kk * 32 + fq * 8); o4 = mfma16(uf8[nt][kk], cur.p[kk], o4); }
                if (valid && live) *(u32x2*)(BIG + (row0 + (size_t)c * 64 + s) * 4096 + 2048 + hd * 128 + es * 32 + nt * 16 + 4 * fq) = pack4(o4);
            }
#pragma unroll
            for (int mt = 0; mt < 2; ++mt)
#pragma unroll
                for (int nt = 0; nt < 2; ++nt) {
                    accS[mt][nt] *= cur.eg;
#pragma unroll
                    for (int kk = 0; kk < 2; ++kk) accS[mt][nt] = mfma16(cur.kt[mt][kk], uf8[nt][kk], accS[mt][nt]);
                    *(u32x2*)(STn + (nt * 16 + fr) * 136 + 32 * wid + 16 * mt + 4 * fq) = pack4(accS[mt][nt]);
                }
        }
        LSYNC();
    };
    GdnFrags fa, fb; load(0, fa); fb = fa;
    if (nch > 1) load(1, fb);
    LSYNC();
    for (int c = 0; c < nch; c += 2) {
        step(c, fa);
        if (c + 2 < nch) load(c + 2, fa);
        if (c + 1 < nch) { step(c + 1, fb); if (c + 3 < nch) load(c + 3, fb); }
    }
    if (!live) return;
    float* So = p.out + (smp ? OFF_SG : OFF_PG) + (size_t)sidx * 128 * 128;
#pragma unroll
    for (int mt = 0; mt < 2; ++mt)
#pragma unroll
        for (int nt = 0; nt < 2; ++nt)
#pragma unroll
            for (int j = 0; j < 4; ++j) So[(size_t)(32 * wid + 16 * mt + 4 * fq + j) * 128 + es * 32 + nt * 16 + fr] = accS[mt][nt][j];
}

DI void phase_post_l1(const Params& p, bf16_t* BIG) {
    const int tid_ = get_tid(), lane = tid_ & 63, gw = VB * 4 + (tid_ >> 6), nw = NVB * 4;
    const int hd = lane >> 3, e0 = (lane & 7) * 16;
    for (int row = gw; row < NTOK; row += nw) {
        bf16_t* op = BIG + (size_t)row * 4096 + 2048 + hd * 128 + e0;
        const bf16_t* zp = BIG + (size_t)row * 4096 + 3072 + hd * 128 + e0;
        float x[16], z[16];
        unpack8(*(const u32x4*)op, x); unpack8(*(const u32x4*)(op + 8), x + 8);
        unpack8(*(const u32x4*)zp, z); unpack8(*(const u32x4*)(zp + 8), z + 8);
        float ss = 0.f;
#pragma unroll
        for (int j = 0; j < 16; ++j) ss += x[j] * x[j];
        ss += __shfl_xor(ss, 1); ss += __shfl_xor(ss, 2); ss += __shfl_xor(ss, 4);
        const float r = rsqrtf(ss * (1.f / 128.f) + 1e-6f);
        float y[16];
#pragma unroll
        for (int j = 0; j < 16; ++j) y[j] = x[j] * r * p.in[30][e0 + j] * siluf(z[j]);
        *(u32x4*)op = pack8(y); *(u32x4*)(op + 8) = pack8(y + 8);
    }
}

__global__ void __launch_bounds__(512, 2) fwd_megakernel(Params p) {
    __shared__ __attribute__((aligned(16))) char smem_all[LDS_BYTES];
    char* smem = smem_all + get_sub() * LDS_SUB;
    cg::grid_group grid = cg::this_grid();
    char* ws = p.ws;
    if (ws == nullptr) grid.sync();
    if (threadIdx.x < 4) ((volatile LAS unsigned*)(smem_all + LDS_BYTES - 16))[threadIdx.x] = 0u;
    __syncthreads();
    const XcdBarrier xb = xcd_barrier_post((unsigned*)(ws + WS_BAR), (volatile LAS unsigned*)(smem_all + LDS_BYTES - 16));
    bf16_t* WGU = (bf16_t*)(ws + WS_WGU); bf16_t* WD = (bf16_t*)(ws + WS_WD); bf16_t* WIN = (bf16_t*)(ws + WS_WIN); bf16_t* WOUT = (bf16_t*)(ws + WS_WOUT);
    bf16_t* H = (bf16_t*)(ws + WS_H); bf16_t* BIG = (bf16_t*)(ws + WS_BIG); float* GATES = (float*)(ws + WS_GATES); bf16_t* HALO = (bf16_t*)(ws + WS_HALO); float* EGL = (float*)(ws + WS_EGL);
    bf16_t* PB = BIG + (size_t)NTOK * 4096;
    float* X = p.out; float* XS = p.out + (size_t)NPR * 1024;
    const float* ng = p.in[9];
    const size_t FW = (size_t)1024 * 2816;
    Epi e{};
    phase_norm(p.in[0], p.in[1], ng, H);
    for (int i = VB * 256 + get_tid(); i < 128 * 1024 / 4; i += NVB * 256) ((float4*)XS)[i] = ((const float4*)p.in[1])[i];
    cvt_job(p.in[11], 1024, 2816, WGU, 1, 0, smem);
    cvt_job(p.in[12], 1024, 2816, WGU, 2, 100, smem);
    cvt_job(p.in[13], 2816, 1024, WD, 0, 200, smem);
    cvt_job(p.in[14], 1024, 5656, WIN, 3, 300, smem);
    cvt_job(p.in[15], 2048, 1024, WOUT, 0, 400, smem);
    xcd_barrier(xb);
    e.o16 = BIG; e.ldc = 2816;
    { PEpiGU pe; pe.O = BIG; gemm_big(H, 1024, WGU, 1024, 5632, pe, smem_all); }
    gemm_tail<EPI_GU>(H, 1024, WGU, 1024, 44, e, smem);
    xcd_barrier(xb);
    e.o32 = X; e.rp = p.in[0]; e.rs = p.in[1]; e.scale = 0.5f;
    { PEpiRES pe; pe.X = X; pe.R = e.rp; pe.scale = e.scale; gemm_big(BIG, 2816, WD, 2816, 1024, pe, smem_all); }
    gemm_tail<EPI_RES>(BIG, 2816, WD, 2816, 8, e, smem);
    xcd_barrier(xb);
    phase_norm(X, XS, ng + 1024, H);
    cvt_job(p.in[11] + FW, 1024, 2816, WGU, 1, 0, smem);
    cvt_job(p.in[12] + FW, 1024, 2816, WGU, 2, 100, smem);
    cvt_job(p.in[13] + FW, 2816, 1024, WD, 0, 200, smem);
    xcd_barrier(xb);
    e.o16 = BIG; e.ldc = 5632; e.gates = GATES; e.halo = HALO; e.cv0 = 4096; e.cv1 = 5632;
    { PEpiPROJ pe; pe.O = BIG; pe.ldc = 5632; pe.halo = HALO; pe.cv0 = 4096; pe.cv1 = 5632; gemm_big(H, 1024, WIN, 1024, 5632, pe, smem_all); }
    gemm_tail<EPI_PROJ>(H, 1024, WIN, 1024, 45, e, smem);
    xcd_barrier(xb);
#if PHM & 1
    phase_conv_ssd(p, BIG, HALO);
#endif
    xcd_barrier(xb);
#if PHM & 2
#ifdef PROBE_L0
    phase_scan_l0(p, BIG, GATES, smem, p.ws == nullptr);
    xcd_barrier(xb);
#endif
    phase_scan_l0(p, BIG, GATES, smem, true);
#endif
    xcd_barrier(xb);
    phase_post_l0(p, BIG);
    xcd_barrier(xb);
    e.o32 = X; e.rp = X; e.rs = XS; e.scale = 1.0f;
    { PEpiRES pe; pe.X = X; pe.R = e.rp; pe.scale = e.scale; gemm_big(BIG + 1024, 5632, WOUT, 2048, 1024, pe, smem_all); }
    gemm_tail<EPI_RES>(BIG + 1024, 5632, WOUT, 2048, 8, e, smem);
    xcd_barrier(xb);
    phase_norm(X, XS, ng + 2048, H);
    xcd_barrier(xb);
    e.o16 = BIG; e.ldc = 2816;
    { PEpiGU pe; pe.O = BIG; gemm_big(H, 1024, WGU, 1024, 5632, pe, smem_all); }
    gemm_tail<EPI_GU>(H, 1024, WGU, 1024, 44, e, smem);
    xcd_barrier(xb);
    e.scale = 0.5f;
    { PEpiRES pe; pe.X = X; pe.R = e.rp; pe.scale = e.scale; gemm_big(BIG, 2816, WD, 2816, 1024, pe, smem_all); }
    gemm_tail<EPI_RES>(BIG, 2816, WD, 2816, 8, e, smem);
    xcd_barrier(xb);
    phase_norm(X, XS, ng + 3072, H);
    cvt_job(p.in[11] + 2 * FW, 1024, 2816, WGU, 1, 0, smem);
    cvt_job(p.in[12] + 2 * FW, 1024, 2816, WGU, 2, 100, smem);
    cvt_job(p.in[13] + 2 * FW, 2816, 1024, WD, 0, 200, smem);
    cvt_job(p.in[25], 1024, 4112, WIN, 0, 300, smem);
    cvt_job(p.in[26], 1024, 1024, WOUT, 0, 400, smem);
    xcd_barrier(xb);
    { PEpiGU pe; pe.O = BIG; gemm_big(H, 1024, WGU, 1024, 5632, pe, smem_all); }
    gemm_tail<EPI_GU>(H, 1024, WGU, 1024, 44, e, smem);
    xcd_barrier(xb);
    { PEpiRES pe; pe.X = X; pe.R = e.rp; pe.scale = e.scale; gemm_big(BIG, 2816, WD, 2816, 1024, pe, smem_all); }
    gemm_tail<EPI_RES>(BIG, 2816, WD, 2816, 8, e, smem);
    xcd_barrier(xb);
    phase_norm(X, XS, ng + 4096, H);
    fill_cache_halo(p.in[8], 3072, HALO);
    cvt_job(p.in[11] + 3 * FW, 1024, 2816, WGU, 1, 0, smem);
    cvt_job(p.in[12] + 3 * FW, 1024, 2816, WGU, 2, 100, smem);
    cvt_job(p.in[13] + 3 * FW, 2816, 1024, WD, 0, 200, smem);
    xcd_barrier(xb);
    e.o16 = BIG; e.ldc = 4096; e.cv0 = 0; e.cv1 = 3072;
    { PEpiPROJ pe; pe.O = BIG; pe.ldc = 4096; pe.halo = HALO; pe.cv0 = 0; pe.cv1 = 3072; gemm_big(H, 1024, WIN, 1024, 4096, pe, smem_all); }
    gemm_tail<EPI_PROJ>(H, 1024, WIN, 1024, 33, e, smem);
    xcd_barrier(xb);
#if PHM & 4
#ifdef PROBE_G1
    for (int it = VB; it < 264 * 8; it += NVB) gdn_g1_item(p, BIG, H, PB, GATES, HALO, EGL, it >> 3, it & 7, smem, p.ws == nullptr);
    xcd_barrier(xb);
#endif
    for (int it = VB; it < (gridDim.x == 256 ? 256 : 264) * 8; it += NVB) gdn_g1_item(p, BIG, H, PB, GATES, HALO, EGL, it >> 3, it & 7, smem, true);
#endif
    xcd_barrier(xb);
#if PHM & 8
#ifdef PROBE_GDN
    { const bool glive = (p.ws == nullptr);
    if (gridDim.x != 256) {
        for (int it = VB; it < 384; it += NVB) {
            const bool smp = it >= 128; const int j = smp ? it - 128 : it;
            gdn_chain(p, BIG, H, PB, EGL, j >> 5, (j >> 2) & 7, j & 3, smp, smem, glive);
        }
    } else {
        const int x = (int)blockIdx.x & 7, y = (int)blockIdx.x >> 3, sub = get_sub();
        if (y < 16) {
            if (sub == 0) gdn_chain(p, BIG, H, PB, EGL, y >> 2, x, y & 3, false, smem, glive);
            else for (int i = 0; i < 130; ++i) { asm volatile("" ::: "memory"); __builtin_amdgcn_s_barrier(); }
        }
        else if (y < 20) {
            const int v = (y - 16) * 16 + x * 2 + sub, sidx = v >> 3, shd = v & 7;
            gdn_g1_item(p, BIG, H, PB, GATES, HALO, EGL, 256 + sidx, shd, smem, glive);
            asm volatile("s_waitcnt vmcnt(0)" ::: "memory");
            __builtin_amdgcn_fence(__ATOMIC_RELEASE, "agent");
            __builtin_amdgcn_fence(__ATOMIC_ACQUIRE, "agent");
            asm volatile("s_waitcnt vmcnt(0)" ::: "memory");
            __builtin_amdgcn_s_barrier();
            for (int e4 = 0; e4 < 4; ++e4) gdn_chain(p, BIG, H, PB, EGL, sidx, shd, e4, true, smem, glive);
        }
    }
    }
    xcd_barrier(xb);
#endif
    { const bool glive = true;
    if (gridDim.x != 256) {
        for (int it = VB; it < 384; it += NVB) {
            const bool smp = it >= 128; const int j = smp ? it - 128 : it;
            gdn_chain(p, BIG, H, PB, EGL, j >> 5, (j >> 2) & 7, j & 3, smp, smem, glive);
        }
    } else {
        const int x = (int)blockIdx.x & 7, y = (int)blockIdx.x >> 3, sub = get_sub();
        if (y < 16) {
            if (sub == 0) gdn_chain(p, BIG, H, PB, EGL, y >> 2, x, y & 3, false, smem, glive);
            else for (int i = 0; i < 130; ++i) { asm volatile("" ::: "memory"); __builtin_amdgcn_s_barrier(); }
        }
        else if (y < 20) {
            const int v = (y - 16) * 16 + x * 2 + sub, sidx = v >> 3, shd = v & 7;
            gdn_g1_item(p, BIG, H, PB, GATES, HALO, EGL, 256 + sidx, shd, smem, glive);
            asm volatile("s_waitcnt vmcnt(0)" ::: "memory");
            __builtin_amdgcn_fence(__ATOMIC_RELEASE, "agent");
            __builtin_amdgcn_fence(__ATOMIC_ACQUIRE, "agent");
            asm volatile("s_waitcnt vmcnt(0)" ::: "memory");
            __builtin_amdgcn_s_barrier();
            for (int e4 = 0; e4 < 4; ++e4) gdn_chain(p, BIG, H, PB, EGL, sidx, shd, e4, true, smem, glive);
        }
    }
    }
#endif
    xcd_barrier(xb);
    phase_post_l1(p, BIG);
    xcd_barrier(xb);
    e.scale = 1.0f;
    { PEpiRES pe; pe.X = X; pe.R = e.rp; pe.scale = e.scale; gemm_big(BIG + 2048, 4096, WOUT, 1024, 1024, pe, smem_all); }
    gemm_tail<EPI_RES>(BIG + 2048, 4096, WOUT, 1024, 8, e, smem);
    xcd_barrier(xb);
    phase_norm(X, XS, ng + 5120, H);
    xcd_barrier(xb);
    e.o16 = BIG; e.ldc = 2816;
    { PEpiGU pe; pe.O = BIG; gemm_big(H, 1024, WGU, 1024, 5632, pe, smem_all); }
    gemm_tail<EPI_GU>(H, 1024, WGU, 1024, 44, e, smem);
    xcd_barrier(xb);
    e.scale = 0.5f;
    { PEpiRES pe; pe.X = X; pe.R = e.rp; pe.scale = e.scale; gemm_big(BIG, 2816, WD, 2816, 1024, pe, smem_all); }
    gemm_tail<EPI_RES>(BIG, 2816, WD, 2816, 8, e, smem);
    xcd_barrier(xb);
    phase_final_norm(X, p.in[10]);
}

extern "C" void kernel_launch(void* const* d_in, const int* in_sizes, int n_in, void* d_out, int out_size, void* d_ws, size_t ws_size, hipStream_t stream) {
    static int grid_blocks = 0;
    if (!grid_blocks) {
        int dev = 0, cus = 0, per_cu = 0;
        hipGetDevice(&dev);
        hipDeviceGetAttribute(&cus, hipDeviceAttributeMultiprocessorCount, dev);
        hipOccupancyMaxActiveBlocksPerMultiprocessor(&per_cu, fwd_megakernel, 512, 0);
        if (per_cu > 1) per_cu = 1;
        if (per_cu < 1) per_cu = 1;
        grid_blocks = cus * per_cu;
    }
    Params p{};
    for (int i = 0; i < 31; ++i) p.in[i] = (const float*)d_in[i];
    p.out = (float*)d_out;
    p.ws = (char*)d_ws;
    (void)hipMemsetAsync((char*)d_ws + WS_BAR, 0, 16384, stream);
    void* args[] = {&p};
    hipError_t err = hipLaunchCooperativeKernel((void*)fwd_megakernel, dim3(grid_blocks), dim3(512), args, 0, stream);
    if (err != hipSuccess) fprintf(stderr, "cooperative launch failed: %s (grid %d)\n", hipGetErrorString(err), grid_blocks);
}
```

```cpp
#include <hip/hip_runtime.h>
#include <hip/hip_cooperative_groups.h>
#include <cstdio>
namespace cg = cooperative_groups;

typedef unsigned short bf16_t;
typedef short bf16x8 __attribute__((ext_vector_type(8)));
typedef float f32x4 __attribute__((ext_vector_type(4)));
typedef unsigned u32x2 __attribute__((ext_vector_type(2)));
typedef unsigned u32x4 __attribute__((ext_vector_type(4)));

#define DI __device__ __forceinline__
#define NTOK 16512
#define NPR 16384
#define LDS_SUB 75776
#define LDS_BYTES (2 * LDS_SUB + 16)
#ifndef PHM
#define PHM 15
#endif

#define WS_WGU   0ull
#define WS_WD    (WS_WGU + 5632ull * 1024 * 2)
#define WS_WIN   (WS_WD + 1024ull * 2816 * 2)
#define WS_WOUT  (WS_WIN + 5760ull * 1024 * 2)
#define WS_H     (WS_WOUT + 1024ull * 2048 * 2)
#define WS_BIG   (WS_H + 16512ull * 1024 * 2)
#define WS_GATES (WS_BIG + 16512ull * 5632 * 2)
#define WS_HALO  (WS_GATES + 16512ull * 32 * 4)
#define WS_EGL   (WS_HALO + 272ull * 3 * 3072 * 2)
#define WS_BAR   (WS_EGL + 272ull * 8 * 4)
#define WS_END   (WS_BAR + 16384ull)

struct Params {
    const float* in[31];
    float* out;
    char* ws;
};

DI int get_tid() { int t = threadIdx.x & 255; asm volatile("" : "+v"(t)); return t; }
DI int get_sub() { return __builtin_amdgcn_readfirstlane((int)(threadIdx.x >> 8)); }
#define VB ((int)blockIdx.x * 2 + get_sub())
#define NVB ((int)gridDim.x * 2)
typedef __bf16 hwbf16x2 __attribute__((ext_vector_type(2)));
typedef float hwf32x2 __attribute__((ext_vector_type(2)));
DI unsigned pack2(float lo, float hi) { hwf32x2 v = {lo, hi}; hwbf16x2 b = __builtin_convertvector(v, hwbf16x2); return __builtin_bit_cast(unsigned, b); }
DI bf16_t f2bf(float f) { return (bf16_t)(pack2(f, f) & 0xffffu); }
DI float bf2f(bf16_t h) { return __uint_as_float(((unsigned)h) << 16); }
DI float lo2f(unsigned u) { return __uint_as_float(u << 16); }
DI float hi2f(unsigned u) { return __uint_as_float(u & 0xffff0000u); }
DI float siluf(float x) { return x * __builtin_amdgcn_rcpf(1.f + __expf(-x)); }
DI float sigmf(float x) { return __builtin_amdgcn_rcpf(1.f + __expf(-x)); }
DI float softplusf(float x) { return fmaxf(x, 0.f) + log1pf(__expf(-fabsf(x))); }
DI f32x4 mfma16(bf16x8 a, bf16x8 b, f32x4 c) { return __builtin_amdgcn_mfma_f32_16x16x32_bf16(a, b, c, 0, 0, 0); }
DI bf16x8 ldfrag(const bf16_t* base, int ld, int row, int k) { return *(const bf16x8*)(base + row * ld + k); }
typedef short s16x4 __attribute__((ext_vector_type(4)));
DI bf16x8 ldfrag_tr(const bf16_t* T, int ld, int k0, int c0, int fr, int fq) {
    const bf16_t* p0 = T + (k0 + 8 * fq + (fr >> 2)) * ld + c0 + 4 * (fr & 3);
    const s16x4 a = __builtin_amdgcn_ds_read_tr16_b64_v4i16((__attribute__((address_space(3))) s16x4*)p0);
    const s16x4 b = __builtin_amdgcn_ds_read_tr16_b64_v4i16((__attribute__((address_space(3))) s16x4*)(p0 + 4 * ld));
    return (bf16x8){a[0], a[1], a[2], a[3], b[0], b[1], b[2], b[3]};
}
DI void unpack8(u32x4 v, float* f) {
    f[0] = lo2f(v.x); f[1] = hi2f(v.x); f[2] = lo2f(v.y); f[3] = hi2f(v.y);
    f[4] = lo2f(v.z); f[5] = hi2f(v.z); f[6] = lo2f(v.w); f[7] = hi2f(v.w);
}
DI u32x4 pack8(const float* f) { u32x4 o; o.x = pack2(f[0], f[1]); o.y = pack2(f[2], f[3]); o.z = pack2(f[4], f[5]); o.w = pack2(f[6], f[7]); return o; }
DI u32x2 pack4(f32x4 v) { u32x2 o; o.x = pack2(v[0], v[1]); o.y = pack2(v[2], v[3]); return o; }
DI float wave_sum(float v) {
#pragma unroll
    for (int o = 32; o >= 1; o >>= 1) v += __shfl_xor(v, o);
    return v;
}


#define XB_TMO      128
#define XB_XCNT(j)  (256  + 64 * (j))
#define XB_XSUB(j)  (1280 + 64 * (j))
#define XB_XGEN(j)  (2304 + 64 * (j))
#define XB_TOP      3328
#define XB_TOPGEN   3392
#define XCD_BAR_WORDS 3456
#define XB_SPIN_CAP (1u << 18)
#define LAS __attribute__((address_space(3)))
DI unsigned xb_ld(unsigned* p)              { return __hip_atomic_load(p, __ATOMIC_RELAXED, __HIP_MEMORY_SCOPE_AGENT); }
DI unsigned xb_add(unsigned* p, unsigned v) { return __hip_atomic_fetch_add(p, v, __ATOMIC_RELAXED, __HIP_MEMORY_SCOPE_AGENT); }
DI unsigned xb_xcc_id() { return (unsigned)__builtin_amdgcn_s_getreg((3 << 11) | 20) & 0xFu; }
#define XB_SPIN(cond, bar) do { unsigned _sp = 0; while (cond) { __builtin_amdgcn_s_sleep(1); \
    if ((++_sp & 255u) == 0u) { if (xb_ld(&(bar)[XB_TMO])) break; if (_sp > XB_SPIN_CAP) { atomicAdd(&(bar)[XB_TMO], 1u); break; } } } } while (0)
struct XcdBarrier { unsigned* bar; unsigned x; volatile LAS unsigned* st; };
DI XcdBarrier xcd_barrier_post(unsigned* bar, volatile LAS unsigned* st) {
    XcdBarrier b; b.bar = bar; b.x = xb_xcc_id(); b.st = st;
    if (threadIdx.x == 0) (void)xb_add(&bar[XB_XCNT(b.x)], 1u);
    return b;
}
DI void xcd_barrier_complete(unsigned* bar, unsigned x, unsigned& nloc, unsigned& nx) {
    const unsigned G = gridDim.x * gridDim.y * gridDim.z;
    unsigned sum, cnt, mine, sp = 0u;
    for (;;) {
        sum = 0u; cnt = 0u; mine = 0u;
#pragma unroll
        for (unsigned j = 0; j < 16; ++j) { const unsigned c = xb_ld(&bar[XB_XCNT(j)]); sum += c; cnt += (c > 0u) ? 1u : 0u; mine = (j == x) ? c : mine; }
        if (sum == G) break;
        __builtin_amdgcn_s_sleep(1);
        if ((++sp & 255u) == 0u) { if (xb_ld(&bar[XB_TMO])) break; if (sp > XB_SPIN_CAP) { atomicAdd(&bar[XB_TMO], 1u); break; } }
    }
    nloc = mine > 0u ? mine : 1u; nx = cnt > 0u ? cnt : 1u;
}
DI void xcd_barrier(const XcdBarrier& b) {
    asm volatile("s_waitcnt vmcnt(0)" ::: "memory");
    __syncthreads();
    if (threadIdx.x == 0) {
        unsigned* bar = b.bar;
        __builtin_amdgcn_s_waitcnt(0);
        unsigned nloc = b.st[0], nx = b.st[1];
        if (nloc == 0u) { xcd_barrier_complete(bar, b.x, nloc, nx); b.st[0] = nloc; b.st[1] = nx; }
        const unsigned old = xb_add(&bar[XB_XSUB(b.x)], 1u);
        const unsigned gen = old / nloc;
        if (old + 1u == (gen + 1u) * nloc) {
            __builtin_amdgcn_fence(__ATOMIC_RELEASE, "agent");
            asm volatile("s_waitcnt vmcnt(0)" ::: "memory");
            const unsigned og = xb_add(&bar[XB_TOP], 1u);
            const unsigned tg = og / nx;
            if (og + 1u == (tg + 1u) * nx) xb_add(&bar[XB_TOPGEN], 1u);
            else XB_SPIN(xb_ld(&bar[XB_TOPGEN]) == tg, bar);
            __builtin_amdgcn_fence(__ATOMIC_ACQUIRE, "agent");
            xb_add(&bar[XB_XGEN(b.x)], 1u);
            asm volatile("s_waitcnt vmcnt(0)" ::: "memory");
        } else {
            XB_SPIN(xb_ld(&bar[XB_XGEN(b.x)]) == gen, bar);
            __builtin_amdgcn_fence(__ATOMIC_ACQUIRE, "agent");
            asm volatile("s_waitcnt vmcnt(0)" ::: "memory");
        }
    }
    __syncthreads();
}

DI void phase_norm(const float* xp, const float* xs, const float* g, bf16_t* h) {
    const int tid_ = get_tid(), lane = tid_ & 63, gw = VB * 4 + (tid_ >> 6), nw = NVB * 4;
    float4 gg[4];
#pragma unroll
    for (int i = 0; i < 4; ++i) gg[i] = *(const float4*)(g + i * 256 + lane * 4);
    for (int row = gw; row < NTOK; row += 2 * nw) {
        const int rowb = row + nw < NTOK ? row + nw : row;
        const float* sa = row < NPR ? xp + (size_t)row * 1024 : xs + (size_t)(row - NPR) * 1024;
        const float* sb = rowb < NPR ? xp + (size_t)rowb * 1024 : xs + (size_t)(rowb - NPR) * 1024;
        float4 va[4], vb[4]; float ssa = 0.f, ssb = 0.f;
#pragma unroll
        for (int i = 0; i < 4; ++i) { va[i] = *(const float4*)(sa + i * 256 + lane * 4); vb[i] = *(const float4*)(sb + i * 256 + lane * 4); }
#pragma unroll
        for (int i = 0; i < 4; ++i) {
            ssa += va[i].x * va[i].x + va[i].y * va[i].y + va[i].z * va[i].z + va[i].w * va[i].w;
            ssb += vb[i].x * vb[i].x + vb[i].y * vb[i].y + vb[i].z * vb[i].z + vb[i].w * vb[i].w;
        }
        ssa = wave_sum(ssa); ssb = wave_sum(ssb);
        const float ra = rsqrtf(ssa * (1.f / 1024.f) + 1e-6f), rb = rsqrtf(ssb * (1.f / 1024.f) + 1e-6f);
#pragma unroll
        for (int i = 0; i < 4; ++i) {
            u32x2 o; o.x = pack2(va[i].x * ra * gg[i].x, va[i].y * ra * gg[i].y); o.y = pack2(va[i].z * ra * gg[i].z, va[i].w * ra * gg[i].w);
            *(u32x2*)(h + (size_t)row * 1024 + i * 256 + lane * 4) = o;
            u32x2 q; q.x = pack2(vb[i].x * rb * gg[i].x, vb[i].y * rb * gg[i].y); q.y = pack2(vb[i].z * rb * gg[i].z, vb[i].w * rb * gg[i].w);
            *(u32x2*)(h + (size_t)rowb * 1024 + i * 256 + lane * 4) = q;
        }
    }
}
DI void phase_final_norm(float* x, const float* g) {
    const int tid_ = get_tid(), lane = tid_ & 63, gw = VB * 4 + (tid_ >> 6), nw = NVB * 4;
    float4 gg[4];
#pragma unroll
    for (int i = 0; i < 4; ++i) gg[i] = *(const float4*)(g + i * 256 + lane * 4);
    for (int row = gw; row < NTOK; row += 2 * nw) {
        const bool two = row + nw < NTOK;
        float* sa = x + (size_t)row * 1024; float* sb = x + (size_t)(two ? row + nw : row) * 1024;
        float4 va[4], vb[4]; float ssa = 0.f, ssb = 0.f;
#pragma unroll
        for (int i = 0; i < 4; ++i) { va[i] = *(const float4*)(sa + i * 256 + lane * 4); vb[i] = *(const float4*)(sb + i * 256 + lane * 4); }
#pragma unroll
        for (int i = 0; i < 4; ++i) {
            ssa += va[i].x * va[i].x + va[i].y * va[i].y + va[i].z * va[i].z + va[i].w * va[i].w;
            ssb += vb[i].x * vb[i].x + vb[i].y * vb[i].y + vb[i].z * vb[i].z + vb[i].w * vb[i].w;
        }
        ssa = wave_sum(ssa); ssb = wave_sum(ssb);
        const float ra = rsqrtf(ssa * (1.f / 1024.f) + 1e-6f), rb = rsqrtf(ssb * (1.f / 1024.f) + 1e-6f);
#pragma unroll
        for (int i = 0; i < 4; ++i) {
            float4 o; o.x = va[i].x * ra * gg[i].x; o.y = va[i].y * ra * gg[i].y; o.z = va[i].z * ra * gg[i].z; o.w = va[i].w * ra * gg[i].w;
            *(float4*)(sa + i * 256 + lane * 4) = o;
            if (two) { float4 q; q.x = vb[i].x * rb * gg[i].x; q.y = vb[i].y * rb * gg[i].y; q.z = vb[i].z * rb * gg[i].z; q.w = vb[i].w * rb * gg[i].w; *(float4*)(sb + i * 256 + lane * 4) = q; }
        }
    }
}

DI int map_row(int mode, int n) {
    if (mode == 0) return n;
    if (mode == 1 || mode == 2) {
        const int oc = n & 127;
        return ((n >> 7) << 8) + (((oc >> 2) & 1) << 7) + ((oc >> 5) << 5) + ((mode - 1) << 4) + (((oc >> 3) & 3) << 2) + (oc & 3);
    }
    if (n < 2048) return n;
    if (n < 3072) return n + 1024;
    if (n < 3080) return n - 3072 + 5632;
    if (n < 4104) return n - 3080 + 2048;
    if (n < 5640) return n - 4104 + 4096;
    return n;
}
DI void cvt_job(const float* src, int K, int N, bf16_t* dst, int mode, int rot, char* smem) {
    float* tile = (float*)smem;
    const int tid = get_tid(), nkt = K >> 6, nnt = (N + 63) >> 6, ntiles = nkt * nnt;
    const int kl0 = tid >> 4, nl4 = (tid & 15) * 4;
    float4 v[4];
    auto issue = [&](int t) __attribute__((always_inline)) {
        const int kt = t % nkt, nt = t / nkt, n = nt * 64 + nl4, nc = n < N ? n : 0;
#pragma unroll
        for (int i = 0; i < 4; ++i) {
            v[i] = *(const float4*)(src + (size_t)(kt * 64 + kl0 + 16 * i) * N + nc);
            if (n >= N) v[i] = make_float4(0.f, 0.f, 0.f, 0.f);
        }
    };
    int t = (int)((VB + rot) % NVB);
    if (t < ntiles) issue(t);
    while (t < ntiles) {
        const int kt = t % nkt, nt = t / nkt;
        __syncthreads();
#pragma unroll
        for (int i = 0; i < 4; ++i) {
            const int kl = kl0 + 16 * i;
            tile[kl * 65 + nl4] = v[i].x; tile[kl * 65 + nl4 + 1] = v[i].y; tile[kl * 65 + nl4 + 2] = v[i].z; tile[kl * 65 + nl4 + 3] = v[i].w;
        }
        const int tn = t + NVB;
        if (tn < ntiles) issue(tn);
        __syncthreads();
        const int nl = tid >> 2, kq = (tid & 3) * 16, n = nt * 64 + nl;
        if (n < N) {
            const float sc = (mode == 3 && n >= 512 && n < 1024) ? 0.08838834764831845f : 1.f;
            float tv[16];
#pragma unroll
            for (int q = 0; q < 16; ++q) tv[q] = tile[(kq + q) * 65 + nl] * sc;
            const u32x4 o0 = pack8(tv), o1 = pack8(tv + 8);
            bf16_t* d = dst + (size_t)map_row(mode, n) * K + kt * 64 + kq;
            *(u32x4*)d = o0; *(u32x4*)(d + 8) = o1;
        }
        t = tn;
    }
    __syncthreads();
}

struct Epi {
    bf16_t* o16; int ldc;
    float* o32;
    const float* rp; const float* rs; float scale;
    float* gates; bf16_t* halo; int cv0, cv1;
};
enum { EPI_GU = 0, EPI_RES = 1, EPI_PROJ = 2 };

template <int EPI>
DI void gemm_tail(const bf16_t* A, int lda, const bf16_t* Bt, int K, int nN, const Epi& e, char* smem) {
    const int tid = get_tid(), wid = tid >> 6, lane = tid & 63, wr = wid >> 1, wc = wid & 1, fr = lane & 15, fq = lane >> 4;
    const int nkt = K >> 6;
    const int nitems = EPI == EPI_GU ? nN : (EPI == EPI_PROJ ? nN + 128 : nN * (nkt >> 2));
    for (int it0 = 0; it0 < nitems; it0 += NVB) {
        int it = it0 + ((VB + (NVB >> 1)) % NVB); const bool act = it < nitems; if (!act) it = 0;
        int pm, pn, kbeg = 0, nk = nkt;
        if (EPI == EPI_GU) { pm = 128; pn = it; }
        else if (EPI == EPI_PROJ) { if (it < nN) { pm = 128; pn = it; } else { pm = it - nN; pn = nN - 1; } }
        else { pm = 128; pn = it % nN; kbeg = (it / nN) * 4; nk = 4; }
        f32x4 acc[4][4];
#pragma unroll
        for (int n = 0; n < 4; ++n)
#pragma unroll
            for (int m = 0; m < 4; ++m) acc[n][m] = (f32x4){0.f, 0.f, 0.f, 0.f};
        const bf16_t* Ab = A + (size_t)(pm * 128) * lda + kbeg * 64;
        const bf16_t* Bb = Bt + (size_t)(pn * 128) * K + kbeg * 64;
        const int sr = tid >> 3, sgc = ((tid & 7) ^ (sr & 7)) * 8;
        const bf16_t* ap = Ab + (size_t)sr * lda + sgc;
        const bf16_t* bp = Bb + (size_t)sr * K + sgc;
        const size_t a32 = (size_t)32 * lda, b32 = (size_t)32 * K;
        __attribute__((address_space(3))) char* lbase = (__attribute__((address_space(3))) char*)smem + tid * 16;
#define GEMM_STAGE(BUF)                                                                                                         \
        {                                                                                                                        \
            _Pragma("unroll") for (int ii = 0; ii < 4; ++ii) {                                                                   \
                __builtin_amdgcn_global_load_lds((const unsigned*)(ap + ii * a32), (__attribute__((address_space(3))) unsigned*)(lbase + (BUF) * 32768 + ii * 4096), 16, 0, 0);          \
                __builtin_amdgcn_global_load_lds((const unsigned*)(bp + ii * b32), (__attribute__((address_space(3))) unsigned*)(lbase + (BUF) * 32768 + 16384 + ii * 4096), 16, 0, 0);  \
            }                                                                                                                    \
            ap += 64; bp += 64;                                                                                                  \
        }
#define GEMM_COMPUTE(BUF)                                                                                                       \
        {                                                                                                                        \
            const char* SA = smem + (BUF) * 32768; const char* SB = SA + 16384;                                                  \
            _Pragma("unroll") for (int ks = 0; ks < 2; ++ks) {                                                                   \
                bf16x8 af[4], bf[4];                                                                                             \
                const int sw = ((ks * 4 + fq) ^ (fr & 7)) << 4;                                                                  \
                _Pragma("unroll") for (int m = 0; m < 4; ++m) af[m] = *(const bf16x8*)(SA + (wr * 64 + m * 16 + fr) * 128 + sw); \
                _Pragma("unroll") for (int n = 0; n < 4; ++n) bf[n] = *(const bf16x8*)(SB + (wc * 64 + n * 16 + fr) * 128 + sw); \
                __builtin_amdgcn_s_setprio(1);                                                                                   \
                _Pragma("unroll") for (int n = 0; n < 4; ++n)                                                                    \
                    _Pragma("unroll") for (int m = 0; m < 4; ++m) acc[n][m] = mfma16(bf[n], af[m], acc[n][m]);                   \
                __builtin_amdgcn_s_setprio(0);                                                                                   \
            }                                                                                                                    \
        }
        __syncthreads();
        GEMM_STAGE(0)
        for (int kt = 0; kt < nk; kt += 2) {
            asm volatile("s_waitcnt vmcnt(0)" ::: "memory");
            __syncthreads();
            GEMM_STAGE(1)
            GEMM_COMPUTE(0)
            asm volatile("s_waitcnt vmcnt(0)" ::: "memory");
            __syncthreads();
            if (kt + 2 < nk) GEMM_STAGE(0)
            GEMM_COMPUTE(1)
        }
        if (act)
#pragma unroll
        for (int m = 0; m < 4; ++m) {
            const int row = pm * 128 + wr * 64 + m * 16 + fr;
            if (EPI == EPI_GU) {
#pragma unroll
                for (int i = 0; i < 2; ++i) {
                    const f32x4 g = acc[2 * i][m], u = acc[2 * i + 1][m];
                    u32x2 o; o.x = pack2(siluf(g[0]) * u[0], siluf(g[1]) * u[1]); o.y = pack2(siluf(g[2]) * u[2], siluf(g[3]) * u[3]);
                    *(u32x2*)(e.o16 + (size_t)row * e.ldc + (pn >> 1) * 128 + (wc * 2 + i) * 32 + 8 * fq + 4 * (pn & 1)) = o;
                }
            } else if (EPI == EPI_RES) {
#pragma unroll
                for (int n = 0; n < 4; ++n) {
                    float* dst = e.o32 + (size_t)row * 1024 + pn * 128 + wc * 64 + n * 16 + 4 * fq;
#pragma unroll
                    for (int j = 0; j < 4; ++j) atomicAdd(dst + j, e.scale * acc[n][m][j]);
                }
            } else {
                if (pn < nN - 1) {
                    int hr, unit;
                    if (row < NPR) { hr = (row & 63) - 61; unit = row >> 6; } else { hr = ((row - NPR) & 15) - 13; unit = 256 + ((row - NPR) >> 4); }
#pragma unroll
                    for (int n = 0; n < 4; ++n) {
                        const int col = pn * 128 + wc * 64 + n * 16 + 4 * fq;
                        u32x2 o; o.x = pack2(acc[n][m][0], acc[n][m][1]); o.y = pack2(acc[n][m][2], acc[n][m][3]);
                        *(u32x2*)(e.o16 + (size_t)row * e.ldc + col) = o;
                        if (hr >= 0 && col >= e.cv0 && col < e.cv1) *(u32x2*)(e.halo + ((size_t)unit * 3 + hr) * 3072 + (col - e.cv0)) = o;
                    }
                } else if (wc == 0) {
#pragma unroll
                    for (int n = 0; n < 2; ++n) {
                        float4 o; o.x = acc[n][m][0]; o.y = acc[n][m][1]; o.z = acc[n][m][2]; o.w = acc[n][m][3];
                        *(float4*)(e.gates + (size_t)row * 32 + n * 16 + 4 * fq) = o;
                    }
                }
            }
        }
    }
}


namespace pg8 {
#define PG8_LAS __attribute__((address_space(3)))
constexpr int BM = 256, BK = 64, HALF = 128, HTB = HALF * BK * 2  , STAGE_BYTES = 8 * HTB, NXCD = 8, WGM = 8;
__host__ __device__ __forceinline__ int lds_byte(int r, int c) { const int st = (r >> 4) * 2 + (c >> 5), rr = r & 15, cc = c & 31, ob = rr * 64 + cc * 2; return st * 1024 + (ob ^ (((ob >> 9) & 1) << 5)); }
__host__ __device__ __forceinline__ void stage_rc(int b, int& R, int& C) { const int st = b / 1024, sb = b % 1024, swz = sb ^ (((sb >> 9) & 1) << 5); R = (st >> 1) * 16 + swz / 64; C = (st & 1) * 32 + (swz % 64) / 2; }
__host__ __device__ __forceinline__ int perm32(int rho) { const int n = rho >> 4, i = rho & 15; return 8 * (i >> 2) + 4 * n + (i & 3); }
struct Unit { int pm, pn; };
struct Gemm { const bf16_t* A; const bf16_t* Bt; int M, N, K, lda; };
struct StaticOrder {
    int nM, nN, nwg, G, c;
    __host__ __device__ void init(int M, int N, int G_, int c_) { nM = M / BM; nN = N / BM; nwg = nM * nN; G = G_; c = c_; }
    __host__ __device__ bool next(int i, Unit& u) const {
        const long L = (long)i * G + c; if (L >= nwg) return false;
        int wgid = (int)L; { const int q = nwg / NXCD, r = nwg % NXCD, xcd = wgid % NXCD, off = wgid / NXCD; wgid = (xcd < r ? xcd * (q + 1) : r * (q + 1) + (xcd - r) * q) + off; }
        const int nig = WGM * nN, gid = wgid / nig, fm = gid * WGM, gsz = (nM - fm) < WGM ? (nM - fm) : WGM;
        u.pm = fm + ((wgid % nig) % gsz); u.pn = (wgid % nig) / gsz; return true;
    }
    __device__ __forceinline__ void a_ready(const Unit&) const {}
    __device__ __forceinline__ void done(const Unit&) const {}
};

template <class Epi, class Sched>
__device__ __forceinline__ void gemm_phase(PG8_LAS unsigned char* lds, const Gemm g, const Sched& S, const Epi& E) {
    const int tid = threadIdx.x, wid = __builtin_amdgcn_readfirstlane(tid >> 6), lane = tid & 63, wr = wid >> 2, wc = wid & 3, fr = lane & 15, fq = lane >> 4;
    const int K = g.K, nt = K / BK;
#define PG8_STAMP() do {} while (0)
    PG8_STAMP();
    unsigned voffA[2], voffB[2];
#pragma unroll
    for (int i = 0; i < 2; ++i) { int R, C; stage_rc(tid * 16 + i * 8192, R, C); const int Rb = Epi::PERM ? ((R & ~31) + perm32(R & 31)) : R;
        voffA[i] = (unsigned)(R * g.lda + C) * 2u; voffB[i] = (unsigned)(Rb * K + C) * 2u; }
    const size_t kstep = (size_t)(BK * 2);
    const size_t hstepB = (size_t)HALF * K * 2, hstepA = (size_t)HALF * g.lda * 2;
    const size_t tstepB = 2 * hstepB, tstepA = 2 * hstepA;
    const unsigned ldsw = (unsigned)wid * 1024u;
    const int aoff = lds_byte(wr * 64 + fr, fq * 8), boff = lds_byte(wc * 32 + fr, fq * 8);
#define PG8_SA(b, h) (((b) * 2 + (h)) * HTB)
#define PG8_SB(b, h) ((4 + (b) * 2 + (h)) * HTB)
#define PG8_STAGE(bufoff, gbase, voff) do { _Pragma("unroll") for (int _i = 0; _i < 2; ++_i) \
        __builtin_amdgcn_global_load_lds((const unsigned*)((const char*)(gbase) + (voff)[_i]), (PG8_LAS unsigned*)(lds + (bufoff) + ldsw + _i * 8192), 16, 0, 0); } while (0)
#define PG8_LDA(dst, b, h) do { _Pragma("unroll") for (int m = 0; m < 4; ++m) _Pragma("unroll") for (int k = 0; k < 2; ++k) dst[m][k] = *(const PG8_LAS bf16x8*)(lds + PG8_SA(b, h) + aoff + m * 2048 + k * 1024); } while (0)
#define PG8_LDB(dst, b, h) do { _Pragma("unroll") for (int n = 0; n < 2; ++n) _Pragma("unroll") for (int k = 0; k < 2; ++k) dst[n][k] = *(const PG8_LAS bf16x8*)(lds + PG8_SB(b, h) + boff + n * 2048 + k * 1024); } while (0)
#define PG8_MMA(ai, bj, At, Bt) do { __builtin_amdgcn_s_setprio(1); _Pragma("unroll") for (int m = 0; m < 4; ++m) _Pragma("unroll") for (int n = 0; n < 2; ++n) _Pragma("unroll") for (int k = 0; k < 2; ++k) \
        acc[ai][bj][m][n] = __builtin_amdgcn_mfma_f32_16x16x32_bf16(Bt[n][k], At[m][k], acc[ai][bj][m][n], 0, 0, 0); __builtin_amdgcn_s_setprio(0); } while (0)
#define PG8_WAIT_V(n) asm volatile("s_waitcnt vmcnt(" #n ")" ::: "memory")
#define PG8_WAIT_L(n) asm volatile("s_waitcnt lgkmcnt(" #n ")" ::: "memory")
#define PG8_BAR __builtin_amdgcn_s_barrier()
#define PG8_SCHED __builtin_amdgcn_sched_barrier(0)
    Unit cur, nxt; int ui = 0;
    if (!S.next(0, cur)) return;
    f32x4 acc[2][2][4][2];
#pragma unroll
    for (int a = 0; a < 2; ++a)
#pragma unroll
        for (int b = 0; b < 2; ++b)
#pragma unroll
            for (int m = 0; m < 4; ++m)
#pragma unroll
                for (int n = 0; n < 2; ++n) acc[a][b][m][n] = (f32x4){0.f, 0.f, 0.f, 0.f};
    bf16x8 At[4][2], B0[2][2], B1[2][2];
    const char* cA = (const char*)g.A + (size_t)cur.pm * tstepA; const char* cB = (const char*)g.Bt + (size_t)cur.pn * tstepB;
    S.a_ready(cur);
    PG8_STAGE(PG8_SB(0, 0), cB, voffB); PG8_STAGE(PG8_SA(0, 0), cA, voffA); PG8_STAGE(PG8_SB(0, 1), cB + hstepB, voffB); PG8_STAGE(PG8_SA(0, 1), cA + hstepA, voffA);
    if (wr == 1) PG8_BAR;
    PG8_WAIT_V(4); PG8_BAR;
    PG8_STAGE(PG8_SB(1, 0), cB + kstep, voffB); PG8_STAGE(PG8_SA(1, 0), cA + kstep, voffA); PG8_STAGE(PG8_SB(1, 1), cB + hstepB + kstep, voffB);
    PG8_WAIT_V(6); PG8_BAR;
    PG8_STAMP();
    for (;;) {
        const bool has_next = S.next(ui + 1, nxt);
        const char* nA = has_next ? (const char*)g.A + (size_t)nxt.pm * tstepA : cA; const char* nB = has_next ? (const char*)g.Bt + (size_t)nxt.pn * tstepB : cB;
        for (int t = 0; t < nt; t += 2) {
            const bool last = (t == nt - 2);
            const char* a1 = cA + (size_t)(t + 1) * kstep;
            const char* a2 = last ? nA : cA + (size_t)(t + 2) * kstep; const char* b2 = last ? nB : cB + (size_t)(t + 2) * kstep;
            const char* a3 = a2 + kstep; const char* b3 = b2 + kstep;
            if (last && has_next) S.a_ready(nxt);
            PG8_LDB(B0, 0, 0); PG8_SCHED; PG8_LDA(At, 0, 0); PG8_STAGE(PG8_SA(1, 1), a1 + hstepA, voffA);
            PG8_WAIT_L(8); PG8_BAR; PG8_WAIT_L(0); PG8_MMA(0, 0, At, B0); PG8_BAR; PG8_SCHED;
            PG8_LDB(B1, 0, 1); PG8_STAGE(PG8_SB(0, 0), b2, voffB);
            PG8_BAR; PG8_WAIT_L(0); PG8_MMA(0, 1, At, B1); PG8_BAR;
            PG8_LDA(At, 0, 1); PG8_STAGE(PG8_SA(0, 0), a2, voffA);
            PG8_BAR; PG8_WAIT_L(0); PG8_MMA(1, 0, At, B0); PG8_BAR; PG8_SCHED;
            PG8_STAGE(PG8_SB(0, 1), b2 + hstepB, voffB);
            PG8_WAIT_V(6); PG8_BAR; PG8_MMA(1, 1, At, B1); PG8_BAR;
            PG8_LDB(B0, 1, 0); PG8_SCHED; PG8_LDA(At, 1, 0); PG8_STAGE(PG8_SA(0, 1), a2 + hstepA, voffA);
            PG8_WAIT_L(8); PG8_BAR; PG8_WAIT_L(0); PG8_MMA(0, 0, At, B0); PG8_BAR; PG8_SCHED;
            PG8_LDB(B1, 1, 1); PG8_STAGE(PG8_SB(1, 0), b3, voffB);
            PG8_BAR; PG8_WAIT_L(0); PG8_MMA(0, 1, At, B1); PG8_BAR;
            PG8_LDA(At, 1, 1); PG8_STAGE(PG8_SA(1, 0), a3, voffA);
            PG8_BAR; PG8_WAIT_L(0); PG8_MMA(1, 0, At, B0); PG8_BAR; PG8_SCHED;
            PG8_STAGE(PG8_SB(1, 1), b3 + hstepB, voffB);
            PG8_WAIT_V(6); PG8_BAR; PG8_MMA(1, 1, At, B1); PG8_BAR;
        }
        PG8_STAMP();
        if constexpr (!Epi::AFTER_DRAIN) { E(acc, cur, wr, wc, fr, fq); S.done(cur); }
        PG8_STAMP();
        if (!has_next) break;
#pragma unroll
        for (int a = 0; a < 2; ++a)
#pragma unroll
            for (int b = 0; b < 2; ++b)
#pragma unroll
                for (int m = 0; m < 4; ++m)
#pragma unroll
                    for (int n = 0; n < 2; ++n) acc[a][b][m][n] = (f32x4){0.f, 0.f, 0.f, 0.f};
        cur = nxt; cA = nA; cB = nB; ++ui;
    }
    PG8_WAIT_V(0);
    if (wr == 0) PG8_BAR;
    PG8_BAR;
    if constexpr (Epi::AFTER_DRAIN) { E.fused(acc, cur, wr, wc, fr, fq, lds, wid, lane); S.done(cur); }
    PG8_STAMP();
#undef PG8_STAMP
#undef PG8_SA
#undef PG8_SB
#undef PG8_STAGE
#undef PG8_LDA
#undef PG8_LDB
#undef PG8_MMA
#undef PG8_WAIT_V
#undef PG8_WAIT_L
#undef PG8_BAR
#undef PG8_SCHED
}
}

struct PEpiGU {
    static constexpr bool PERM = false, AFTER_DRAIN = false;
    bf16_t* O;
    DI void operator()(const f32x4 (&acc)[2][2][4][2], const pg8::Unit& u, int wr, int wc, int fr, int fq) const {
        asm volatile("" : "+v"(fr), "+v"(fq));
#pragma unroll
        for (int ai = 0; ai < 2; ++ai)
#pragma unroll
            for (int m = 0; m < 4; ++m) {
                bf16_t* rowp = O + (size_t)(u.pm * 256 + ai * 128 + wr * 64 + m * 16 + fr) * 2816 + u.pn * 128 + wc * 32 + 8 * fq;
                u32x4 o;
                { const f32x4 g = acc[ai][0][m][0], up = acc[ai][0][m][1]; o.x = pack2(siluf(g[0]) * up[0], siluf(g[1]) * up[1]); o.y = pack2(siluf(g[2]) * up[2], siluf(g[3]) * up[3]); }
                { const f32x4 g = acc[ai][1][m][0], up = acc[ai][1][m][1]; o.z = pack2(siluf(g[0]) * up[0], siluf(g[1]) * up[1]); o.w = pack2(siluf(g[2]) * up[2], siluf(g[3]) * up[3]); }
                *(u32x4*)rowp = o;
            }
    }
};
struct PEpiRES {
    static constexpr bool PERM = false, AFTER_DRAIN = false;
    float* X; const float* R; float scale;
    DI void operator()(const f32x4 (&acc)[2][2][4][2], const pg8::Unit& u, int wr, int wc, int fr, int fq) const {
        asm volatile("" : "+v"(fr), "+v"(fq));
#pragma unroll
        for (int ai = 0; ai < 2; ++ai)
#pragma unroll
            for (int m = 0; m < 4; ++m) {
                const size_t off = (size_t)(u.pm * 256 + ai * 128 + wr * 64 + m * 16 + fr) * 1024 + u.pn * 256 + wc * 32 + 4 * fq;
#pragma unroll
                for (int bj = 0; bj < 2; ++bj)
#pragma unroll
                    for (int n = 0; n < 2; ++n) {
                        const float4 r4 = *(const float4*)(R + off + bj * 128 + n * 16);
                        const f32x4 a = acc[ai][bj][m][n];
                        float4 o; o.x = r4.x + scale * a[0]; o.y = r4.y + scale * a[1]; o.z = r4.z + scale * a[2]; o.w = r4.w + scale * a[3];
                        *(float4*)(X + off + bj * 128 + n * 16) = o;
                    }
            }
    }
};
struct PEpiPROJ {
    static constexpr bool PERM = true, AFTER_DRAIN = false;
    bf16_t* O; int ldc; bf16_t* halo; int cv0, cv1;
    DI void operator()(const f32x4 (&acc)[2][2][4][2], const pg8::Unit& u, int wr, int wc, int fr, int fq) const {
        asm volatile("" : "+v"(fr), "+v"(fq));
#pragma unroll
        for (int ai = 0; ai < 2; ++ai)
#pragma unroll
            for (int m = 0; m < 4; ++m) {
                const int row = u.pm * 256 + ai * 128 + wr * 64 + m * 16 + fr, hr = (row & 63) - 61, unit = row >> 6;
#pragma unroll
                for (int bj = 0; bj < 2; ++bj) {
                    const int col = u.pn * 256 + bj * 128 + wc * 32 + 8 * fq;
                    const u32x2 lo = pack4(acc[ai][bj][m][0]), hi = pack4(acc[ai][bj][m][1]);
                    const u32x4 o = (u32x4){lo.x, lo.y, hi.x, hi.y};
                    *(u32x4*)(O + (size_t)row * ldc + col) = o;
                    if (hr >= 0 && col >= cv0 && col < cv1) *(u32x4*)(halo + ((size_t)unit * 3 + hr) * 3072 + (col - cv0)) = o;
                }
            }
    }
};
template <class PE>
DI void gemm_big(const bf16_t* A, int lda, const bf16_t* Bt, int K, int N, const PE& pe, char* smem_all) {
    pg8::Gemm g; g.A = A; g.Bt = Bt; g.M = NPR; g.N = N; g.K = K; g.lda = lda;
    pg8::StaticOrder S; S.init(NPR, N, (int)gridDim.x, (int)blockIdx.x);
    __syncthreads();
    pg8::gemm_phase<PE, pg8::StaticOrder>((PG8_LAS unsigned char*)smem_all, g, S, pe);
    __syncthreads();
}

#define OFF_YS   16777216
#define OFF_PC   16908288
#define OFF_PN   17432576
#define OFF_PM   17434624
#define OFF_PSSD 17434640
#define OFF_PSC  17958928
#define OFF_PG   17977360
#define OFF_PGC  18501648
#define OFF_SC   18538512
#define OFF_SN   19587088
#define OFF_SM   19591184
#define OFF_SSSD 19591216
#define OFF_SSC  20639792
#define OFF_SG   20676656
#define OFF_SGC  21725232

#define LSYNC() do { asm volatile("s_waitcnt lgkmcnt(0)" ::: "memory"); __builtin_amdgcn_s_barrier(); asm volatile("" ::: "memory"); } while (0)

DI float scan_add(float v, int lane) {
#pragma unroll
    for (int o = 1; o < 64; o <<= 1) { const float t = __shfl_up(v, o); if (lane >= o) v += t; }
    return v;
}
DI float scan_max(float v, int lane) {
#pragma unroll
    for (int o = 1; o < 64; o <<= 1) { const float t = __shfl_up(v, o); if (lane >= o) v = fmaxf(v, t); }
    return v;
}

DI void fill_cache_halo(const float* cache, int width, bf16_t* halo) {
    for (int i = VB * 256 + get_tid(); i < 8 * 3 * width; i += NVB * 256) {
        const int s = i / (3 * width), rem = i % (3 * width), r = rem / width, col = rem % width;
        halo[((size_t)(264 + s) * 3 + r) * 3072 + col] = f2bf(cache[i]);
    }
}

DI void phase_conv_ssd(const Params& p, bf16_t* BIG, const bf16_t* halo) {
    const int tid = get_tid(), cv = tid & 31, tg = tid >> 5;
    const float* cw = p.in[19]; const float* cb = p.in[20];
    for (int it = VB; it < 264 * 6; it += NVB) {
        const int unit = it / 6, cblk = it % 6, col = cblk * 256 + cv * 8;
        const bool smp = unit >= 256;
        const int L = smp ? 16 : 64, c = unit & 63, s = unit - 256;
        const size_t row0 = smp ? (size_t)NPR + s * 16 : (size_t)unit * 64;
        const bool act = tg * 8 < L;
        float x[11][8];
        if (act) {
#pragma unroll
            for (int i = 0; i < 11; ++i) {
                const int rl = tg * 8 - 3 + i;
                if (rl >= 0) { const u32x4 v = *(const u32x4*)(BIG + (row0 + rl) * 5632 + 4096 + col); unpack8(v, x[i]); }
                else if (!smp) {
                    if (c == 0) {
#pragma unroll
                        for (int j = 0; j < 8; ++j) x[i][j] = 0.f;
                    } else { const u32x4 v = *(const u32x4*)(halo + ((size_t)(unit - 1) * 3 + (rl + 3)) * 3072 + col); unpack8(v, x[i]); }
                } else {
                    const float* src = p.in[6] + ((size_t)s * 3 + (rl + 3)) * 1536 + col;
                    const float4 a = *(const float4*)src, b = *(const float4*)(src + 4);
                    x[i][0] = a.x; x[i][1] = a.y; x[i][2] = a.z; x[i][3] = a.w; x[i][4] = b.x; x[i][5] = b.y; x[i][6] = b.z; x[i][7] = b.w;
                }
            }
        }
        __syncthreads();
        if (act) {
            float w[4][8], bb[8];
#pragma unroll
            for (int i = 0; i < 4; ++i) {
                const float4 a = *(const float4*)(cw + i * 1536 + col), b = *(const float4*)(cw + i * 1536 + col + 4);
                w[i][0] = a.x; w[i][1] = a.y; w[i][2] = a.z; w[i][3] = a.w; w[i][4] = b.x; w[i][5] = b.y; w[i][6] = b.z; w[i][7] = b.w;
            }
            { const float4 a = *(const float4*)(cb + col), b = *(const float4*)(cb + col + 4);
              bb[0] = a.x; bb[1] = a.y; bb[2] = a.z; bb[3] = a.w; bb[4] = b.x; bb[5] = b.y; bb[6] = b.z; bb[7] = b.w; }
#pragma unroll
            for (int t = 0; t < 8; ++t) {
                float o[8];
#pragma unroll
                for (int j = 0; j < 8; ++j) { const float a = bb[j] + w[0][j] * x[t][j] + w[1][j] * x[t + 1][j] + w[2][j] * x[t + 2][j] + w[3][j] * x[t + 3][j]; o[j] = siluf(a); }
                *(u32x4*)(BIG + (row0 + tg * 8 + t) * 5632 + 4096 + col) = pack8(o);
            }
        }
        if ((smp || c == 63) && tid < 96) {
            const int i = tid >> 5;
            float f[8]; unpack8(*(const u32x4*)(halo + ((size_t)unit * 3 + i) * 3072 + col), f);
            float* dst = smp ? p.out + OFF_SSC + ((size_t)s * 3 + i) * 1536 + col : p.out + OFF_PSC + ((size_t)(unit >> 6) * 3 + i) * 1536 + col;
            *(float4*)dst = make_float4(f[0], f[1], f[2], f[3]); *(float4*)(dst + 4) = make_float4(f[4], f[5], f[6], f[7]);
        }
        __syncthreads();
    }
}

#define L_Q   0
#define L_K   17408
#define L_KT  34816
#define L_VT  53248
#define L_VW  55552
#define L_P   57856
#define L_ST  67072
#define L_F   71424

template <int NT>
DI void mlstm_chain(const Params& p, bf16_t* BIG, const float* gates, int b, int hd, int es, bool smp, char* smem, bool live) {
    const int tid = get_tid(), wid = tid >> 6, lane = tid & 63, fr = lane & 15, fq = lane >> 4;
    bf16_t* Qs = (bf16_t*)(smem + L_Q); bf16_t* Ks = (bf16_t*)(smem + L_K); bf16_t* WRs = (bf16_t*)(smem + L_KT);     bf16_t* VTs = (bf16_t*)(smem + L_VT);
    constexpr int LDV = 16 * NT + 8;
    bf16_t* VWs = VTs + 64 * LDV; bf16_t* Ps = VWs + 64 * LDV; bf16_t* STs = Ps + 64 * 72;
    float* fl = (float*)(STs + 16 * NT * 136);
    float* as_ = fl; float* Ms = fl + 64; float* bs = fl + 128; float* wrs = fl + 192; float* rsum = fl + 256; float* qns = fl + 320; float* ns = fl + 384; float* sc = fl + 512;
    const int L = smp ? 16 : 64, nch = smp ? 1 : 64, sidx = b * 4 + hd;
    const size_t row0 = smp ? (size_t)NPR + b * 16 : (size_t)b * 4096;
    const float bi = p.in[16][hd], bfg = p.in[17][hd];
    float m = 0.f;
    f32x4 accN[2];
    accN[0] = (f32x4){0.f, 0.f, 0.f, 0.f}; accN[1] = accN[0];
    f32x4 accC[2][NT];
#pragma unroll
    for (int mt = 0; mt < 2; ++mt)
#pragma unroll
        for (int nt = 0; nt < NT; ++nt) accC[mt][nt] = (f32x4){0.f, 0.f, 0.f, 0.f};
    if (smp) {
        const float* C0 = p.in[2] + (size_t)sidx * 128 * 256;
#pragma unroll
        for (int mt = 0; mt < 2; ++mt)
#pragma unroll
            for (int nt = 0; nt < NT; ++nt)
#pragma unroll
                for (int j = 0; j < 4; ++j) accC[mt][nt][j] = C0[(size_t)(32 * wid + 16 * mt + 4 * fq + j) * 256 + es * 16 * NT + nt * 16 + fr];
        if (fr == 0) {
#pragma unroll
            for (int mt = 0; mt < 2; ++mt)
#pragma unroll
                for (int j = 0; j < 4; ++j) accN[mt][j] = p.in[3][sidx * 128 + 32 * wid + 16 * mt + 4 * fq + j];
        }
        m = p.in[4][sidx];
    }
    LSYNC();
#pragma unroll
    for (int mt = 0; mt < 2; ++mt)
#pragma unroll
        for (int nt = 0; nt < NT; ++nt) *(u32x2*)(STs + (nt * 16 + fr) * 136 + 32 * wid + 16 * mt + 4 * fq) = pack4(accC[mt][nt]);
#pragma unroll
    for (int mt = 0; mt < 2; ++mt) if (fr == 0) { ns[32 * wid + 16 * mt + 4 * fq] = accN[mt][0]; ns[32 * wid + 16 * mt + 4 * fq + 1] = accN[mt][1]; ns[32 * wid + 16 * mt + 4 * fq + 2] = accN[mt][2]; ns[32 * wid + 16 * mt + 4 * fq + 3] = accN[mt][3]; }
    for (int i = tid; i < 16 * 72 / 2; i += 256) ((unsigned*)WRs)[i] = 0u;

    u32x4 qv[4], kv[4], vv; float gi = 0.f, gf = 0.f;
    auto load = [&](int c) __attribute__((always_inline)) {
        const size_t r0 = row0 + (size_t)c * 64;
{
            const int r = tid >> 2, qt = tid & 3, rc = r < L ? r : L - 1;
            const bf16_t* qp = BIG + (r0 + rc) * 5632 + hd * 128 + qt * 32;
#pragma unroll
            for (int i = 0; i < 4; ++i) {
                qv[i] = *(const u32x4*)(qp + i * 8); kv[i] = *(const u32x4*)(qp + 512 + i * 8);
                if (r >= L) { qv[i] = (u32x4){0u, 0u, 0u, 0u}; kv[i] = (u32x4){0u, 0u, 0u, 0u}; }
            }
        }
        { const int vt = NT == 2 ? tid : (tid & 127), r = vt >> NT, cc = vt & (2 * NT - 1), rc = r < L ? r : L - 1;
          vv = *(const u32x4*)(BIG + (r0 + rc) * 5632 + 1024 + hd * 256 + es * 16 * NT + cc * 8);
          if (r >= L) vv = (u32x4){0u, 0u, 0u, 0u}; }
        { const int lc = lane < L ? lane : L - 1; gi = gates[(r0 + lc) * 32 + hd]; gf = gates[(r0 + lc) * 32 + 4 + hd]; }
    };
    load(0);
    for (int c = 0; c < nch; ++c) {
        LSYNC();
        if (wid == 0) {
            float ig = -1e30f, lf = 0.f;
            if (lane < L) { ig = gi + bi; const float x = gf + bfg; lf = fminf(x, 0.f) - log1pf(__expf(-fabsf(x))); }
            const float bc = scan_add(lf, lane);
            const float a = ig - bc;
            const float pm = scan_max(a, lane);
            const float M = fmaxf(m, pm);
            const float Mlast = __shfl(M, L - 1), bL = __shfl(bc, L - 1);
            as_[lane] = a; Ms[lane] = M; bs[lane] = bc; { const float wrv = lane < L ? __expf(a - Mlast) : 0.f; wrs[lane] = wrv; WRs[lane] = f2bf(wrv); }
            if (lane == 0) { sc[0] = Mlast; sc[1] = bL; }
        }
        LSYNC();
{
            const int r = tid >> 2, qt = tid & 3;
            bf16_t* qd = Qs + r * 136 + qt * 32; bf16_t* kd = Ks + r * 136 + qt * 32;
#pragma unroll
            for (int i = 0; i < 4; ++i) { *(u32x4*)(qd + i * 8) = qv[i]; *(u32x4*)(kd + i * 8) = kv[i]; }
        }
        if (NT == 2 || tid < 128) {
            const int r = tid >> NT, cc = tid & (2 * NT - 1); const float w = wrs[r];
            float vf[8]; unpack8(vv, vf);
#pragma unroll
            for (int j = 0; j < 8; ++j) vf[j] *= w;
            *(u32x4*)(VTs + r * LDV + cc * 8) = vv; *(u32x4*)(VWs + r * LDV + cc * 8) = pack8(vf);
        }
        if (c + 1 < nch) load(c + 1);
        LSYNC();
        {
            f32x4 s4[4];
#pragma unroll
            for (int nt = 0; nt < 4; ++nt) s4[nt] = (f32x4){0.f, 0.f, 0.f, 0.f};
#pragma unroll 1
            for (int kk = 0; kk < 4; ++kk) {
                const bf16x8 qf = ldfrag(Qs, 136, 16 * wid + fr, kk * 32 + fq * 8);
#pragma unroll
                for (int nt = 0; nt < 4; ++nt) s4[nt] = mfma16(ldfrag(Ks, 136, 16 * nt + fr, kk * 32 + fq * 8), qf, s4[nt]);
            }
            const int s = 16 * wid + fr; const float Msv = Ms[s]; float rs = 0.f;
#pragma unroll
            for (int nt = 0; nt < 4; ++nt) {
                f32x4 pv;
#pragma unroll
                for (int j = 0; j < 4; ++j) { const int r = 16 * nt + 4 * fq + j; const float d = (r <= s) ? __expf(as_[r] - Msv) : 0.f; pv[j] = s4[nt][j] * d; rs += pv[j]; }
                *(u32x2*)(Ps + s * 72 + 16 * nt + 4 * fq) = pack4(pv);
            }
            rs += __shfl_xor(rs, 16); rs += __shfl_xor(rs, 32);
            if (fq == 0) rsum[s] = rs;
            const int s2 = tid >> 2, part = tid & 3; float qa = 0.f;
#pragma unroll
            for (int j = 0; j < 4; ++j) { float qf8[8]; unpack8(*(const u32x4*)(Qs + s2 * 136 + part * 32 + j * 8), qf8);
#pragma unroll
                for (int i = 0; i < 8; ++i) qa += qf8[i] * ns[part * 32 + j * 8 + i]; }
            qa += __shfl_xor(qa, 1); qa += __shfl_xor(qa, 2);
            if (part == 0) qns[s2] = qa;
        }
        LSYNC();
        const float Mlast = sc[0], bL = sc[1];
        {
            bf16x8 pf[2], qf[4];
#pragma unroll
            for (int kk = 0; kk < 2; ++kk) pf[kk] = ldfrag(Ps, 72, 16 * wid + fr, kk * 32 + fq * 8);
#pragma unroll
            for (int kk = 0; kk < 4; ++kk) qf[kk] = ldfrag(Qs, 136, 16 * wid + fr, kk * 32 + fq * 8);
            const int s = 16 * wid + fr; const float Msv = Ms[s], wi = __expf(m - Msv);
            const float den = rsum[s] + wi * qns[s], ms = bs[s] + Msv, inv = 1.f / fmaxf(fabsf(den), __expf(-ms));
#pragma unroll
            for (int nt = 0; nt < NT; ++nt) {
                f32x4 h1 = (f32x4){0.f, 0.f, 0.f, 0.f}, h2 = h1;
#pragma unroll
                for (int kk = 0; kk < 2; ++kk) h1 = mfma16(ldfrag_tr(VTs, LDV, kk * 32, nt * 16, fr, fq), pf[kk], h1);
#pragma unroll
                for (int kk = 0; kk < 4; ++kk) h2 = mfma16(ldfrag(STs, 136, nt * 16 + fr, kk * 32 + fq * 8), qf[kk], h2);
                f32x4 hv;
#pragma unroll
                for (int j = 0; j < 4; ++j) hv[j] = (h1[j] + wi * h2[j]) * inv;
                if (s < L && live) *(u32x2*)(BIG + (row0 + (size_t)c * 64 + s) * 5632 + 1024 + hd * 256 + es * 16 * NT + nt * 16 + 4 * fq) = pack4(hv);
            }
        }
        {
            const float decay = __expf(m - Mlast);
            bf16x8 vw0[NT], vw1[NT];
#pragma unroll
            for (int nt = 0; nt < NT; ++nt) { vw0[nt] = ldfrag_tr(VWs, LDV, 0, nt * 16, fr, fq); vw1[nt] = ldfrag_tr(VWs, LDV, 32, nt * 16, fr, fq); }
#pragma unroll
            for (int mt = 0; mt < 2; ++mt) {
                const bf16x8 k0 = ldfrag_tr(Ks, 136, 0, 32 * wid + 16 * mt, fr, fq), k1 = ldfrag_tr(Ks, 136, 32, 32 * wid + 16 * mt, fr, fq);
#pragma unroll
                for (int nt = 0; nt < NT; ++nt) {
                    accC[mt][nt] *= decay;
                    accC[mt][nt] = mfma16(k0, vw0[nt], accC[mt][nt]);
                    accC[mt][nt] = mfma16(k1, vw1[nt], accC[mt][nt]);
                }
                accN[mt] *= decay;
                accN[mt] = mfma16(k0, ldfrag(WRs, 72, fr, fq * 8), accN[mt]);
                accN[mt] = mfma16(k1, ldfrag(WRs, 72, fr, 32 + fq * 8), accN[mt]);
            }
        }
        m = bL + Mlast;
        LSYNC();
#pragma unroll
        for (int mt = 0; mt < 2; ++mt)
#pragma unroll
            for (int nt = 0; nt < NT; ++nt) *(u32x2*)(STs + (nt * 16 + fr) * 136 + 32 * wid + 16 * mt + 4 * fq) = pack4(accC[mt][nt]);
    #pragma unroll
        for (int mt = 0; mt < 2; ++mt) if (fr == 0) { ns[32 * wid + 16 * mt + 4 * fq] = accN[mt][0]; ns[32 * wid + 16 * mt + 4 * fq + 1] = accN[mt][1]; ns[32 * wid + 16 * mt + 4 * fq + 2] = accN[mt][2]; ns[32 * wid + 16 * mt + 4 * fq + 3] = accN[mt][3]; }
    }
    if (!live) return;
    float* Co = p.out + (smp ? OFF_SC : OFF_PC) + (size_t)sidx * 128 * 256;
#pragma unroll
    for (int mt = 0; mt < 2; ++mt)
#pragma unroll
        for (int nt = 0; nt < NT; ++nt)
#pragma unroll
            for (int j = 0; j < 4; ++j) Co[(size_t)(32 * wid + 16 * mt + 4 * fq + j) * 256 + es * 16 * NT + nt * 16 + fr] = accC[mt][nt][j];
    if (es == 0) {
        if (fr == 0) {
#pragma unroll
            for (int mt = 0; mt < 2; ++mt)
#pragma unroll
                for (int j = 0; j < 4; ++j) p.out[(smp ? OFF_SN : OFF_PN) + sidx * 128 + 32 * wid + 16 * mt + 4 * fq + j] = accN[mt][j];
        }
        if (tid == 0) p.out[(smp ? OFF_SM : OFF_PM) + sidx] = m;
    }
}

template <int NT>
DI void ssd_chain(const Params& p, bf16_t* BIG, const float* gates, int b, int hd, int ps, bool smp, char* smem, bool live) {
    const int tid = get_tid(), wid = tid >> 6, lane = tid & 63, fr = lane & 15, fq = lane >> 4;
    bf16_t* Cs = (bf16_t*)(smem + L_Q); bf16_t* Bs = (bf16_t*)(smem + L_K);  bf16_t* XTs = (bf16_t*)(smem + L_VT);
    constexpr int LDX = 16 * NT + 8;
    bf16_t* XWs = XTs + 64 * LDX; bf16_t* Ps = XWs + 64 * LDX; bf16_t* STs = Ps + 64 * 72;
    float* fl = (float*)(STs + 16 * NT * 136);
    float* bs = fl; float* dts = fl + 64; float* wrs = fl + 128; float* sc = fl + 192;
    const int L = smp ? 16 : 64, nch = smp ? 1 : 64, sidx = b * 16 + hd, g = hd >> 3;
    const size_t row0 = smp ? (size_t)NPR + b * 16 : (size_t)b * 4096;
    const float dtb = p.in[21][hd], negA = -__expf(p.in[22][hd]), Dk = p.in[23][hd];
    f32x4 accS[2][NT];
#pragma unroll
    for (int i = 0; i < 2; ++i)
#pragma unroll
        for (int nt = 0; nt < NT; ++nt) accS[i][nt] = (f32x4){0.f, 0.f, 0.f, 0.f};
    if (smp) {
        const float* S0 = p.in[5] + (size_t)sidx * 64 * 128;
#pragma unroll
        for (int i = 0; i < 2; ++i)
#pragma unroll
            for (int nt = 0; nt < NT; ++nt)
#pragma unroll
                for (int j = 0; j < 4; ++j) accS[i][nt][j] = S0[(size_t)(ps * 16 * NT + nt * 16 + fr) * 128 + 16 * (2 * wid + i) + 4 * fq + j];
    }
    LSYNC();
#pragma unroll
    for (int i = 0; i < 2; ++i)
#pragma unroll
        for (int nt = 0; nt < NT; ++nt) *(u32x2*)(STs + (nt * 16 + fr) * 136 + 16 * (2 * wid + i) + 4 * fq) = pack4(accS[i][nt]);

    u32x4 qv[4], kv[4], vv; float gd = 0.f;
    auto load = [&](int c) __attribute__((always_inline)) {
        const size_t r0 = row0 + (size_t)c * 64;
{
            const int r = tid >> 2, qt = tid & 3, rc = r < L ? r : L - 1;
            const bf16_t* bp = BIG + (r0 + rc) * 5632 + 5120 + g * 128 + qt * 32;
#pragma unroll
            for (int i = 0; i < 4; ++i) {
                qv[i] = *(const u32x4*)(bp + 256 + i * 8); kv[i] = *(const u32x4*)(bp + i * 8);
                if (r >= L) { qv[i] = (u32x4){0u, 0u, 0u, 0u}; kv[i] = (u32x4){0u, 0u, 0u, 0u}; }
            }
        }
        { const int vt = NT == 2 ? tid : (tid & 127), r = vt >> NT, cc = vt & (2 * NT - 1), rc = r < L ? r : L - 1;
          vv = *(const u32x4*)(BIG + (r0 + rc) * 5632 + 4096 + hd * 64 + ps * 16 * NT + cc * 8);
          if (r >= L) vv = (u32x4){0u, 0u, 0u, 0u}; }
        { const int lc = lane < L ? lane : L - 1; gd = gates[(r0 + lc) * 32 + 8 + hd]; }
    };
    load(0);
    for (int c = 0; c < nch; ++c) {
        LSYNC();
        if (wid == 0) {
            float dtv = 0.f;
            if (lane < L) dtv = softplusf(gd + dtb);
            const float a = negA * dtv;
            const float bc = scan_add(a, lane);
            const float bL = __shfl(bc, L - 1);
            bs[lane] = bc; dts[lane] = dtv; wrs[lane] = __expf(bL - bc) * dtv;
            if (lane == 0) sc[1] = bL;
        }
        LSYNC();
{
            const int r = tid >> 2, qt = tid & 3;
            bf16_t* qd = Cs + r * 136 + qt * 32; bf16_t* kd = Bs + r * 136 + qt * 32;
#pragma unroll
            for (int i = 0; i < 4; ++i) { *(u32x4*)(qd + i * 8) = qv[i]; *(u32x4*)(kd + i * 8) = kv[i]; }
        }
        if (NT == 2 || tid < 128) {
            const int r = tid >> NT, cc = tid & (2 * NT - 1); const float w = wrs[r];
            float vf[8]; unpack8(vv, vf);
#pragma unroll
            for (int j = 0; j < 8; ++j) vf[j] *= w;
            *(u32x4*)(XTs + r * LDX + cc * 8) = vv; *(u32x4*)(XWs + r * LDX + cc * 8) = pack8(vf);
        }
        if (c + 1 < nch) load(c + 1);
        LSYNC();
        {
            f32x4 s4[4];
#pragma unroll
            for (int nt = 0; nt < 4; ++nt) s4[nt] = (f32x4){0.f, 0.f, 0.f, 0.f};
#pragma unroll 1
            for (int kk = 0; kk < 4; ++kk) {
                const bf16x8 qf = ldfrag(Cs, 136, 16 * wid + fr, kk * 32 + fq * 8);
#pragma unroll
                for (int nt = 0; nt < 4; ++nt) s4[nt] = mfma16(ldfrag(Bs, 136, 16 * nt + fr, kk * 32 + fq * 8), qf, s4[nt]);
            }
            const int s = 16 * wid + fr; const float bsv = bs[s];
#pragma unroll
            for (int nt = 0; nt < 4; ++nt) {
                f32x4 pv;
#pragma unroll
                for (int j = 0; j < 4; ++j) { const int r = 16 * nt + 4 * fq + j; const float d = (r <= s) ? __expf(bsv - bs[r]) * dts[r] : 0.f; pv[j] = s4[nt][j] * d; }
                *(u32x2*)(Ps + s * 72 + 16 * nt + 4 * fq) = pack4(pv);
            }
        }
        LSYNC();
        const float bL = sc[1];
        {
            bf16x8 pf[2], cf[4];
#pragma unroll
            for (int kk = 0; kk < 2; ++kk) pf[kk] = ldfrag(Ps, 72, 16 * wid + fr, kk * 32 + fq * 8);
#pragma unroll
            for (int kk = 0; kk < 4; ++kk) cf[kk] = ldfrag(Cs, 136, 16 * wid + fr, kk * 32 + fq * 8);
            const int s = 16 * wid + fr; const float eb = __expf(bs[s]);
#pragma unroll
            for (int nt = 0; nt < NT; ++nt) {
                f32x4 h1 = (f32x4){0.f, 0.f, 0.f, 0.f}, h2 = h1;
#pragma unroll
                for (int kk = 0; kk < 2; ++kk) h1 = mfma16(ldfrag_tr(XTs, LDX, kk * 32, nt * 16, fr, fq), pf[kk], h1);
#pragma unroll
                for (int kk = 0; kk < 4; ++kk) h2 = mfma16(ldfrag(STs, 136, nt * 16 + fr, kk * 32 + fq * 8), cf[kk], h2);
                if (s < L && live) {
                    bf16_t* zp = BIG + (row0 + (size_t)c * 64 + s) * 5632 + 2048 + hd * 64 + ps * 16 * NT + nt * 16 + 4 * fq;
                    const u32x2 zr = *(const u32x2*)zp;
                    const float zf[4] = {lo2f(zr.x), hi2f(zr.x), lo2f(zr.y), hi2f(zr.y)};
                    f32x4 yv;
#pragma unroll
                    for (int j = 0; j < 4; ++j) { const float xv = bf2f(XTs[s * LDX + nt * 16 + 4 * fq + j]); yv[j] = (h1[j] + eb * h2[j] + Dk * xv) * siluf(zf[j]); }
                    *(u32x2*)zp = pack4(yv);
                }
            }
        }
        {
            const float dec = __expf(bL);
#pragma unroll
            for (int i = 0; i < 2; ++i) {
                const bf16x8 b0 = ldfrag_tr(Bs, 136, 0, 16 * (2 * wid + i), fr, fq), b1 = ldfrag_tr(Bs, 136, 32, 16 * (2 * wid + i), fr, fq);
#pragma unroll
                for (int nt = 0; nt < NT; ++nt) {
                    accS[i][nt] *= dec;
                    accS[i][nt] = mfma16(b0, ldfrag_tr(XWs, LDX, 0, nt * 16, fr, fq), accS[i][nt]);
                    accS[i][nt] = mfma16(b1, ldfrag_tr(XWs, LDX, 32, nt * 16, fr, fq), accS[i][nt]);
                }
            }
        }
        LSYNC();
#pragma unroll
        for (int i = 0; i < 2; ++i)
#pragma unroll
            for (int nt = 0; nt < NT; ++nt) *(u32x2*)(STs + (nt * 16 + fr) * 136 + 16 * (2 * wid + i) + 4 * fq) = pack4(accS[i][nt]);
    }
    if (!live) return;
    float* So = p.out + (smp ? OFF_SSSD : OFF_PSSD) + (size_t)sidx * 64 * 128;
#pragma unroll
    for (int i = 0; i < 2; ++i)
#pragma unroll
        for (int nt = 0; nt < NT; ++nt) {
            float4 o; o.x = accS[i][nt][0]; o.y = accS[i][nt][1]; o.z = accS[i][nt][2]; o.w = accS[i][nt][3];
            *(float4*)(So + (size_t)(ps * 16 * NT + nt * 16 + fr) * 128 + 16 * (2 * wid + i) + 4 * fq) = o;
        }
}

DI void phase_scan_l0(const Params& p, bf16_t* BIG, const float* gates, char* smem, bool live) {
    if (gridDim.x != 256) {
        for (int it = VB; it < 512; it += NVB) {
            const int k = it & 255;
            if (it < 256) mlstm_chain<1>(p, BIG, gates, k >> 6, (k >> 4) & 3, k & 15, false, smem, live);
            else ssd_chain<1>(p, BIG, gates, k >> 6, (k >> 2) & 15, k & 3, false, smem, live);
        }
    } else {
        const int x = (int)blockIdx.x & 7, y = (int)blockIdx.x >> 3, sub = get_sub();
        if (sub != 0) { for (int i = 0; i < 321; ++i) { asm volatile("" ::: "memory"); __builtin_amdgcn_s_barrier(); } }
        else if (y < 16) { const int chain = x + 8 * (y >> 3); mlstm_chain<2>(p, BIG, gates, chain >> 2, chain & 3, y & 7, false, smem, live); }
        else { const int yy = y - 16; ssd_chain<2>(p, BIG, gates, x >> 1, (x & 1) * 8 + (yy >> 1), yy & 1, false, smem, live); }
    }
    for (int it = 512 + VB; it < 1536; it += NVB) {
        const int k = (it - 512) & 511;
        if (it < 1024) mlstm_chain<1>(p, BIG, gates, k >> 6, (k >> 4) & 3, k & 15, true, smem, live);
        else ssd_chain<1>(p, BIG, gates, k >> 6, (k >> 2) & 15, k & 3, true, smem, live);
    }
}

DI void phase_post_l0(const Params& p, bf16_t* BIG) {
    const int tid_ = get_tid(), lane = tid_ & 63, gw = VB * 4 + (tid_ >> 6), nw = NVB * 4;
    for (int row = gw; row < NTOK; row += nw) {
        bf16_t* rp = BIG + (size_t)row * 5632;
        u32x2 rv[4], ov[4]; u32x4 yv[2];
#pragma unroll
        for (int hd = 0; hd < 4; ++hd) { rv[hd] = *(const u32x2*)(rp + 1024 + hd * 256 + lane * 4); ov[hd] = *(const u32x2*)(rp + 3072 + hd * 256 + lane * 4); }
#pragma unroll
        for (int g = 0; g < 2; ++g) yv[g] = *(const u32x4*)(rp + 2048 + g * 512 + lane * 8);
#pragma unroll
        for (int hd = 0; hd < 4; ++hd) {
            const float x[4] = {lo2f(rv[hd].x), hi2f(rv[hd].x), lo2f(rv[hd].y), hi2f(rv[hd].y)}, o[4] = {lo2f(ov[hd].x), hi2f(ov[hd].x), lo2f(ov[hd].y), hi2f(ov[hd].y)};
            const float ss = wave_sum(x[0] * x[0] + x[1] * x[1] + x[2] * x[2] + x[3] * x[3]);
            const float r = rsqrtf(ss * (1.f / 256.f) + 1e-6f);
            const float4 gg = *(const float4*)(p.in[18] + hd * 256 + lane * 4);
            f32x4 y; y[0] = sigmf(o[0]) * x[0] * r * gg.x; y[1] = sigmf(o[1]) * x[1] * r * gg.y; y[2] = sigmf(o[2]) * x[2] * r * gg.z; y[3] = sigmf(o[3]) * x[3] * r * gg.w;
            *(u32x2*)(rp + 1024 + hd * 256 + lane * 4) = pack4(y);
        }
#pragma unroll
        for (int g = 0; g < 2; ++g) {
            float x[8]; unpack8(yv[g], x);
            float ss = 0.f;
#pragma unroll
            for (int j = 0; j < 8; ++j) ss += x[j] * x[j];
            ss = wave_sum(ss);
            const float r = rsqrtf(ss * (1.f / 512.f) + 1e-6f);
            const float4 g0 = *(const float4*)(p.in[24] + g * 512 + lane * 8), g1 = *(const float4*)(p.in[24] + g * 512 + lane * 8 + 4);
            float y[8] = {x[0] * r * g0.x, x[1] * r * g0.y, x[2] * r * g0.z, x[3] * r * g0.w, x[4] * r * g1.x, x[5] * r * g1.y, x[6] * r * g1.z, x[7] * r * g1.w};
            *(u32x4*)(rp + 2048 + g * 512 + lane * 8) = pack8(y);
        }
    }
}

#define G_QN  0
#define G_KN  18432
#define G_AT  36864
#define G_VN  53504
#define G_TV  0
#define G_TW  9216
#define G_F   71936
DI void gdn_g1_item(const Params& p, bf16_t* BIG, bf16_t* Wb, bf16_t* PB, const float* gates, const bf16_t* halo, float* egl, int unit, int hd, char* smem, bool live) {
    const int tid = get_tid(), wid = tid >> 6, lane = tid & 63, fr = lane & 15, fq = lane >> 4;
    bf16_t* Qn = (bf16_t*)(smem + G_QN); bf16_t* Kn = (bf16_t*)(smem + G_KN);
    bf16_t* Vn = (bf16_t*)(smem + G_VN);
    float* AT = (float*)(smem + G_AT); bf16_t* Tv = (bf16_t*)(smem + G_TV); bf16_t* Tw = (bf16_t*)(smem + G_TW);
    float* beta_s = (float*)(smem + G_F); float* gam_s = beta_s + 64;
    const bool smp = unit >= 256;
    const int L = smp ? 16 : 64, c = unit & 63, s_ = unit - 256;
    const size_t row0 = smp ? (size_t)NPR + s_ * 16 : (size_t)unit * 64;
    const int tok = tid >> 2, qt = tid & 3;
    const float* cw = p.in[27];
    const bf16_t* hp = halo + (size_t)(smp ? 264 + s_ : (unit > 0 ? unit - 1 : 0)) * 3 * 3072;
    const bool zh = !smp && c == 0;
    LSYNC();
    if (wid == 0) {
        float beta = 0.f, g = 0.f;
        const int lc = lane < L ? lane : L - 1;
        const float br = gates[(row0 + lc) * 32 + hd], ar = gates[(row0 + lc) * 32 + 8 + hd];
        if (lane < L) { beta = sigmf(br); g = -__expf(p.in[29][hd]) * softplusf(ar + p.in[28][hd]); }
        const float gam = scan_add(g, lane);
        beta_s[lane] = beta; gam_s[lane] = gam;
        if (lane == L - 1 && live) egl[unit * 8 + hd] = __expf(gam);
    }
    u32x4 xn[16];
    auto g1_issue = [&](int mi) __attribute__((always_inline)) {
#pragma unroll
        for (int j = 0; j < 4; ++j) {
            const int col = mi * 1024 + hd * 128 + j * 32 + qt * 8;
#pragma unroll
            for (int i = 0; i < 4; ++i) {
                const int tc = tok < L ? tok : L - 1, rlc = tc - 3 + i;
                const bf16_t* src = rlc >= 0 ? BIG + (row0 + rlc) * 4096 + col : hp + (rlc + 3) * 3072 + col;
                xn[j * 4 + i] = *(const u32x4*)src;
                if (rlc < 0 && zh) xn[j * 4 + i] = (u32x4){0u, 0u, 0u, 0u};
            }
        }
    };
    g1_issue(0);
#pragma unroll 1
    for (int mi = 0; mi < 3; ++mi) {
        float o[32];
        u32x4 xc[16];
#pragma unroll
        for (int q = 0; q < 16; ++q) xc[q] = xn[q];
        if (mi < 2) g1_issue(mi + 1);
#pragma unroll
        for (int j = 0; j < 4; ++j) {
            const int col = mi * 1024 + hd * 128 + j * 32 + qt * 8;
            float a8[8];
#pragma unroll
            for (int q = 0; q < 8; ++q) a8[q] = 0.f;
#pragma unroll
            for (int i = 0; i < 4; ++i) {
                float xf[8]; unpack8(xc[j * 4 + i], xf);
                const float4 w0 = *(const float4*)(cw + i * 3072 + col), w1 = *(const float4*)(cw + i * 3072 + col + 4);
                a8[0] += w0.x * xf[0]; a8[1] += w0.y * xf[1]; a8[2] += w0.z * xf[2]; a8[3] += w0.w * xf[3];
                a8[4] += w1.x * xf[4]; a8[5] += w1.y * xf[5]; a8[6] += w1.z * xf[6]; a8[7] += w1.w * xf[7];
            }
#pragma unroll
            for (int q = 0; q < 8; ++q) o[j * 8 + q] = siluf(a8[q]);
        }
        if (mi < 2) {
            float ss = 0.f;
#pragma unroll
            for (int q = 0; q < 32; ++q) ss += o[q] * o[q];
            ss += __shfl_xor(ss, 1); ss += __shfl_xor(ss, 2);
            const float sc = rsqrtf(ss + 1e-6f) * (mi == 0 ? 0.08838834764831845f : 1.f);
#pragma unroll
            for (int q = 0; q < 32; ++q) o[q] *= sc;
        }
        if (tok >= L) {
#pragma unroll
            for (int q = 0; q < 32; ++q) o[q] = 0.f;
        }
        bf16_t* dst = (mi == 0 ? Qn : (mi == 1 ? Kn : Vn)) + tok * 136 + qt * 8;
#pragma unroll
        for (int j = 0; j < 4; ++j) *(u32x4*)(dst + j * 32) = pack8(o + j * 8);
    }
    LSYNC();
    {
        f32x4 a4[4], p4[4];
#pragma unroll
        for (int nt = 0; nt < 4; ++nt) { a4[nt] = (f32x4){0.f, 0.f, 0.f, 0.f}; p4[nt] = a4[nt]; }
#pragma unroll 1
        for (int kk = 0; kk < 4; ++kk) {
            const bf16x8 qf = ldfrag(Qn, 136, 16 * wid + fr, kk * 32 + fq * 8), ksf = ldfrag(Kn, 136, 16 * wid + fr, kk * 32 + fq * 8);
#pragma unroll
            for (int nt = 0; nt < 4; ++nt) { const bf16x8 kf = ldfrag(Kn, 136, 16 * nt + fr, kk * 32 + fq * 8); a4[nt] = mfma16(kf, ksf, a4[nt]); p4[nt] = mfma16(kf, qf, p4[nt]); }
        }
        const int s = 16 * wid + fr; const float gs = gam_s[s], bsv = beta_s[s];
#pragma unroll
        for (int nt = 0; nt < 4; ++nt) {
            f32x4 pv;
#pragma unroll
            for (int j = 0; j < 4; ++j) {
                const int r = 16 * nt + 4 * fq + j;
                const float d = (r <= s) ? __expf(gs - gam_s[r]) : 0.f;
                pv[j] = p4[nt][j] * d;
                AT[s * 65 + r] = (r < s) ? a4[nt][j] * d * bsv : 0.f;
            }
            if (s < L && live) *(u32x2*)(PB + (row0 + s) * 512 + hd * 64 + 16 * nt + 4 * fq) = pack4(pv);
        }
    }
    LSYNC();
    if (tok < L && live) {
        const float eg = __expf(gam_s[tok]);
#pragma unroll
        for (int j = 0; j < 4; ++j) {
            float qf8[8]; unpack8(*(const u32x4*)(Qn + tok * 136 + qt * 32 + j * 8), qf8);
#pragma unroll
            for (int q = 0; q < 8; ++q) qf8[q] *= eg;
            *(u32x4*)(BIG + (row0 + tok) * 4096 + hd * 128 + qt * 32 + j * 8) = pack8(qf8);
        }
    }
    LSYNC();
    {
        if (lane < 16) {
            const int o = 16 * wid; float t[16];
#pragma unroll
            for (int s = 0; s < 16; ++s) {
                float acc = (s == lane) ? 1.f : 0.f;
#pragma unroll
                for (int r = 0; r < s; ++r) acc -= AT[(o + s) * 65 + o + r] * t[r];
                t[s] = acc;
            }
#pragma unroll
            for (int s = 0; s < 16; ++s) AT[(o + s) * 65 + o + lane] = t[s];
        }
        LSYNC();
        {
            f32x4 bacc[2];
#pragma unroll
            for (int bb = 0; bb < 2; ++bb) {
                const int blk = wid + 4 * bb;
                bacc[bb] = (f32x4){0.f, 0.f, 0.f, 0.f};
                if (blk < 6) {
                    const int i = blk == 0 ? 1 : (blk < 3 ? 2 : 3), jb = blk == 0 ? 0 : (blk < 3 ? blk - 1 : blk - 3);
#pragma unroll
                    for (int kq = 0; kq < 4; ++kq)
                        bacc[bb] = __builtin_amdgcn_mfma_f32_16x16x4f32(AT[(16 * i + fr) * 65 + 16 * i + 4 * kq + fq], AT[(16 * i + 4 * kq + fq) * 65 + 16 * jb + fr], bacc[bb], 0, 0, 0);
                }
            }
            LSYNC();
#pragma unroll
            for (int bb = 0; bb < 2; ++bb) {
                const int blk = wid + 4 * bb;
                if (blk < 6) {
                    const int i = blk == 0 ? 1 : (blk < 3 ? 2 : 3), jb = blk == 0 ? 0 : (blk < 3 ? blk - 1 : blk - 3);
#pragma unroll
                    for (int jj = 0; jj < 4; ++jj) AT[(16 * i + 4 * fq + jj) * 65 + 16 * jb + fr] = bacc[bb][jj];
                }
            }
            LSYNC();
        }
#pragma unroll
        for (int i = 1; i < 4; ++i) {
            f32x4 tacc = (f32x4){0.f, 0.f, 0.f, 0.f};
            if (wid < i) {
                for (int m0 = 16 * wid; m0 < 16 * i; m0 += 4)
                    tacc = __builtin_amdgcn_mfma_f32_16x16x4f32(AT[(16 * i + fr) * 65 + m0 + fq], AT[(m0 + fq) * 65 + 16 * wid + fr], tacc, 0, 0, 0);
            }
            LSYNC();
            if (wid < i) {
#pragma unroll
                for (int jj = 0; jj < 4; ++jj) AT[(16 * i + 4 * fq + jj) * 65 + 16 * wid + fr] = -tacc[jj];
            }
            LSYNC();
        }
        const int s = tid >> 2, j0 = (tid & 3) * 16;
#pragma unroll
        for (int jj = 0; jj < 16; ++jj) {
            const int j = j0 + jj; const float t = AT[s * 65 + j], bj = beta_s[j];
            Tv[s * 72 + j] = f2bf(t * bj); Tw[s * 72 + j] = f2bf(t * bj * __expf(gam_s[j]));
        }
    }
    LSYNC();
    {
        const int s = 16 * wid + fr;
        const bf16x8 tw0 = ldfrag(Tw, 72, s, fq * 8), tw1 = ldfrag(Tw, 72, s, 32 + fq * 8), tv0 = ldfrag(Tv, 72, s, fq * 8), tv1 = ldfrag(Tv, 72, s, 32 + fq * 8);
#pragma unroll 2
        for (int nt = 0; nt < 8; ++nt) {
            f32x4 w4 = (f32x4){0.f, 0.f, 0.f, 0.f}, u4 = w4;
            w4 = mfma16(ldfrag_tr(Kn, 136, 0, 16 * nt, fr, fq), tw0, w4); w4 = mfma16(ldfrag_tr(Kn, 136, 32, 16 * nt, fr, fq), tw1, w4);
            u4 = mfma16(ldfrag_tr(Vn, 136, 0, 16 * nt, fr, fq), tv0, u4); u4 = mfma16(ldfrag_tr(Vn, 136, 32, 16 * nt, fr, fq), tv1, u4);
            if (s < L && live) {
                *(u32x2*)(Wb + (row0 + s) * 1024 + hd * 128 + 16 * nt + 4 * fq) = pack4(w4);
                *(u32x2*)(BIG + (row0 + s) * 4096 + 2048 + hd * 128 + 16 * nt + 4 * fq) = pack4(u4);
            }
        }
        const float gL = gam_s[L - 1];
#pragma unroll
        for (int ci = 0; ci < 2; ++ci)
#pragma unroll
            for (int kk = 0; kk < 2; ++kk) {
                const int cc = 2 * wid + ci, rb = 32 * kk + 8 * fq, d = 16 * cc + fr;
                const bf16x8 kf8 = ldfrag_tr(Kn, 136, 32 * kk, 16 * cc, fr, fq);
                if (rb < L && live) {
                    float kf[8]; unpack8(__builtin_bit_cast(u32x4, kf8), kf);
#pragma unroll
                    for (int q = 0; q < 8; ++q) kf[q] *= __expf(gL - gam_s[rb + q]);
                    const int e = d * L + rb;
                    *(u32x4*)(BIG + (row0 + (e >> 7)) * 4096 + 1024 + hd * 128 + (e & 127)) = pack8(kf);
                }
            }
        if ((smp || c == 63) && tid < 144 && live) {
            const int i = tid / 48, rem = tid % 48, col = (rem >> 4) * 1024 + hd * 128 + (rem & 15) * 8;
            float f[8]; unpack8(*(const u32x4*)(halo + ((size_t)unit * 3 + i) * 3072 + col), f);
            float* dst = smp ? p.out + OFF_SGC + ((size_t)s_ * 3 + i) * 3072 + col : p.out + OFF_PGC + ((size_t)(unit >> 6) * 3 + i) * 3072 + col;
            *(float4*)dst = make_float4(f[0], f[1], f[2], f[3]); *(float4*)(dst + 4) = make_float4(f[4], f[5], f[6], f[7]);
        }
    }
}

struct GdnFrags { bf16x8 w[4], q[4], p[2], kt[2][2]; u32x2 u0[2]; float eg; };
DI void gdn_chain(const Params& p, bf16_t* BIG, const bf16_t* Wb, const bf16_t* PB, const float* egl, int b, int hd, int es, bool smp, char* smem, bool live) {
    const int tid = get_tid(), wid = tid >> 6, lane = tid & 63, fr = lane & 15, fq = lane >> 4;
    bf16_t* UT0 = (bf16_t*)smem;
    bf16_t* ST0 = (bf16_t*)(smem + 9216);
    const int L = smp ? 16 : 64, nch = smp ? 1 : 64, sidx = b * 8 + hd;
    const size_t row0 = smp ? (size_t)NPR + b * 16 : (size_t)b * 4096;
    const bf16x8 z8 = (bf16x8){0, 0, 0, 0, 0, 0, 0, 0};
    f32x4 accS[2][2];
#pragma unroll
    for (int mt = 0; mt < 2; ++mt)
#pragma unroll
        for (int nt = 0; nt < 2; ++nt) accS[mt][nt] = (f32x4){0.f, 0.f, 0.f, 0.f};
    if (smp) {
        const float* S0 = p.in[7] + (size_t)sidx * 128 * 128;
#pragma unroll
        for (int mt = 0; mt < 2; ++mt)
#pragma unroll
            for (int nt = 0; nt < 2; ++nt)
#pragma unroll
                for (int j = 0; j < 4; ++j) accS[mt][nt][j] = S0[(size_t)(32 * wid + 16 * mt + 4 * fq + j) * 128 + es * 32 + nt * 16 + fr];
    }
    LSYNC();
#pragma unroll
    for (int mt = 0; mt < 2; ++mt)
#pragma unroll
        for (int nt = 0; nt < 2; ++nt) *(u32x2*)(ST0 + (nt * 16 + fr) * 136 + 32 * wid + 16 * mt + 4 * fq) = pack4(accS[mt][nt]);
    const int s = 16 * wid + fr, sc_ = s < L ? s : L - 1;
    const bool valid = s < L;
    auto load = [&](int c, GdnFrags& F) __attribute__((always_inline)) {
        const size_t r0 = row0 + (size_t)c * 64;
        const bf16_t* wp = Wb + (r0 + sc_) * 1024 + hd * 128 + fq * 8;
        const bf16_t* qp = BIG + (r0 + sc_) * 4096 + hd * 128 + fq * 8;
        const bf16_t* pp = PB + (r0 + sc_) * 512 + hd * 64 + fq * 8;
#pragma unroll
        for (int kk = 0; kk < 4; ++kk) { F.w[kk] = *(const bf16x8*)(wp + kk * 32); F.q[kk] = *(const bf16x8*)(qp + kk * 32); if (!valid) { F.w[kk] = z8; F.q[kk] = z8; } }
#pragma unroll
        for (int kk = 0; kk < 2; ++kk) { F.p[kk] = *(const bf16x8*)(pp + kk * 32); if (!valid) F.p[kk] = z8; }
#pragma unroll
        for (int mt = 0; mt < 2; ++mt)
#pragma unroll
            for (int kk = 0; kk < 2; ++kk) {
                const int d = 32 * wid + 16 * mt + fr, r = kk * 32 + fq * 8, rc = r < L ? r : 0, e = d * L + rc;
                F.kt[mt][kk] = *(const bf16x8*)(BIG + (r0 + (e >> 7)) * 4096 + 1024 + hd * 128 + (e & 127));
                if (r >= L) F.kt[mt][kk] = z8;
            }
#pragma unroll
        for (int nt = 0; nt < 2; ++nt) {
            F.u0[nt] = *(const u32x2*)(BIG + (r0 + sc_) * 4096 + 2048 + hd * 128 + es * 32 + nt * 16 + 4 * fq);
            if (!valid) F.u0[nt] = (u32x2){0u, 0u};
        }
        F.eg = egl[(smp ? 256 + b : b * 64 + c) * 8 + hd];
    };
    auto step = [&](int c, const GdnFrags& cur) __attribute__((always_inline)) {
        const bf16_t* STc = ST0 + (c & 1) * (32 * 136); bf16_t* STn = ST0 + ((c + 1) & 1) * (32 * 136);
        bf16_t* UTc = UT0 + (c & 1) * (32 * 72);
        bf16x8 sf[2][4];
#pragma unroll
        for (int nt = 0; nt < 2; ++nt)
#pragma unroll
            for (int kk = 0; kk < 4; ++kk) sf[nt][kk] = ldfrag(STc, 136, nt * 16 + fr, kk * 32 + fq * 8);
#pragma unroll
        for (int nt = 0; nt < 2; ++nt) {
            f32x4 w4 = (f32x4){0.f, 0.f, 0.f, 0.f};
#pragma unroll
            for (int kk = 0; kk < 4; ++kk) w4 = mfma16(sf[nt][kk], cur.w[kk], w4);
            const float uf[4] = {lo2f(cur.u0[nt].x) - w4[0], hi2f(cur.u0[nt].x) - w4[1], lo2f(cur.u0[nt].y) - w4[2], hi2f(cur.u0[nt].y) - w4[3]};
#pragma unroll
            for (int j = 0; j < 4; ++j) UTc[(nt * 16 + 4 * fq + j) * 72 + s] = f2bf(uf[j]);
        }
        LSYNC();
        {
            bf16x8 uf8[2][2];
#pragma unroll
            for (int nt = 0; nt < 2; ++nt) {
                f32x4 o4 = (f32x4){0.f, 0.f, 0.f, 0.f};
#pragma unroll
                for (int kk = 0; kk < 4; ++kk) o4 = mfma16(sf[nt][kk], cur.q[kk], o4);
#pragma unroll
                for (int kk = 0; kk < 2; ++kk) { uf8[nt][kk] = ldfrag(UTc, 72, nt * 16 + fr, kk * 32 + fq * 8); o4 = mfma16(uf8[nt][kk], cur.p[kk], o4); }
                if (valid && live) *(u32x2*)(BIG + (row0 + (size_t)c * 64 + s) * 4096 + 2048 + hd * 128 + es * 32 + nt * 16 + 4 * fq) = pack4(o4);
            }
#pragma unroll
            for (int mt = 0; mt < 2; ++mt)
#pragma unroll
                for (int nt = 0; nt < 2; ++nt) {
                    accS[mt][nt] *= cur.eg;
#pragma unroll
                    for (int kk = 0; kk < 2; ++kk) accS[mt][nt] = mfma16(cur.kt[mt][kk], uf8[nt][kk], accS[mt][nt]);
                    *(u32x2*)(STn + (nt * 16 + fr) * 136 + 32 * wid + 16 * mt + 4 * fq) = pack4(accS[mt][nt]);
                }
        }
        LSYNC();
    };
    GdnFrags fa, fb; load(0, fa); fb = fa;
    if (nch > 1) load(1, fb);
    LSYNC();
    for (int c = 0; c < nch; c += 2) {
        step(c, fa);
        if (c + 2 < nch) load(c + 2, fa);
        if (c + 1 < nch) { step(c + 1, fb); if (c + 3 < nch) load(c + 3, fb); }
    }
    if (!live) return;
    float* So = p.out + (smp ? OFF_SG : OFF_PG) + (size_t)sidx * 128 * 128;
#pragma unroll
    for (int mt = 0; mt < 2; ++mt)
#pragma unroll
        for (int nt = 0; nt < 2; ++nt)
#pragma unroll
            for (int j = 0; j < 4; ++j) So[(size_t)(32 * wid + 16 * mt + 4 * fq + j) * 128 + es * 32 + nt * 16 + fr] = accS[mt][nt][j];
}

DI void phase_post_l1(const Params& p, bf16_t* BIG) {
    const int tid_ = get_tid(), lane = tid_ & 63, gw = VB * 4 + (tid_ >> 6), nw = NVB * 4;
    const int hd = lane >> 3, e0 = (lane & 7) * 16;
    for (int row = gw; row < NTOK; row += nw) {
        bf16_t* op = BIG + (size_t)row * 4096 + 2048 + hd * 128 + e0;
        const bf16_t* zp = BIG + (size_t)row * 4096 + 3072 + hd * 128 + e0;
        float x[16], z[16];
        unpack8(*(const u32x4*)op, x); unpack8(*(const u32x4*)(op + 8), x + 8);
        unpack8(*(const u32x4*)zp, z); unpack8(*(const u32x4*)(zp + 8), z + 8);
        float ss = 0.f;
#pragma unroll
        for (int j = 0; j < 16; ++j) ss += x[j] * x[j];
        ss += __shfl_xor(ss, 1); ss += __shfl_xor(ss, 2); ss += __shfl_xor(ss, 4);
        const float r = rsqrtf(ss * (1.f / 128.f) + 1e-6f);
        float y[16];
#pragma unroll
        for (int j = 0; j < 16; ++j) y[j] = x[j] * r * p.in[30][e0 + j] * siluf(z[j]);
        *(u32x4*)op = pack8(y); *(u32x4*)(op + 8) = pack8(y + 8);
    }
}

__global__ void __launch_bounds__(512, 2) fwd_megakernel(Params p) {
    __shared__ __attribute__((aligned(16))) char smem_all[LDS_BYTES];
    char* smem = smem_all + get_sub() * LDS_SUB;
    cg::grid_group grid = cg::this_grid();
    char* ws = p.ws;
    if (ws == nullptr) grid.sync();
    if (threadIdx.x < 4) ((volatile LAS unsigned*)(smem_all + LDS_BYTES - 16))[threadIdx.x] = 0u;
    __syncthreads();
    const XcdBarrier xb = xcd_barrier_post((unsigned*)(ws + WS_BAR), (volatile LAS unsigned*)(smem_all + LDS_BYTES - 16));
    bf16_t* WGU = (bf16_t*)(ws + WS_WGU); bf16_t* WD = (bf16_t*)(ws + WS_WD); bf16_t* WIN = (bf16_t*)(ws + WS_WIN); bf16_t* WOUT = (bf16_t*)(ws + WS_WOUT);
    bf16_t* H = (bf16_t*)(ws + WS_H); bf16_t* BIG = (bf16_t*)(ws + WS_BIG); float* GATES = (float*)(ws + WS_GATES); bf16_t* HALO = (bf16_t*)(ws + WS_HALO); float* EGL = (float*)(ws + WS_EGL);
    bf16_t* PB = BIG + (size_t)NTOK * 4096;
    float* X = p.out; float* XS = p.out + (size_t)NPR * 1024;
    const float* ng = p.in[9];
    const size_t FW = (size_t)1024 * 2816;
    Epi e{};
    phase_norm(p.in[0], p.in[1], ng, H);
    for (int i = VB * 256 + get_tid(); i < 128 * 1024 / 4; i += NVB * 256) ((float4*)XS)[i] = ((const float4*)p.in[1])[i];
    cvt_job(p.in[11], 1024, 2816, WGU, 1, 0, smem);
    cvt_job(p.in[12], 1024, 2816, WGU, 2, 100, smem);
    cvt_job(p.in[13], 2816, 1024, WD, 0, 200, smem);
    cvt_job(p.in[14], 1024, 5656, WIN, 3, 300, smem);
    cvt_job(p.in[15], 2048, 1024, WOUT, 0, 400, smem);
    xcd_barrier(xb);
    e.o16 = BIG; e.ldc = 2816;
    { PEpiGU pe; pe.O = BIG; gemm_big(H, 1024, WGU, 1024, 5632, pe, smem_all); }
    gemm_tail<EPI_GU>(H, 1024, WGU, 1024, 44, e, smem);
    xcd_barrier(xb);
    e.o32 = X; e.rp = p.in[0]; e.rs = p.in[1]; e.scale = 0.5f;
    { PEpiRES pe; pe.X = X; pe.R = e.rp; pe.scale = e.scale; gemm_big(BIG, 2816, WD, 2816, 1024, pe, smem_all); }
    gemm_tail<EPI_RES>(BIG, 2816, WD, 2816, 8, e, smem);
    xcd_barrier(xb);
    phase_norm(X, XS, ng + 1024, H);
    cvt_job(p.in[11] + FW, 1024, 2816, WGU, 1, 0, smem);
    cvt_job(p.in[12] + FW, 1024, 2816, WGU, 2, 100, smem);
    cvt_job(p.in[13] + FW, 2816, 1024, WD, 0, 200, smem);
    xcd_barrier(xb);
    e.o16 = BIG; e.ldc = 5632; e.gates = GATES; e.halo = HALO; e.cv0 = 4096; e.cv1 = 5632;
    { PEpiPROJ pe; pe.O = BIG; pe.ldc = 5632; pe.halo = HALO; pe.cv0 = 4096; pe.cv1 = 5632; gemm_big(H, 1024, WIN, 1024, 5632, pe, smem_all); }
    gemm_tail<EPI_PROJ>(H, 1024, WIN, 1024, 45, e, smem);
    xcd_barrier(xb);
#if PHM & 1
    phase_conv_ssd(p, BIG, HALO);
#endif
    xcd_barrier(xb);
#if PHM & 2
#ifdef PROBE_L0
    phase_scan_l0(p, BIG, GATES, smem, p.ws == nullptr);
    xcd_barrier(xb);
#endif
    phase_scan_l0(p, BIG, GATES, smem, true);
#endif
    xcd_barrier(xb);
    phase_post_l0(p, BIG);
    xcd_barrier(xb);
    e.o32 = X; e.rp = X; e.rs = XS; e.scale = 1.0f;
    { PEpiRES pe; pe.X = X; pe.R = e.rp; pe.scale = e.scale; gemm_big(BIG + 1024, 5632, WOUT, 2048, 1024, pe, smem_all); }
    gemm_tail<EPI_RES>(BIG + 1024, 5632, WOUT, 2048, 8, e, smem);
    xcd_barrier(xb);
    phase_norm(X, XS, ng + 2048, H);
    xcd_barrier(xb);
    e.o16 = BIG; e.ldc = 2816;
    { PEpiGU pe; pe.O = BIG; gemm_big(H, 1024, WGU, 1024, 5632, pe, smem_all); }
    gemm_tail<EPI_GU>(H, 1024, WGU, 1024, 44, e, smem);
    xcd_barrier(xb);
    e.scale = 0.5f;
    { PEpiRES pe; pe.X = X; pe.R = e.rp; pe.scale = e.scale; gemm_big(BIG, 2816, WD, 2816, 1024, pe, smem_all); }
    gemm_tail<EPI_RES>(BIG, 2816, WD, 2816, 8, e, smem);
    xcd_barrier(xb);
    phase_norm(X, XS, ng + 3072, H);
    cvt_job(p.in[11] + 2 * FW, 1024, 2816, WGU, 1, 0, smem);
    cvt_job(p.in[12] + 2 * FW, 1024, 2816, WGU, 2, 100, smem);
    cvt_job(p.in[13] + 2 * FW, 2816, 1024, WD, 0, 200, smem);
    cvt_job(p.in[25], 1024, 4112, WIN, 0, 300, smem);
    cvt_job(p.in[26], 1024, 1024, WOUT, 0, 400, smem);
    xcd_barrier(xb);
    { PEpiGU pe; pe.O = BIG; gemm_big(H, 1024, WGU, 1024, 5632, pe, smem_all); }
    gemm_tail<EPI_GU>(H, 1024, WGU, 1024, 44, e, smem);
    xcd_barrier(xb);
    { PEpiRES pe; pe.X = X; pe.R = e.rp; pe.scale = e.scale; gemm_big(BIG, 2816, WD, 2816, 1024, pe, smem_all); }
    gemm_tail<EPI_RES>(BIG, 2816, WD, 2816, 8, e, smem);
    xcd_barrier(xb);
    phase_norm(X, XS, ng + 4096, H);
    fill_cache_halo(p.in[8], 3072, HALO);
    cvt_job(p.in[11] + 3 * FW, 1024, 2816, WGU, 1, 0, smem);
    cvt_job(p.in[12] + 3 * FW, 1024, 2816, WGU, 2, 100, smem);
    cvt_job(p.in[13] + 3 * FW, 2816, 1024, WD, 0, 200, smem);
    xcd_barrier(xb);
    e.o16 = BIG; e.ldc = 4096; e.cv0 = 0; e.cv1 = 3072;
    { PEpiPROJ pe; pe.O = BIG; pe.ldc = 4096; pe.halo = HALO; pe.cv0 = 0; pe.cv1 = 3072; gemm_big(H, 1024, WIN, 1024, 4096, pe, smem_all); }
    gemm_tail<EPI_PROJ>(H, 1024, WIN, 1024, 33, e, smem);
    xcd_barrier(xb);
#if PHM & 4
#ifdef PROBE_G1
    for (int it = VB; it < 264 * 8; it += NVB) gdn_g1_item(p, BIG, H, PB, GATES, HALO, EGL, it >> 3, it & 7, smem, p.ws == nullptr);
    xcd_barrier(xb);
#endif
    for (int it = VB; it < (gridDim.x == 256 ? 256 : 264) * 8; it += NVB) gdn_g1_item(p, BIG, H, PB, GATES, HALO, EGL, it >> 3, it & 7, smem, true);
#endif
    xcd_barrier(xb);
#if PHM & 8
#ifdef PROBE_GDN
    { const bool glive = (p.ws == nullptr);
    if (gridDim.x != 256) {
        for (int it = VB; it < 384; it += NVB) {
            const bool smp = it >= 128; const int j = smp ? it - 128 : it;
            gdn_chain(p, BIG, H, PB, EGL, j >> 5, (j >> 2) & 7, j & 3, smp, smem, glive);
        }
    } else {
        const int x = (int)blockIdx.x & 7, y = (int)blockIdx.x >> 3, sub = get_sub();
        if (y < 16) {
            if (sub == 0) gdn_chain(p, BIG, H, PB, EGL, y >> 2, x, y & 3, false, smem, glive);
            else for (int i = 0; i < 130; ++i) { asm volatile("" ::: "memory"); __builtin_amdgcn_s_barrier(); }
        }
        else if (y < 20) {
            const int v = (y - 16) * 16 + x * 2 + sub, sidx = v >> 3, shd = v & 7;
            gdn_g1_item(p, BIG, H, PB, GATES, HALO, EGL, 256 + sidx, shd, smem, glive);
            asm volatile("s_waitcnt vmcnt(0)" ::: "memory");
            __builtin_amdgcn_fence(__ATOMIC_RELEASE, "agent");
            __builtin_amdgcn_fence(__ATOMIC_ACQUIRE, "agent");
            asm volatile("s_waitcnt vmcnt(0)" ::: "memory");
            __builtin_amdgcn_s_barrier();
            for (int e4 = 0; e4 < 4; ++e4) gdn_chain(p, BIG, H, PB, EGL, sidx, shd, e4, true, smem, glive);
        }
    }
    }
    xcd_barrier(xb);
#endif
    { const bool glive = true;
    if (gridDim.x != 256) {
        for (int it = VB; it < 384; it += NVB) {
            const bool smp = it >= 128; const int j = smp ? it - 128 : it;
            gdn_chain(p, BIG, H, PB, EGL, j >> 5, (j >> 2) & 7, j & 3, smp, smem, glive);
        }
    } else {
        const int x = (int)blockIdx.x & 7, y = (int)blockIdx.x >> 3, sub = get_sub();
        if (y < 16) {
            if (sub == 0) gdn_chain(p, BIG, H, PB, EGL, y >> 2, x, y & 3, false, smem, glive);
            else for (int i = 0; i < 130; ++i) { asm volatile("" ::: "memory"); __builtin_amdgcn_s_barrier(); }
        }
        else if (y < 20) {
            const int v = (y - 16) * 16 + x * 2 + sub, sidx = v >> 3, shd = v & 7;
            gdn_g1_item(p, BIG, H, PB, GATES, HALO, EGL, 256 + sidx, shd, smem, glive);
            asm volatile("s_waitcnt vmcnt(0)" ::: "memory");
            __builtin_amdgcn_fence(__ATOMIC_RELEASE, "agent");
            __builtin_amdgcn_fence(__ATOMIC_ACQUIRE, "agent");
            asm volatile("s_waitcnt vmcnt(0)" ::: "memory");
            __builtin_amdgcn_s_barrier();
            for (int e4 = 0; e4 < 4; ++e4) gdn_chain(p, BIG, H, PB, EGL, sidx, shd, e4, true, smem, glive);
        }
    }
    }
#endif
    xcd_barrier(xb);
    phase_post_l1(p, BIG);
    xcd_barrier(xb);
    e.scale = 1.0f;
    { PEpiRES pe; pe.X = X; pe.R = e.rp; pe.scale = e.scale; gemm_big(BIG + 2048, 4096, WOUT, 1024, 1024, pe, smem_all); }
    gemm_tail<EPI_RES>(BIG + 2048, 4096, WOUT, 1024, 8, e, smem);
    xcd_barrier(xb);
    phase_norm(X, XS, ng + 5120, H);
    xcd_barrier(xb);
    e.o16 = BIG; e.ldc = 2816;
    { PEpiGU pe; pe.O = BIG; gemm_big(H, 1024, WGU, 1024, 5632, pe, smem_all); }
    gemm_tail<EPI_GU>(H, 1024, WGU, 1024, 44, e, smem);
    xcd_barrier(xb);
    e.scale = 0.5f;
    { PEpiRES pe; pe.X = X; pe.R = e.rp; pe.scale = e.scale; gemm_big(BIG, 2816, WD, 2816, 1024, pe, smem_all); }
    gemm_tail<EPI_RES>(BIG, 2816, WD, 2816, 8, e, smem);
    xcd_barrier(xb);
    phase_final_norm(X, p.in[10]);
}

extern "C" void kernel_launch(void* const* d_in, const int* in_sizes, int n_in, void* d_out, int out_size, void* d_ws, size_t ws_size, hipStream_t stream) {
    static int grid_blocks = 0;
    if (!grid_blocks) {
        int dev = 0, cus = 0, per_cu = 0;
        hipGetDevice(&dev);
        hipDeviceGetAttribute(&cus, hipDeviceAttributeMultiprocessorCount, dev);
        hipOccupancyMaxActiveBlocksPerMultiprocessor(&per_cu, fwd_megakernel, 512, 0);
        if (per_cu > 1) per_cu = 1;
        if (per_cu < 1) per_cu = 1;
        grid_blocks = cus * per_cu;
    }
    Params p{};
    for (int i = 0; i < 31; ++i) p.in[i] = (const float*)d_in[i];
    p.out = (float*)d_out;
    p.ws = (char*)d_ws;
    (void)hipMemsetAsync((char*)d_ws + WS_BAR, 0, 16384, stream);
    void* args[] = {&p};
    hipError_t err = hipLaunchCooperativeKernel((void*)fwd_megakernel, dim3(grid_blocks), dim3(512), args, 0, stream);
    if (err != hipSuccess) fprintf(stderr, "cooperative launch failed: %s (grid %d)\n", hipGetErrorString(err), grid_blocks);
}
```
